# Optimizing an MI355X kernel written in HIP

```python
import math
import jax, jax.numpy as jnp
from jax import lax
import numpy as np

D_MODEL = 4096
BATCH = 1
SEQ = 8192
DEPTH = 1
DEC_BATCH = 16
DEC_SEQ = 16
PAST_LEN = 2048

CHUNK = 64
D_MIX = D_MODEL
D_MLSTM = D_MIX // 2
D_S5 = D_MIX - D_MLSTM
M_HEADS = 4
M_DV = D_MLSTM // M_HEADS
M_DQK = M_DV // 2
CONV_W = 4
S5_GROUP = 16
S5_GROUPS = D_S5 // S5_GROUP
S5_STATE = 64
D_FF = ((8 * D_MODEL // 3 + 255) // 256) * 256
D_IN = 3 * D_MLSTM + D_S5 + 2 * M_HEADS
RMS_EPS = 1e-6

kernel_name = 'hybrid_mlstm_s5_stream_step'


def rmsnorm(x, g):
    xf = x.astype(jnp.float32)
    y = xf * lax.rsqrt(jnp.mean(xf * xf, axis=-1, keepdims=True) + RMS_EPS)
    return (y * g.astype(jnp.float32)).astype(x.dtype)


def swiglu(x, w_gate, w_up, w_down):
    return (jax.nn.silu(x @ w_gate) * (x @ w_up)) @ w_down


def causal_conv(u, buf, w, b):
    L = u.shape[1]
    xp = jnp.concatenate([buf.astype(u.dtype), u], axis=1)
    y = b + xp[:, 0:L] * w[0]
    for j in range(1, CONV_W):
        y = y + xp[:, j:j + L] * w[j]
    return y, xp[:, L:]


def to_chunks(a, lc):
    bsz, nh, L = a.shape[:3]
    a = a.reshape((bsz, nh, L // lc, lc) + a.shape[3:])
    return jnp.moveaxis(a, 2, 0)


def from_chunks(a):
    a = jnp.moveaxis(a, 0, 2)
    return a.reshape((a.shape[0], a.shape[1], a.shape[2] * a.shape[3]) + a.shape[4:])


def mlstm_chunk(carry, inp):
    c0, n0, m0 = carry
    q, k, v, ig, lf = inp
    lc = q.shape[2]
    b = jnp.cumsum(lf, axis=-1)
    causal = jnp.tril(jnp.ones((lc, lc), dtype=bool))
    log_d = jnp.where(causal, b[..., :, None] - b[..., None, :] + ig[..., None, :], -jnp.inf)
    inter = b + m0[..., None]
    m_t = jnp.maximum(inter, jnp.max(log_d, axis=-1))
    s = jnp.einsum('bhtd,bhsd->bhts', q, k) * jnp.exp(log_d - m_t[..., None])
    w_inter = jnp.exp(inter - m_t)
    num = w_inter[..., None] * jnp.einsum('bhtd,bhde->bhte', q, c0) + jnp.einsum('bhts,bhse->bhte', s, v)
    den = w_inter * jnp.einsum('bhtd,bhd->bht', q, n0) + jnp.sum(s, axis=-1)
    h = num / jnp.maximum(jnp.abs(den), jnp.exp(-m_t))[..., None]
    b_last = b[..., -1]
    log_w = b_last[..., None] - b + ig
    m_new = jnp.maximum(b_last + m0, jnp.max(log_w, axis=-1))
    w = jnp.exp(log_w - m_new[..., None])
    decay = jnp.exp(b_last + m0 - m_new)
    c_new = decay[..., None, None] * c0 + jnp.einsum('bhs,bhsd,bhse->bhde', w, k, v)
    n_new = decay[..., None] * n0 + jnp.einsum('bhs,bhsd->bhd', w, k)
    return (c_new, n_new, m_new), h


def mlstm(q, k, v, ig, lf, c0, n0, m0):
    lc = min(CHUNK, q.shape[2])
    xs = (to_chunks(q, lc), to_chunks(k, lc), to_chunks(v, lc), to_chunks(ig, lc), to_chunks(lf, lc))
    (c, n, m), h = lax.scan(mlstm_chunk, (c0, n0, m0), xs)
    return from_chunks(h), c, n, m


def complex_combine(e1, e2):
    a1r, a1i, b1r, b1i = e1
    a2r, a2i, b2r, b2i = e2
    return (a1r * a2r - a1i * a2i,
            a1r * a2i + a1i * a2r,
            a2r * b1r - a2i * b1i + b2r,
            a2r * b1i + a2i * b1r + b2i)


def s5_discretize(a_re, a_im, log_dt, b_re, b_im):
    dt = jnp.exp(log_dt)[:, None]
    mag = jnp.exp(a_re * dt)
    ab_re = mag * jnp.cos(a_im * dt)
    ab_im = mag * jnp.sin(a_im * dt)
    den = a_re * a_re + a_im * a_im
    inv_re = a_re / den
    inv_im = -a_im / den
    f_re = ab_re - 1.0
    f_im = ab_im
    q_re = f_re * inv_re - f_im * inv_im
    q_im = f_re * inv_im + f_im * inv_re
    bb_re = q_re[..., None] * b_re - q_im[..., None] * b_im
    bb_im = q_re[..., None] * b_im + q_im[..., None] * b_re
    return ab_re, ab_im, bb_re, bb_im


def s5_scan(u, h_re, h_im, ab_re, ab_im, bb_re, bb_im, c_re, c_im, d):
    bsz, L = u.shape[:2]
    lc = min(CHUNK, L)
    uc = jnp.moveaxis(u.reshape(bsz, L // lc, lc, S5_GROUPS, S5_GROUP), 1, 0)

    def step(carry, u_c):
        hr, hi = carry
        bu_re = jnp.einsum('blgj,gpj->blgp', u_c, bb_re)
        bu_im = jnp.einsum('blgj,gpj->blgp', u_c, bb_im)
        bu_re = bu_re.at[:, 0].add(ab_re * hr - ab_im * hi)
        bu_im = bu_im.at[:, 0].add(ab_re * hi + ab_im * hr)
        a_r = jnp.broadcast_to(ab_re, bu_re.shape)
        a_i = jnp.broadcast_to(ab_im, bu_re.shape)
        _, _, sr, si = lax.associative_scan(complex_combine, (a_r, a_i, bu_re, bu_im), axis=1)
        y = (jnp.einsum('blgp,gjp->blgj', sr, c_re) - jnp.einsum('blgp,gjp->blgj', si, c_im)
             + d * u_c)
        return (sr[:, -1], si[:, -1]), y

    (hr, hi), y = lax.scan(step, (h_re, h_im), uc)
    y = jnp.moveaxis(y, 0, 1).reshape(bsz, L, D_S5)
    return y, hr, hi


def layer(x, m_c, m_n, m_m, conv_buf, s5_re, s5_im, p):
    dt = x.dtype
    bsz, L, _ = x.shape
    f32 = jnp.float32
    h = rmsnorm(x, p['ff1_norm_pre'])
    x = x + 0.5 * rmsnorm(swiglu(h, p['ff1_w_gate'], p['ff1_w_up'], p['ff1_w_down']), p['ff1_norm_post'])
    h = rmsnorm(x, p['mix_norm_pre'])
    proj = h @ p['w_in']
    u_m, v, o, u_s, ig, fg = jnp.split(
        proj, [D_MLSTM, 2 * D_MLSTM, 3 * D_MLSTM, 3 * D_MLSTM + D_S5, 3 * D_MLSTM + D_S5 + M_HEADS], axis=-1)
    cv, conv_new = causal_conv(u_m, conv_buf, p['mlstm_conv_w'], p['mlstm_conv_b'])
    cv = jax.nn.silu(cv).reshape(bsz, L, M_HEADS, M_DV)
    q = jnp.einsum('blhd,hde->bhle', cv, p['mlstm_w_q']).astype(f32)
    k = jnp.einsum('blhd,hde->bhle', cv, p['mlstm_w_k']).astype(f32) * (M_DQK ** -0.5)
    vh = v.reshape(bsz, L, M_HEADS, M_DV).transpose(0, 2, 1, 3).astype(f32)
    ig = (ig + p['mlstm_b_i']).astype(f32).transpose(0, 2, 1)
    lf = jax.nn.log_sigmoid((fg + p['mlstm_b_f']).astype(f32)).transpose(0, 2, 1)
    hm, c_new, n_new, m_new = mlstm(q, k, vh, ig, lf, m_c.astype(f32), m_n.astype(f32), m_m.astype(f32))
    hm = rmsnorm(hm, p['mlstm_head_norm'][:, None, :])
    hm = hm.transpose(0, 2, 1, 3).reshape(bsz, L, D_MLSTM).astype(dt) * jax.nn.sigmoid(o)
    ab_re, ab_im, bb_re, bb_im = s5_discretize(
        p['s5_a_re'].astype(f32), p['s5_a_im'].astype(f32), p['s5_log_dt'].astype(f32),
        p['s5_b_re'].astype(f32), p['s5_b_im'].astype(f32))
    ys, sr_new, si_new = s5_scan(
        u_s.astype(f32).reshape(bsz, L, S5_GROUPS, S5_GROUP), s5_re.astype(f32), s5_im.astype(f32),
        ab_re, ab_im, bb_re, bb_im, p['s5_c_re'].astype(f32), p['s5_c_im'].astype(f32), p['s5_d'].astype(f32))
    g = jax.nn.gelu(ys)
    ys = (g * jax.nn.sigmoid(g @ p['s5_w_glu'].astype(f32) + p['s5_b_glu'].astype(f32))).astype(dt)
    mix = jnp.concatenate([hm, ys], axis=-1) @ p['w_out']
    x = x + rmsnorm(mix, p['mix_norm_post'])
    h = rmsnorm(x, p['ff2_norm_pre'])
    x = x + 0.5 * rmsnorm(swiglu(h, p['ff2_w_gate'], p['ff2_w_up'], p['ff2_w_down']), p['ff2_norm_post'])
    return x, c_new, n_new, m_new, conv_new, sr_new, si_new


def setup_inputs(seed: int = 0) -> dict:
    key = jax.random.key(seed)
    ks = jax.random.split(key, 40)
    f32 = jnp.float32

    def nrm(k, shape, scale):
        return jax.random.normal(k, shape, f32) * scale

    def gain(k, shape):
        return 1.0 + 0.01 * jax.random.normal(k, shape, f32)

    b_f = jnp.linspace(3.0, 6.0, M_HEADS, dtype=f32)[None, :] + nrm(ks[20], (DEPTH, M_HEADS), 0.1)
    a_im = jnp.pi * jnp.arange(S5_STATE, dtype=f32)[None, None, :] + nrm(ks[23], (DEPTH, S5_GROUPS, S5_STATE), 0.01)
    return {
        'x_prompt': nrm(ks[0], (BATCH, SEQ, D_MODEL), 1.0),
        'x_sample': nrm(ks[1], (DEC_BATCH, DEC_SEQ, D_MODEL), 1.0),
        'state_mlstm_C': nrm(ks[2], (DEPTH, DEC_BATCH, M_HEADS, M_DQK, M_DV), M_DQK ** -0.5),
        'state_mlstm_n': nrm(ks[3], (DEPTH, DEC_BATCH, M_HEADS, M_DQK), 1.0),
        'state_mlstm_m': nrm(ks[4], (DEPTH, DEC_BATCH, M_HEADS), 1.0),
        'cache_mlstm_conv': nrm(ks[5], (DEPTH, DEC_BATCH, CONV_W - 1, D_MLSTM), 1.0),
        'state_s5_re': nrm(ks[6], (DEPTH, DEC_BATCH, S5_GROUPS, S5_STATE), 0.5),
        'state_s5_im': nrm(ks[7], (DEPTH, DEC_BATCH, S5_GROUPS, S5_STATE), 0.5),
        'ff1_norm_pre': gain(ks[8], (DEPTH, D_MODEL)),
        'ff1_norm_post': gain(ks[9], (DEPTH, D_MODEL)),
        'ff1_w_gate': nrm(ks[10], (DEPTH, D_MODEL, D_FF), D_MODEL ** -0.5),
        'ff1_w_up': nrm(ks[11], (DEPTH, D_MODEL, D_FF), D_MODEL ** -0.5),
        'ff1_w_down': nrm(ks[12], (DEPTH, D_FF, D_MODEL), D_FF ** -0.5),
        'mix_norm_pre': gain(ks[13], (DEPTH, D_MODEL)),
        'w_in': nrm(ks[14], (DEPTH, D_MODEL, D_IN), D_MODEL ** -0.5),
        'mlstm_conv_w': nrm(ks[15], (DEPTH, CONV_W, D_MLSTM), CONV_W ** -0.5),
        'mlstm_conv_b': nrm(ks[16], (DEPTH, D_MLSTM), 0.01),
        'mlstm_w_q': nrm(ks[17], (DEPTH, M_HEADS, M_DV, M_DQK), M_DV ** -0.5),
        'mlstm_w_k': nrm(ks[18], (DEPTH, M_HEADS, M_DV, M_DQK), M_DV ** -0.5),
        'mlstm_b_i': nrm(ks[19], (DEPTH, M_HEADS), 0.1),
        'mlstm_b_f': b_f,
        'mlstm_head_norm': gain(ks[21], (DEPTH, M_HEADS, M_DV)),
        's5_a_re': -0.5 + nrm(ks[22], (DEPTH, S5_GROUPS, S5_STATE), 0.01),
        's5_a_im': a_im,
        's5_log_dt': jax.random.uniform(ks[24], (DEPTH, S5_GROUPS), f32, math.log(1e-3), math.log(1e-1)),
        's5_b_re': nrm(ks[25], (DEPTH, S5_GROUPS, S5_STATE, S5_GROUP), (2 * S5_GROUP) ** -0.5),
        's5_b_im': nrm(ks[26], (DEPTH, S5_GROUPS, S5_STATE, S5_GROUP), (2 * S5_GROUP) ** -0.5),
        's5_c_re': nrm(ks[27], (DEPTH, S5_GROUPS, S5_GROUP, S5_STATE), (2 * S5_STATE) ** -0.5),
        's5_c_im': nrm(ks[28], (DEPTH, S5_GROUPS, S5_GROUP, S5_STATE), (2 * S5_STATE) ** -0.5),
        's5_d': nrm(ks[29], (DEPTH, S5_GROUPS, S5_GROUP), 1.0),
        's5_w_glu': nrm(ks[30], (DEPTH, D_S5, D_S5), D_S5 ** -0.5),
        's5_b_glu': nrm(ks[31], (DEPTH, D_S5), 0.01),
        'w_out': nrm(ks[32], (DEPTH, D_MIX, D_MODEL), D_MIX ** -0.5),
        'mix_norm_post': gain(ks[33], (DEPTH, D_MODEL)),
        'ff2_norm_pre': gain(ks[34], (DEPTH, D_MODEL)),
        'ff2_norm_post': gain(ks[35], (DEPTH, D_MODEL)),
        'ff2_w_gate': nrm(ks[36], (DEPTH, D_MODEL, D_FF), D_MODEL ** -0.5),
        'ff2_w_up': nrm(ks[37], (DEPTH, D_MODEL, D_FF), D_MODEL ** -0.5),
        'ff2_w_down': nrm(ks[38], (DEPTH, D_FF, D_MODEL), D_FF ** -0.5),
    }


def reference(x_prompt, x_sample, state_mlstm_C, state_mlstm_n, state_mlstm_m, cache_mlstm_conv,
              state_s5_re, state_s5_im, ff1_norm_pre, ff1_norm_post, ff1_w_gate, ff1_w_up, ff1_w_down,
              mix_norm_pre, w_in, mlstm_conv_w, mlstm_conv_b, mlstm_w_q, mlstm_w_k, mlstm_b_i, mlstm_b_f,
              mlstm_head_norm, s5_a_re, s5_a_im, s5_log_dt, s5_b_re, s5_b_im, s5_c_re, s5_c_im, s5_d,
              s5_w_glu, s5_b_glu, w_out, mix_norm_post, ff2_norm_pre, ff2_norm_post, ff2_w_gate, ff2_w_up,
              ff2_w_down):
    f32 = jnp.float32
    bp = x_prompt.shape[0]
    yp = x_prompt
    ys = x_sample
    new_p = []
    new_s = []
    for l in range(DEPTH):
        p = dict(ff1_norm_pre=ff1_norm_pre[l], ff1_norm_post=ff1_norm_post[l], ff1_w_gate=ff1_w_gate[l],
                 ff1_w_up=ff1_w_up[l], ff1_w_down=ff1_w_down[l], mix_norm_pre=mix_norm_pre[l], w_in=w_in[l],
                 mlstm_conv_w=mlstm_conv_w[l], mlstm_conv_b=mlstm_conv_b[l], mlstm_w_q=mlstm_w_q[l],
                 mlstm_w_k=mlstm_w_k[l], mlstm_b_i=mlstm_b_i[l], mlstm_b_f=mlstm_b_f[l],
                 mlstm_head_norm=mlstm_head_norm[l], s5_a_re=s5_a_re[l], s5_a_im=s5_a_im[l],
                 s5_log_dt=s5_log_dt[l], s5_b_re=s5_b_re[l], s5_b_im=s5_b_im[l], s5_c_re=s5_c_re[l],
                 s5_c_im=s5_c_im[l], s5_d=s5_d[l], s5_w_glu=s5_w_glu[l], s5_b_glu=s5_b_glu[l],
                 w_out=w_out[l], mix_norm_post=mix_norm_post[l], ff2_norm_pre=ff2_norm_pre[l],
                 ff2_norm_post=ff2_norm_post[l], ff2_w_gate=ff2_w_gate[l], ff2_w_up=ff2_w_up[l],
                 ff2_w_down=ff2_w_down[l])
        yp, pc, pn, pm, pconv, pre, pim = layer(
            yp,
            jnp.zeros((bp, M_HEADS, M_DQK, M_DV), f32),
            jnp.zeros((bp, M_HEADS, M_DQK), f32),
            jnp.zeros((bp, M_HEADS), f32),
            jnp.zeros((bp, CONV_W - 1, D_MLSTM), yp.dtype),
            jnp.zeros((bp, S5_GROUPS, S5_STATE), f32),
            jnp.zeros((bp, S5_GROUPS, S5_STATE), f32),
            p)
        new_p.append((pc, pn, pm, pconv, pre, pim))
        ys, sc, sn, sm, sconv, sre, sim = layer(
            ys, state_mlstm_C[l], state_mlstm_n[l], state_mlstm_m[l], cache_mlstm_conv[l],
            state_s5_re[l], state_s5_im[l], p)
        new_s.append((sc, sn, sm, sconv, sre, sim))
    c_p, n_p, m_p, conv_p, re_p, im_p = [jnp.stack([e[i] for e in new_p]) for i in range(6)]
    c_s, n_s, m_s, conv_s, re_s, im_s = [jnp.stack([e[i] for e in new_s]) for i in range(6)]
    return (yp, ys, c_p, n_p, m_p, conv_p, re_p, im_p, c_s, n_s, m_s, conv_s, re_s, im_s)
```

```cpp
#include <hip/hip_runtime.h>
#include <cstdio>
#include <cstdint>
#include <type_traits>

#define MK_ONE_LAUNCH 1
#ifndef PROBE_MASK
#define PROBE_MASK 0
#endif

#define GAS __attribute__((address_space(1)))
#define LAS __attribute__((address_space(3)))
#define CAS __attribute__((address_space(4)))
typedef unsigned short bf16;
typedef short bf16x8 __attribute__((ext_vector_type(8)));
typedef short s16x4 __attribute__((ext_vector_type(4)));
typedef float f32x4 __attribute__((ext_vector_type(4)));
typedef float f32x2 __attribute__((ext_vector_type(2)));
typedef unsigned u32x4 __attribute__((ext_vector_type(4)));
typedef unsigned u32x2 __attribute__((ext_vector_type(2)));
typedef int i32x4 __attribute__((ext_vector_type(4)));

constexpr int D = 4096, TP = 8192, T = 8448, DFF = 11008, DM = 2048, NH = 4, DV = 512, DQK = 256;
constexpr int NG = 128, NP = 64, NJ = 16;
constexpr int NSU = 48;
constexpr float EPS = 1e-6f;
constexpr int NWAVES = 8, NTHREADS = 512;

__host__ __device__ __forceinline__ int su_row0(int su) { return su < 32 ? su * 256 : TP + (su - 32) * 16; }
__host__ __device__ __forceinline__ int su_len(int su) { return su < 32 ? 256 : 16; }

constexpr size_t O_Y = 0, O_CP = 34603008, O_NP = O_CP + 524288, O_MP = O_NP + 1024, O_CONVP = O_MP + 4, O_S5REP = O_CONVP + 6144, O_S5IMP = O_S5REP + 8192,
                 O_CS = O_S5IMP + 8192, O_NS = O_CS + 8388608, O_MS = O_NS + 16384, O_CONVS = O_MS + 64, O_S5RES = O_CONVS + 98304, O_S5IMS = O_S5RES + 131072, O_END = O_S5IMS + 131072;
static_assert(O_END == 43916356, "output size");

enum { I_XP = 0, I_XS, I_SC, I_SN, I_SM, I_CONV, I_S5RE, I_S5IM, I_F1PRE, I_F1POST, I_F1G, I_F1U, I_F1D, I_MIXPRE, I_WIN, I_CONVW, I_CONVB, I_WQ, I_WK, I_BI, I_BF, I_HN,
       I_ARE, I_AIM, I_LOGDT, I_BRE, I_BIM, I_CRE, I_CIM, I_S5D, I_WGLU, I_BGLU, I_WOUT, I_MIXPOST, I_F2PRE, I_F2POST, I_F2G, I_F2U, I_F2D, N_IN };
static_assert(N_IN == 39, "inputs");

constexpr size_t al256(size_t x) { return (x + 255) & ~(size_t)255; }
constexpr size_t WS_CTL = 0, CTL_BYTES = 1u << 20;
constexpr size_t WS_W1GU = WS_CTL + CTL_BYTES;
constexpr size_t SZ_WGU = (size_t)2 * DFF * D * 2, SZ_WD = (size_t)D * DFF * 2;
constexpr size_t WS_W1D = WS_W1GU + SZ_WGU;
constexpr size_t WS_W2GU = WS_W1D + SZ_WD;
constexpr size_t WS_W2D = WS_W2GU + SZ_WGU;
constexpr size_t WS_WIN = WS_W2D + SZ_WD;
constexpr size_t WS_WQK = WS_WIN + (size_t)8448 * D * 2;
constexpr size_t WS_WGLU = WS_WQK + (size_t)4 * 512 * 512 * 2;
constexpr size_t WS_WOUT = WS_WGLU + (size_t)2048 * 2048 * 2;
constexpr size_t WS_HA = WS_WOUT + (size_t)D * D * 2;
constexpr size_t WS_HID = WS_HA + (size_t)T * D * 2;
constexpr size_t WS_PB = WS_HID, WS_CV = WS_PB + (size_t)T * 8192 * 2;
constexpr size_t WS_DBUF = WS_HID + (size_t)T * DFF * 2;
static_assert(WS_CV + (size_t)T * 2048 * 2 <= WS_DBUF, "HID alias");
constexpr size_t WS_KV = WS_DBUF, WS_C0 = WS_KV + (size_t)128 * 131072 * 4;
constexpr size_t WS_Q = WS_DBUF + (size_t)T * D * 4;
static_assert(WS_C0 + (size_t)192 * 131072 * 2 <= WS_Q, "DBUF alias");
constexpr size_t WS_K = WS_Q + (size_t)T * 1024 * 2;
constexpr size_t WS_G = WS_K + (size_t)T * 1024 * 2;
constexpr size_t WS_GATES = WS_G + (size_t)T * 2048 * 2;
constexpr size_t WS_BARR = al256(WS_GATES + (size_t)T * 8 * 4);
constexpr size_t WS_AARR = WS_BARR + (size_t)4 * T * 4;
constexpr size_t WS_MRUN = WS_AARR + (size_t)4 * T * 4;
constexpr size_t WS_SUA = WS_MRUN + (size_t)4 * T * 4;
constexpr size_t WS_SUB = WS_SUA + 1024;
constexpr size_t WS_NK = WS_SUB + 1024;
constexpr size_t WS_N0 = WS_NK + (size_t)128 * 256 * 4;
constexpr size_t WS_M0 = WS_N0 + (size_t)192 * 256 * 4;
constexpr size_t WS_S5AB = WS_M0 + 1024;
constexpr size_t WS_S5BB = WS_S5AB + (size_t)2 * 8192 * 4;
constexpr size_t WS_S5LOC = WS_S5BB + (size_t)2 * 131072 * 4;
constexpr size_t WS_S5HIN = WS_S5LOC + (size_t)2 * 32 * 8192 * 4;
constexpr size_t WS_SLAB = al256(WS_S5HIN + (size_t)2 * 32 * 8192 * 4);
constexpr size_t WS_XR = WS_SLAB + (size_t)16 * 256 * D * 4;
constexpr size_t WS_SA = WS_XR + (size_t)T * D * 2;
constexpr size_t WS_WSTAT = al256(WS_SA + (size_t)T * 256);
constexpr size_t WS_HQ = al256(WS_WSTAT + 4 * 256 * 4);
constexpr size_t WS_SA2 = al256(WS_HQ + (size_t)T * D);
constexpr size_t WS_END = WS_SA2 + (size_t)T * 256;
constexpr size_t WS_HID8 = WS_W1GU;
static_assert((size_t)T * DFF <= SZ_WGU, "HID8 alias");

constexpr int LDS_BYTES = 155648;
constexpr int LDS_MISC = 151552;

__device__ __forceinline__ float wave_sum(float v) {
#pragma unroll
    for (int o = 1; o < 64; o <<= 1) v += __shfl_xor(v, o);
    return v;
}
__device__ __forceinline__ float wave_max(float v) {
#pragma unroll
    for (int o = 1; o < 64; o <<= 1) v = fmaxf(v, __shfl_xor(v, o));
    return v;
}
__device__ __forceinline__ unsigned q8(float x) { return (unsigned)(int)fminf(fmaxf(rintf(x), -127.f), 127.f) & 0xffu; }
__device__ __forceinline__ unsigned q8x4(float a, float b, float c, float d) { return q8(a) | (q8(b) << 8) | (q8(c) << 16) | (q8(d) << 24); }
__device__ __forceinline__ unsigned cvt_pk_bf16(float lo, float hi) { unsigned r; asm volatile("v_cvt_pk_bf16_f32 %0, %1, %2" : "=v"(r) : "v"(lo), "v"(hi)); return r; }
__device__ __forceinline__ float bflo(unsigned w) { return __uint_as_float(w << 16); }
__device__ __forceinline__ float bfhi(unsigned w) { return __uint_as_float(w & 0xffff0000u); }
__device__ __forceinline__ float bf2f(bf16 v) { return __uint_as_float(((unsigned)v) << 16); }
__device__ __forceinline__ bf16 f2bf(float f) { return (bf16)(cvt_pk_bf16(f, 0.f) & 0xffffu); }
__device__ __forceinline__ float sigmoidf_(float x) { return __builtin_amdgcn_rcpf(1.0f + __builtin_amdgcn_exp2f(-1.4426950408889634f * x)); }
__device__ __forceinline__ float siluf_(float x) { return x * __builtin_amdgcn_rcpf(1.0f + __builtin_amdgcn_exp2f(-1.4426950408889634f * x)); }
__device__ __forceinline__ float gelu_tanh(float x) { const float u = -2.302208198f * (x + 0.044715f * x * x * x); return x * __builtin_amdgcn_rcpf(1.0f + __builtin_amdgcn_exp2f(u)); }
__device__ __forceinline__ float logsigmoidf_(float x) { return fminf(x, 0.f) - log1pf(__expf(-fabsf(x))); }

namespace pg8 {
typedef unsigned short bf16_t;
constexpr int BM = 256, BK = 64, HALF = 128, HTB = HALF * BK * 2, STAGE_BYTES = 8 * HTB, NXCD = 8, WGM = 8;
__host__ __device__ __forceinline__ int lds_byte(int r, int c) { const int st = (r >> 4) * 2 + (c >> 5), rr = r & 15, cc = c & 31, ob = rr * 64 + cc * 2; return st * 1024 + (ob ^ (((ob >> 9) & 1) << 5)); }
__host__ __device__ __forceinline__ void stage_rc(int b, int& R, int& C) { const int st = b / 1024, sb = b % 1024, swz = sb ^ (((sb >> 9) & 1) << 5); R = (st >> 1) * 16 + swz / 64; C = (st & 1) * 32 + (swz % 64) / 2; }
__host__ __device__ __forceinline__ int perm32(int rho) { const int n = rho >> 4, i = rho & 15; return 8 * (i >> 2) + 4 * n + (i & 3); }

struct Unit { int pm, pn, z; };
struct Gemm { const bf16_t* A; const bf16_t* Bt; int lda, ldb, K; size_t zA, zB; };

struct StaticOrder {
    int nM, nN, nZ, nwg, G, c;
    __host__ __device__ void init(int nM_, int nN_, int nZ_, int G_, int c_) { nM = nM_; nN = nN_; nZ = nZ_; nwg = nM * nN; G = G_; c = c_; }
    __host__ __device__ bool next(int i, Unit& u) const {
        const long L = (long)i * G + c; if (L >= (long)nwg * nZ) return false;
        u.z = (int)(L / nwg);
        int wgid = (int)(L % nwg); { const int q = nwg / NXCD, r = nwg % NXCD, xcd = wgid % NXCD, off = wgid / NXCD; wgid = (xcd < r ? xcd * (q + 1) : r * (q + 1) + (xcd - r) * q) + off; }
        const int nig = WGM * nN, gid = wgid / nig, fm = gid * WGM, gsz = (nM - fm) < WGM ? (nM - fm) : WGM;
        u.pm = fm + ((wgid % nig) % gsz); u.pn = (wgid % nig) / gsz; return true;
    }
    __device__ __forceinline__ void a_ready(const Unit&) const {}
    __device__ __forceinline__ void done(const Unit&) const {}
};

struct EpiF32 {
    static constexpr bool PERM = false;
    float* C; int ldc;
    __device__ __forceinline__ void operator()(const f32x4 (&acc)[2][2][4][2], const Unit& u, int wr, int wc, int fr, int fq) const {
        const int row0 = u.pm * BM + wr * 64 + fr, col0 = u.pn * BM + wc * 32 + 4 * fq;
#pragma unroll
        for (int ai = 0; ai < 2; ++ai)
#pragma unroll
            for (int m = 0; m < 4; ++m) { float* rowp = C + (size_t)(row0 + ai * HALF + m * 16) * ldc + col0;
#pragma unroll
                for (int bj = 0; bj < 2; ++bj)
#pragma unroll
                    for (int n = 0; n < 2; ++n) *(f32x4*)(rowp + bj * HALF + n * 16) = acc[ai][bj][m][n]; }
    }
};
struct EpiBf16 {
    static constexpr bool PERM = true;
    bf16_t* O; int ldc;
    __device__ __forceinline__ void operator()(const f32x4 (&acc)[2][2][4][2], const Unit& u, int wr, int wc, int fr, int fq) const {
        const int row0 = u.pm * BM + wr * 64 + fr, col0 = u.pn * BM + wc * 32 + 8 * fq;
#pragma unroll
        for (int ai = 0; ai < 2; ++ai)
#pragma unroll
            for (int m = 0; m < 4; ++m) { bf16_t* rowp = O + (size_t)(row0 + ai * HALF + m * 16) * ldc + col0;
#pragma unroll
                for (int bj = 0; bj < 2; ++bj) { const f32x4 v0 = acc[ai][bj][m][0], v1 = acc[ai][bj][m][1];
                    u32x4 w; w.x = cvt_pk_bf16(v0[0], v0[1]); w.y = cvt_pk_bf16(v0[2], v0[3]); w.z = cvt_pk_bf16(v1[0], v1[1]); w.w = cvt_pk_bf16(v1[2], v1[3]);
                    *(u32x4*)(rowp + bj * HALF) = w; } }
    }
};
struct EpiBf16S {
    static constexpr bool PERM = true;
    bf16_t* O; int ldc; const float* sa; float sw;
    __device__ __forceinline__ void operator()(const i32x4 (&acc)[2][2][4][2], const Unit& u, int wr, int wc, int fr, int fq) const {
        const int row0 = u.pm * BM + wr * 64 + fr, col0 = u.pn * BM + wc * 32 + 8 * fq;
        float s8[2][4];
#pragma unroll
        for (int ai = 0; ai < 2; ++ai)
#pragma unroll
            for (int m = 0; m < 4; ++m) s8[ai][m] = sa[(size_t)(row0 + ai * HALF + m * 16) * 64] * sw;
#pragma unroll
        for (int ai = 0; ai < 2; ++ai)
#pragma unroll
            for (int m = 0; m < 4; ++m) { bf16_t* rowp = O + (size_t)(row0 + ai * HALF + m * 16) * ldc + col0; const float s = s8[ai][m];
#pragma unroll
                for (int bj = 0; bj < 2; ++bj) { const i32x4 v0 = acc[ai][bj][m][0], v1 = acc[ai][bj][m][1];
                    u32x4 w; w.x = cvt_pk_bf16((float)v0[0] * s, (float)v0[1] * s); w.y = cvt_pk_bf16((float)v0[2] * s, (float)v0[3] * s); w.z = cvt_pk_bf16((float)v1[0] * s, (float)v1[1] * s); w.w = cvt_pk_bf16((float)v1[2] * s, (float)v1[3] * s);
                    *(u32x4*)(rowp + bj * HALF) = w; } }
    }
};
struct EpiF32S {
    static constexpr bool PERM = false;
    float* C; int ldc; const float* sa; float sw;
    __device__ __forceinline__ void operator()(const i32x4 (&acc)[2][2][4][2], const Unit& u, int wr, int wc, int fr, int fq) const {
        const int row0 = u.pm * BM + wr * 64 + fr, col0 = u.pn * BM + wc * 32 + 4 * fq;
        float s8[2][4];
#pragma unroll
        for (int ai = 0; ai < 2; ++ai)
#pragma unroll
            for (int m = 0; m < 4; ++m) s8[ai][m] = sa[(size_t)(row0 + ai * HALF + m * 16) * 64] * sw;
#pragma unroll
        for (int ai = 0; ai < 2; ++ai)
#pragma unroll
            for (int m = 0; m < 4; ++m) { float* rowp = C + (size_t)(row0 + ai * HALF + m * 16) * ldc + col0; const float s = s8[ai][m];
#pragma unroll
                for (int bj = 0; bj < 2; ++bj)
#pragma unroll
                    for (int n = 0; n < 2; ++n) { const i32x4 v = acc[ai][bj][m][n]; *(f32x4*)(rowp + bj * HALF + n * 16) = (f32x4){(float)v[0] * s, (float)v[1] * s, (float)v[2] * s, (float)v[3] * s}; } }
    }
};
struct OneUnit {
    int pn;
    __device__ __forceinline__ bool next(int i, Unit& u) const { if (i) return false; u.pm = 0; u.pn = pn; u.z = 0; return true; }
    __device__ __forceinline__ void a_ready(const Unit&) const {}
    __device__ __forceinline__ void done(const Unit&) const {}
};
struct EpiF32Atomic {
    static constexpr bool PERM = false;
    float* C; int ldc;
    __device__ __forceinline__ void operator()(const f32x4 (&acc)[2][2][4][2], const Unit& u, int wr, int wc, int fr, int fq) const {
        const int row0 = u.pm * BM + wr * 64 + fr, col0 = u.pn * BM + wc * 32 + 4 * fq;
#pragma unroll
        for (int ai = 0; ai < 2; ++ai)
#pragma unroll
            for (int m = 0; m < 4; ++m) { float* rowp = C + (size_t)(row0 + ai * HALF + m * 16) * ldc + col0;
#pragma unroll
                for (int bj = 0; bj < 2; ++bj)
#pragma unroll
                    for (int n = 0; n < 2; ++n) { float* p = rowp + bj * HALF + n * 16; const f32x4 v = acc[ai][bj][m][n];
                        unsafeAtomicAdd(p, v[0]); unsafeAtomicAdd(p + 1, v[1]); unsafeAtomicAdd(p + 2, v[2]); unsafeAtomicAdd(p + 3, v[3]); } }
    }
};
struct EpiSwiGLU {
    static constexpr bool PERM = true;
    bf16_t* O; int ldc;
    __device__ __forceinline__ void operator()(const f32x4 (&acc)[2][2][4][2], const Unit& u, int wr, int wc, int fr, int fq) const {
        const int row0 = u.pm * BM + wr * 64 + fr, col0 = u.pn * HALF + wc * 32 + 8 * fq;
#pragma unroll
        for (int ai = 0; ai < 2; ++ai)
#pragma unroll
            for (int m = 0; m < 4; ++m) { bf16_t* rowp = O + (size_t)(row0 + ai * HALF + m * 16) * ldc + col0;
                const f32x4 g0 = acc[ai][0][m][0], g1 = acc[ai][0][m][1], u0 = acc[ai][1][m][0], u1 = acc[ai][1][m][1];
                float h[8];
#pragma unroll
                for (int j = 0; j < 4; ++j) { h[j] = siluf_(g0[j]) * u0[j]; h[4 + j] = siluf_(g1[j]) * u1[j]; }
                u32x4 w; w.x = cvt_pk_bf16(h[0], h[1]); w.y = cvt_pk_bf16(h[2], h[3]); w.z = cvt_pk_bf16(h[4], h[5]); w.w = cvt_pk_bf16(h[6], h[7]);
                *(u32x4*)rowp = w; }
    }
};
struct EpiSwiGLU8 {
    static constexpr bool PERM = true;
    bf16_t* O; int ldc; const float* sa; float swg, swu;
    __device__ __forceinline__ void operator()(const i32x4 (&acc)[2][2][4][2], const Unit& u, int wr, int wc, int fr, int fq) const {
        const int row0 = u.pm * BM + wr * 64 + fr, col0 = u.pn * HALF + wc * 32 + 8 * fq;
        float s8[2][4];
#pragma unroll
        for (int ai = 0; ai < 2; ++ai)
#pragma unroll
            for (int m = 0; m < 4; ++m) s8[ai][m] = sa[(size_t)(row0 + ai * HALF + m * 16) * 64];
#pragma unroll
        for (int ai = 0; ai < 2; ++ai)
#pragma unroll
            for (int m = 0; m < 4; ++m) { const int row = row0 + ai * HALF + m * 16; bf16_t* rowp = O + (size_t)row * ldc + col0;
                const float s = s8[ai][m], sg = s * swg, su = s * swu;
                const i32x4 g0 = acc[ai][0][m][0], g1 = acc[ai][0][m][1], u0 = acc[ai][1][m][0], u1 = acc[ai][1][m][1];
                float h[8];
#pragma unroll
                for (int j = 0; j < 4; ++j) { h[j] = siluf_((float)g0[j] * sg) * ((float)u0[j] * su); h[4 + j] = siluf_((float)g1[j] * sg) * ((float)u1[j] * su); }
                u32x4 w; w.x = cvt_pk_bf16(h[0], h[1]); w.y = cvt_pk_bf16(h[2], h[3]); w.z = cvt_pk_bf16(h[4], h[5]); w.w = cvt_pk_bf16(h[6], h[7]);
                *(u32x4*)rowp = w; }
    }
};
struct EpiWin {
    static constexpr bool PERM = true;
    bf16_t* PB; float* GATES;
    __device__ __forceinline__ void operator()(const f32x4 (&acc)[2][2][4][2], const Unit& u, int wr, int wc, int fr, int fq) const {
        const int row0 = u.pm * BM + wr * 64 + fr;
        if (u.pn < 32) {
            const int col0 = u.pn * BM + wc * 32 + 8 * fq;
#pragma unroll
            for (int ai = 0; ai < 2; ++ai)
#pragma unroll
                for (int m = 0; m < 4; ++m) { bf16_t* rowp = PB + (size_t)(row0 + ai * HALF + m * 16) * 8192 + col0;
#pragma unroll
                    for (int bj = 0; bj < 2; ++bj) { const f32x4 v0 = acc[ai][bj][m][0], v1 = acc[ai][bj][m][1];
                        u32x4 w; w.x = cvt_pk_bf16(v0[0], v0[1]); w.y = cvt_pk_bf16(v0[2], v0[3]); w.z = cvt_pk_bf16(v1[0], v1[1]); w.w = cvt_pk_bf16(v1[2], v1[3]);
                        *(u32x4*)(rowp + bj * HALF) = w; } }
        } else if (wc == 0 && fq == 0) {
#pragma unroll
            for (int ai = 0; ai < 2; ++ai)
#pragma unroll
                for (int m = 0; m < 4; ++m) { float* gp = GATES + (size_t)(row0 + ai * HALF + m * 16) * 8;
                    *(f32x4*)gp = acc[ai][0][m][0]; *(f32x4*)(gp + 4) = acc[ai][0][m][1]; }
        }
    }
};
struct EpiQK {
    static constexpr bool PERM = true;
    bf16_t* Q; bf16_t* Kd;
    __device__ __forceinline__ void operator()(const f32x4 (&acc)[2][2][4][2], const Unit& u, int wr, int wc, int fr, int fq) const {
        const int row0 = u.pm * BM + wr * 64 + fr, col0 = u.z * 256 + wc * 32 + 8 * fq; bf16_t* base = u.pn ? Kd : Q;
#pragma unroll
        for (int ai = 0; ai < 2; ++ai)
#pragma unroll
            for (int m = 0; m < 4; ++m) { bf16_t* rowp = base + (size_t)(row0 + ai * HALF + m * 16) * 1024 + col0;
#pragma unroll
                for (int bj = 0; bj < 2; ++bj) { const f32x4 v0 = acc[ai][bj][m][0], v1 = acc[ai][bj][m][1];
                    u32x4 w; w.x = cvt_pk_bf16(v0[0], v0[1]); w.y = cvt_pk_bf16(v0[2], v0[3]); w.z = cvt_pk_bf16(v1[0], v1[1]); w.w = cvt_pk_bf16(v1[2], v1[3]);
                    *(u32x4*)(rowp + bj * HALF) = w; } }
    }
};
struct EpiGLU {
    static constexpr bool PERM = true;
    const bf16_t* Gb; const float* bias; bf16_t* MIX;
    __device__ __forceinline__ void operator()(const f32x4 (&acc)[2][2][4][2], const Unit& u, int wr, int wc, int fr, int fq) const {
        const int row0 = u.pm * BM + wr * 64 + fr, col0 = u.pn * BM + wc * 32 + 8 * fq;
        f32x4 bv[2][2];
#pragma unroll
        for (int bj = 0; bj < 2; ++bj)
#pragma unroll
            for (int n = 0; n < 2; ++n) bv[bj][n] = *(const f32x4*)(bias + col0 + bj * HALF + 4 * n);
#pragma unroll
        for (int ai = 0; ai < 2; ++ai) {
            u32x4 gws[4][2];
#pragma unroll
            for (int m = 0; m < 4; ++m)
#pragma unroll
                for (int bj = 0; bj < 2; ++bj) gws[m][bj] = *(const u32x4*)(Gb + (size_t)(row0 + ai * HALF + m * 16) * 2048 + col0 + bj * HALF);
#pragma unroll
            for (int m = 0; m < 4; ++m) { const size_t row = (size_t)(row0 + ai * HALF + m * 16);
#pragma unroll
                for (int bj = 0; bj < 2; ++bj) { const f32x4 v0 = acc[ai][bj][m][0] + bv[bj][0], v1 = acc[ai][bj][m][1] + bv[bj][1];
                    const u32x4 gw = gws[m][bj];
                    float o[8];
                    o[0] = bflo(gw.x) * sigmoidf_(v0[0]); o[1] = bfhi(gw.x) * sigmoidf_(v0[1]); o[2] = bflo(gw.y) * sigmoidf_(v0[2]); o[3] = bfhi(gw.y) * sigmoidf_(v0[3]);
                    o[4] = bflo(gw.z) * sigmoidf_(v1[0]); o[5] = bfhi(gw.z) * sigmoidf_(v1[1]); o[6] = bflo(gw.w) * sigmoidf_(v1[2]); o[7] = bfhi(gw.w) * sigmoidf_(v1[3]);
                    u32x4 w; w.x = cvt_pk_bf16(o[0], o[1]); w.y = cvt_pk_bf16(o[2], o[3]); w.z = cvt_pk_bf16(o[4], o[5]); w.w = cvt_pk_bf16(o[6], o[7]);
                    *(u32x4*)(MIX + row * 4096 + 2048 + col0 + bj * HALF) = w; } } }
    }
};

template <class Epi, class Sched, bool ALIGN_EPI = false, bool SP2 = false, bool PFB = false, bool I8 = false>
__device__ __forceinline__ void gemm_phase(LAS unsigned char* lds, const Gemm g, const Sched& S, const Epi& E) {
    int tid = threadIdx.x; asm volatile("" : "+v"(tid));
    const int wid = __builtin_amdgcn_readfirstlane(tid >> 6), lane = tid & 63, wr = wid >> 2, wc = wid & 3, fr = lane & 15, fq = lane >> 4;
    const int K = g.K, nt = K / BK;
    unsigned voffA[2], voffB[2];
#pragma unroll
    for (int i = 0; i < 2; ++i) { int R, C; stage_rc(tid * 16 + i * 8192, R, C); const int Rb = Epi::PERM ? ((R & ~31) + perm32(R & 31)) : R;
        voffA[i] = (unsigned)(R * g.lda + C) * 2u; voffB[i] = (unsigned)(Rb * g.ldb + C) * 2u; }
    const size_t kstep = (size_t)(BK * 2);
    const size_t hstepA = (size_t)HALF * g.lda * 2, hstepB = (size_t)HALF * g.ldb * 2;
    const unsigned ldsw = (unsigned)wid * 1024u;
    const int aoff = lds_byte(wr * 64 + fr, fq * 8), boff = lds_byte(wc * 32 + fr, fq * 8);
#define PG8_SA(b, h) (((b) * 2 + (h)) * HTB)
#define PG8_SB(b, h) ((4 + (b) * 2 + (h)) * HTB)
#define PG8_STAGE(bufoff, gbase, voff) do { _Pragma("unroll") for (int _i = 0; _i < 2; ++_i) \
        __builtin_amdgcn_global_load_lds((const unsigned*)((const char*)(gbase) + (voff)[_i]), (LAS unsigned*)(lds + (bufoff) + ldsw + _i * 8192), 16, 0, 0); } while (0)
#define PG8_LDA(dst, b, h) do { _Pragma("unroll") for (int m = 0; m < 4; ++m) _Pragma("unroll") for (int k = 0; k < 2; ++k) dst[m][k] = *(const LAS bf16x8*)(lds + PG8_SA(b, h) + aoff + m * 2048 + k * 1024); } while (0)
#define PG8_LDB(dst, b, h) do { _Pragma("unroll") for (int n = 0; n < 2; ++n) _Pragma("unroll") for (int k = 0; k < 2; ++k) dst[n][k] = *(const LAS bf16x8*)(lds + PG8_SB(b, h) + boff + n * 2048 + k * 1024); } while (0)
#define PG8_MMA(ai, bj, At, Bt) do { __builtin_amdgcn_s_setprio(1); _Pragma("unroll") for (int m = 0; m < 4; ++m) _Pragma("unroll") for (int n = 0; n < 2; ++n) _Pragma("unroll") for (int k = 0; k < 2; ++k) { \
        if constexpr (I8) acc[ai][bj][m][n] = __builtin_bit_cast(AccT, __builtin_amdgcn_mfma_i32_16x16x64_i8(__builtin_bit_cast(i32x4, Bt[n][k]), __builtin_bit_cast(i32x4, At[m][k]), __builtin_bit_cast(i32x4, acc[ai][bj][m][n]), 0, 0, 0)); \
        else acc[ai][bj][m][n] = __builtin_bit_cast(AccT, __builtin_amdgcn_mfma_f32_16x16x32_bf16(Bt[n][k], At[m][k], __builtin_bit_cast(f32x4, acc[ai][bj][m][n]), 0, 0, 0)); } __builtin_amdgcn_s_setprio(0); } while (0)
#define PG8_WAIT_V(n) asm volatile("s_waitcnt vmcnt(" #n ")" ::: "memory")
#define PG8_WAIT_L(n) asm volatile("s_waitcnt lgkmcnt(" #n ")" ::: "memory")
#define PG8_BAR __builtin_amdgcn_s_barrier()
#define PG8_SCHED __builtin_amdgcn_sched_barrier(0)
    Unit cur, nxt; int ui = 0;
    if (!S.next(0, cur)) return;
    typedef typename std::conditional<I8, i32x4, f32x4>::type AccT;
    AccT acc[2][2][4][2];
#pragma unroll
    for (int a = 0; a < 2; ++a)
#pragma unroll
        for (int b = 0; b < 2; ++b)
#pragma unroll
            for (int m = 0; m < 4; ++m)
#pragma unroll
                for (int n = 0; n < 2; ++n) acc[a][b][m][n] = AccT{};
    bf16x8 At[4][2], B0[2][2], B1[2][2];
    const char* cA = (const char*)(g.A + (size_t)cur.pm * BM * g.lda + (size_t)cur.z * g.zA);
    const char* cB = (const char*)(g.Bt + (size_t)cur.pn * BM * g.ldb + (size_t)cur.z * g.zB);
    S.a_ready(cur);
    if constexpr (SP2) {
        PG8_STAGE(PG8_SB(0, 0), cB, voffB); PG8_STAGE(PG8_SB(0, 1), cB + hstepB, voffB); PG8_STAGE(PG8_SA(0, 0), cA, voffA); PG8_STAGE(PG8_SA(0, 1), cA + hstepA, voffA);
        if (wr == 1) PG8_BAR;
        PG8_WAIT_V(2); PG8_BAR;
        PG8_STAGE(PG8_SB(1, 0), cB + kstep, voffB); PG8_STAGE(PG8_SA(1, 0), cA + kstep, voffA); PG8_STAGE(PG8_SB(1, 1), cB + hstepB + kstep, voffB);
        PG8_WAIT_V(6); PG8_BAR;
    } else {
        PG8_STAGE(PG8_SB(0, 0), cB, voffB); PG8_STAGE(PG8_SA(0, 0), cA, voffA); PG8_STAGE(PG8_SB(0, 1), cB + hstepB, voffB); PG8_STAGE(PG8_SA(0, 1), cA + hstepA, voffA);
        if (wr == 1) PG8_BAR;
        PG8_WAIT_V(4); PG8_BAR;
        PG8_STAGE(PG8_SB(1, 0), cB + kstep, voffB); PG8_STAGE(PG8_SA(1, 0), cA + kstep, voffA); PG8_STAGE(PG8_SB(1, 1), cB + hstepB + kstep, voffB);
        PG8_WAIT_V(6); PG8_BAR;
    }
    for (;;) {
        const bool has_next = S.next(ui + 1, nxt);
        const char* nA = has_next ? (const char*)(g.A + (size_t)nxt.pm * BM * g.lda + (size_t)nxt.z * g.zA) : cA;
        const char* nB = has_next ? (const char*)(g.Bt + (size_t)nxt.pn * BM * g.ldb + (size_t)nxt.z * g.zB) : cB;
        for (int t = 0; t < nt; t += 2) {
            const bool last = (t == nt - 2);
            const char* a1 = cA + (size_t)(t + 1) * kstep;
            const char* a2 = last ? nA : cA + (size_t)(t + 2) * kstep; const char* b2 = last ? nB : cB + (size_t)(t + 2) * kstep;
            const char* a3 = a2 + kstep; const char* b3 = b2 + kstep;
            if (last && has_next) S.a_ready(nxt);
            if constexpr (SP2) {
            PG8_LDB(B0, 0, 0); PG8_LDB(B1, 0, 1); PG8_SCHED; PG8_LDA(At, 0, 0); PG8_STAGE(PG8_SA(1, 1), a1 + hstepA, voffA);
            PG8_WAIT_V(8); PG8_WAIT_L(0); PG8_BAR; PG8_MMA(0, 0, At, B0); PG8_MMA(0, 1, At, B1); PG8_BAR; PG8_SCHED;
            PG8_LDA(At, 0, 1); PG8_STAGE(PG8_SB(0, 0), b2, voffB); PG8_STAGE(PG8_SB(0, 1), b2 + hstepB, voffB); PG8_STAGE(PG8_SA(0, 0), a2, voffA);
            PG8_WAIT_V(8); PG8_WAIT_L(0); PG8_BAR; PG8_MMA(1, 0, At, B0); PG8_MMA(1, 1, At, B1); PG8_BAR; PG8_SCHED;
            PG8_LDB(B0, 1, 0); PG8_LDB(B1, 1, 1); PG8_SCHED; PG8_LDA(At, 1, 0); PG8_STAGE(PG8_SA(0, 1), a2 + hstepA, voffA);
            PG8_WAIT_V(8); PG8_WAIT_L(0); PG8_BAR; PG8_MMA(0, 0, At, B0); PG8_MMA(0, 1, At, B1); PG8_BAR; PG8_SCHED;
            PG8_LDA(At, 1, 1); PG8_STAGE(PG8_SB(1, 0), b3, voffB); PG8_STAGE(PG8_SB(1, 1), b3 + hstepB, voffB); PG8_STAGE(PG8_SA(1, 0), a3, voffA);
            PG8_WAIT_V(8); PG8_WAIT_L(0); PG8_BAR; PG8_MMA(1, 0, At, B0); PG8_MMA(1, 1, At, B1); PG8_BAR; PG8_SCHED;
            } else {
            PG8_LDB(B0, 0, 0); PG8_SCHED; PG8_LDA(At, 0, 0); PG8_STAGE(PG8_SA(1, 1), a1 + hstepA, voffA);
            PG8_WAIT_L(8); PG8_BAR; PG8_WAIT_L(0); PG8_MMA(0, 0, At, B0); PG8_BAR; PG8_SCHED;
            PG8_LDB(B1, 0, 1); PG8_STAGE(PG8_SB(0, 0), b2, voffB);
            PG8_BAR; PG8_WAIT_L(0); PG8_MMA(0, 1, At, B1); PG8_BAR;
            PG8_LDA(At, 0, 1); PG8_STAGE(PG8_SA(0, 0), a2, voffA);
            PG8_BAR; PG8_WAIT_L(0); PG8_MMA(1, 0, At, B0); PG8_BAR; PG8_SCHED;
            PG8_STAGE(PG8_SB(0, 1), b2 + hstepB, voffB);
            PG8_WAIT_V(6); PG8_BAR; PG8_MMA(1, 1, At, B1); PG8_BAR;
            PG8_LDB(B0, 1, 0); PG8_SCHED; PG8_LDA(At, 1, 0); PG8_STAGE(PG8_SA(0, 1), a2 + hstepA, voffA);
            PG8_WAIT_L(8); PG8_BAR; PG8_WAIT_L(0); PG8_MMA(0, 0, At, B0); PG8_BAR; PG8_SCHED;
            PG8_LDB(B1, 1, 1); PG8_STAGE(PG8_SB(1, 0), b3, voffB);
            PG8_BAR; PG8_WAIT_L(0); PG8_MMA(0, 1, At, B1); PG8_BAR;
            PG8_LDA(At, 1, 1); PG8_STAGE(PG8_SA(1, 0), a3, voffA);
            PG8_BAR; PG8_WAIT_L(0); PG8_MMA(1, 0, At, B0); PG8_BAR; PG8_SCHED;
            PG8_STAGE(PG8_SB(1, 1), b3 + hstepB, voffB);
            PG8_WAIT_V(6); PG8_BAR; PG8_MMA(1, 1, At, B1); PG8_BAR;
            }
        }
        if constexpr (ALIGN_EPI) { if (wr == 0) PG8_BAR; }
        E(acc, cur, wr, wc, fr, fq); S.done(cur);
        if (!has_next) break;
        if constexpr (PFB) {
            const char* pb = nB + (size_t)((nxt.pm & 7) * 32 + wid * 4) * g.ldb * 2 + lane * 128;
#pragma unroll
            for (int r = 0; r < 4; ++r) __builtin_amdgcn_global_load_lds((const unsigned*)(pb + (size_t)r * g.ldb * 2), (LAS unsigned*)(lds + STAGE_BYTES + wid * 256), 4, 0, 0);
        }
#pragma unroll
        for (int a = 0; a < 2; ++a)
#pragma unroll
            for (int b = 0; b < 2; ++b)
#pragma unroll
                for (int m = 0; m < 4; ++m)
#pragma unroll
                    for (int n = 0; n < 2; ++n) acc[a][b][m][n] = AccT{};
        cur = nxt; cA = nA; cB = nB; ++ui;
        if constexpr (ALIGN_EPI) { if (wr == 1) PG8_BAR; }
    }
    PG8_WAIT_V(0);
    if constexpr (!ALIGN_EPI) { if (wr == 0) PG8_BAR; }
    PG8_BAR;
#undef PG8_SA
#undef PG8_SB
#undef PG8_STAGE
#undef PG8_LDA
#undef PG8_LDB
#undef PG8_MMA
#undef PG8_WAIT_V
#undef PG8_WAIT_L
#undef PG8_BAR
#undef PG8_SCHED
}
}

#define XB_TMO      128
#define XB_XCNT(j)  (256  + 64 * (j))
#define XB_XSUB(j)  (1280 + 64 * (j))
#define XB_XGEN(j)  (2304 + 64 * (j))
#define XB_TOP      3328
#define XB_TOPGEN   3392
#define XCD_BAR_WORDS 3456
#define XB_SPIN_CAP (1u << 18)
__device__ __forceinline__ unsigned xb_ld(unsigned* p)              { return __hip_atomic_load(p, __ATOMIC_RELAXED, __HIP_MEMORY_SCOPE_AGENT); }
__device__ __forceinline__ unsigned xb_add(unsigned* p, unsigned v) { return __hip_atomic_fetch_add(p, v, __ATOMIC_RELAXED, __HIP_MEMORY_SCOPE_AGENT); }
__device__ __forceinline__ unsigned xb_xcc_id() { return (unsigned)__builtin_amdgcn_s_getreg((3 << 11) | 20) & 0xFu; }
#define XB_SPIN(cond, bar) do { unsigned _sp = 0; while (cond) { __builtin_amdgcn_s_sleep(1); \
    if ((++_sp & 255u) == 0u) { if (xb_ld(&(bar)[XB_TMO])) break; if (_sp > XB_SPIN_CAP) { atomicAdd(&(bar)[XB_TMO], 1u); break; } } } } while (0)
struct XcdBarrier { unsigned* bar; unsigned x; volatile LAS unsigned* st; };
__device__ __forceinline__ XcdBarrier xcd_barrier_post(unsigned* bar, volatile LAS unsigned* st) {
    XcdBarrier b; b.bar = bar; b.x = xb_xcc_id(); b.st = st;
    if (threadIdx.x == 0) (void)xb_add(&bar[XB_XCNT(b.x)], 1u);
    return b;
}
__device__ __forceinline__ void xcd_barrier_complete(unsigned* bar, unsigned x, unsigned& nloc, unsigned& nx) {
    const unsigned G = gridDim.x * gridDim.y * gridDim.z;
    unsigned sum, cnt, mine, sp = 0u;
    for (;;) {
        sum = 0u; cnt = 0u; mine = 0u;
#pragma unroll
        for (unsigned j = 0; j < 16; ++j) { const unsigned c = xb_ld(&bar[XB_XCNT(j)]); sum += c; cnt += (c > 0u) ? 1u : 0u; mine = (j == x) ? c : mine; }
        if (sum == G) break;
        __builtin_amdgcn_s_sleep(1);
        if ((++sp & 255u) == 0u) { if (xb_ld(&bar[XB_TMO])) break; if (sp > XB_SPIN_CAP) { atomicAdd(&bar[XB_TMO], 1u); break; } }
    }
    nloc = mine > 0u ? mine : 1u; nx = cnt > 0u ? cnt : 1u;
}
__device__ __forceinline__ void xcd_barrier(const XcdBarrier& b) {
    asm volatile("s_waitcnt vmcnt(0)" ::: "memory");
    __syncthreads();
    if (threadIdx.x == 0) {
        unsigned* bar = b.bar;
        __builtin_amdgcn_s_waitcnt(0);
        unsigned nloc = b.st[0], nx = b.st[1];
        if (nloc == 0u) { xcd_barrier_complete(bar, b.x, nloc, nx); b.st[0] = nloc; b.st[1] = nx; }
        const unsigned old = xb_add(&bar[XB_XSUB(b.x)], 1u);
        const unsigned gen = old / nloc;
        if (old + 1u == (gen + 1u) * nloc) {
            __builtin_amdgcn_fence(__ATOMIC_RELEASE, "agent");
            asm volatile("s_waitcnt vmcnt(0)" ::: "memory");
            const unsigned og = xb_add(&bar[XB_TOP], 1u);
            const unsigned tg = og / nx;
            if (og + 1u == (tg + 1u) * nx) xb_add(&bar[XB_TOPGEN], 1u);
            else XB_SPIN(xb_ld(&bar[XB_TOPGEN]) == tg, bar);
            __builtin_amdgcn_fence(__ATOMIC_ACQUIRE, "agent");
            xb_add(&bar[XB_XGEN(b.x)], 1u);
            asm volatile("s_waitcnt vmcnt(0)" ::: "memory");
        } else {
            XB_SPIN(xb_ld(&bar[XB_XGEN(b.x)]) == gen, bar);
            __builtin_amdgcn_fence(__ATOMIC_ACQUIRE, "agent");
            asm volatile("s_waitcnt vmcnt(0)" ::: "memory");
        }
    }
    __syncthreads();
}

struct Args { const float* in[N_IN]; float* out; unsigned char* ws; int ph_lo, ph_hi; };
static_assert(sizeof(Args) == (N_IN + 2) * 8 + 8, "Args has no padding holes");

struct Frame {
    LAS unsigned char* lds;
    int tid, lane, wave, G, vcu, pp;
    const float* const* in; float* out; unsigned char* ws;
};
#define WSP(type, off) ((type*)(F.ws + (off)))

constexpr int SCR_STRIDE = 16896;
struct CvtItem { const float* W; void* WT; int ldw, k0, n0, ldk, drow0, q8; float scale; };
__device__ __forceinline__ void cvt_load(const CvtItem& c, int lane, f32x4 (&v)[16]) {
    const int rr = c.q8 ? lane >> 3 : lane >> 4, cc = c.q8 ? lane & 7 : lane & 15;
    const float* src = c.W + (size_t)(c.k0 + rr) * c.ldw + c.n0 + 4 * cc; const size_t step = (size_t)(c.q8 ? 8 : 4) * c.ldw;
#pragma unroll
    for (int i = 0; i < 16; ++i) v[i] = __builtin_nontemporal_load((const f32x4*)(src + i * step));
}
__device__ __forceinline__ void cvt_finish(const CvtItem& c, int lane, const f32x4 (&v)[16], LAS float* scr) {
    const float scale = c.scale; const int cl = lane & 7;
    if (!c.q8) {
        { const int r4 = lane >> 4, c16 = lane & 15;
#pragma unroll
          for (int i = 0; i < 16; ++i) { LAS float* d = scr + (4 * i + r4) * 65 + 4 * c16; d[0] = v[i].x; d[1] = v[i].y; d[2] = v[i].z; d[3] = v[i].w; } }
        asm volatile("s_waitcnt lgkmcnt(0)" ::: "memory");
        bf16* WT = (bf16*)c.WT;
#pragma unroll
        for (int j = 0; j < 8; ++j) { const int n = (lane >> 3) + 8 * j; const LAS float* s = scr + (8 * cl) * 65 + n;
            u32x4 o; o.x = cvt_pk_bf16(s[0 * 65] * scale, s[1 * 65] * scale); o.y = cvt_pk_bf16(s[2 * 65] * scale, s[3 * 65] * scale);
            o.z = cvt_pk_bf16(s[4 * 65] * scale, s[5 * 65] * scale); o.w = cvt_pk_bf16(s[6 * 65] * scale, s[7 * 65] * scale);
            *(u32x4*)(WT + (size_t)(c.drow0 + n) * c.ldk + c.k0 + 8 * cl) = o; }
    } else {
        { const int r8 = lane >> 3, c8 = lane & 7;
#pragma unroll
          for (int i = 0; i < 16; ++i) { LAS float* d = scr + (8 * i + r8) * 33 + 4 * c8; d[0] = v[i].x; d[1] = v[i].y; d[2] = v[i].z; d[3] = v[i].w; } }
        asm volatile("s_waitcnt lgkmcnt(0)" ::: "memory");
        signed char* WT8 = (signed char*)c.WT;
#pragma unroll
        for (int j = 0; j < 4; ++j) { const int n = (lane >> 3) + 8 * j; const LAS float* s = scr + (16 * cl) * 33 + n;
            u32x4 o; o.x = q8x4(s[0 * 33] * scale, s[1 * 33] * scale, s[2 * 33] * scale, s[3 * 33] * scale); o.y = q8x4(s[4 * 33] * scale, s[5 * 33] * scale, s[6 * 33] * scale, s[7 * 33] * scale);
            o.z = q8x4(s[8 * 33] * scale, s[9 * 33] * scale, s[10 * 33] * scale, s[11 * 33] * scale); o.w = q8x4(s[12 * 33] * scale, s[13 * 33] * scale, s[14 * 33] * scale, s[15 * 33] * scale);
            *(u32x4*)(WT8 + (size_t)(c.drow0 + n) * c.ldk + c.k0 + 16 * cl) = o; }
    }
    asm volatile("s_waitcnt lgkmcnt(0)" ::: "memory");
}
__device__ __forceinline__ float wscale(Frame& F, int t) { return ((volatile LAS float*)(F.lds + LDS_MISC))[64 + t]; }
__device__ __forceinline__ void p0_stats(Frame& F) {
    LAS float* red = (LAS float*)F.lds;
#pragma unroll
    for (int t = 2; t < 5; ++t) {
        const float* W = F.in[t == 2 ? I_F2G : t == 3 ? I_F2U : I_F2D]; float s = 0.f;
        for (int i = F.tid; i < DFF / 4; i += NTHREADS) {
            const f32x4 v = (t < 4) ? *(const f32x4*)(W + (size_t)2048 * DFF + 4 * i) : *(const f32x4*)(W + (size_t)(4000 + 1000 * (i / 1024)) * D + 4 * (i % 1024)); s += (v.x * v.x + v.y * v.y) + (v.z * v.z + v.w * v.w); }
        s = wave_sum(s);
        __syncthreads();
        if (F.lane == 0) red[F.wave] = s;
        __syncthreads();
        if (F.tid == 0) { const float tot = ((red[0] + red[1]) + (red[2] + red[3])) + ((red[4] + red[5]) + (red[6] + red[7]));
            ((volatile LAS float*)(F.lds + LDS_MISC))[64 + t] = 6.0f * sqrtf(tot * (1.0f / DFF)) * (1.0f / 127.0f); }
    }
    __syncthreads();
}
__device__ __forceinline__ void rms_row_to_i8(const float* xrow, const float* gain, signed char* qrow, float* sa, int lane) {
    const f32x4* xr = (const f32x4*)xrow + lane; const f32x4* gr = (const f32x4*)gain + lane;
    f32x4 v[16]; float s = 0.f;
#pragma unroll
    for (int j = 0; j < 16; ++j) { v[j] = xr[64 * j]; s += (v[j].x * v[j].x + v[j].y * v[j].y) + (v[j].z * v[j].z + v[j].w * v[j].w); }
    const float r = rsqrtf(wave_sum(s) * (1.f / D) + EPS); float am = 0.f;
#pragma unroll
    for (int j = 0; j < 16; ++j) { const f32x4 gg = gr[64 * j]; v[j] = v[j] * r * gg; am = fmaxf(fmaxf(am, fmaxf(fabsf(v[j].x), fabsf(v[j].y))), fmaxf(fabsf(v[j].z), fabsf(v[j].w))); }
    am = fmaxf(wave_max(am), 1e-20f); const float inv = 127.0f / am;
    unsigned* o4 = (unsigned*)qrow + lane;
#pragma unroll
    for (int j = 0; j < 16; ++j) o4[64 * j] = q8x4(v[j].x * inv, v[j].y * inv, v[j].z * inv, v[j].w * inv);
    if (lane == 0) *sa = am * (1.0f / 127.0f);
}
__device__ __forceinline__ void rms_row_to_bf16(const float* xrow, const float* gain, bf16* orow, int lane) {
    const f32x4* xr = (const f32x4*)xrow + lane; const f32x4* gr = (const f32x4*)gain + lane;
    f32x4 v[16]; float s = 0.f;
#pragma unroll
    for (int j = 0; j < 16; ++j) { v[j] = xr[64 * j]; s += (v[j].x * v[j].x + v[j].y * v[j].y) + (v[j].z * v[j].z + v[j].w * v[j].w); }
    const float r = rsqrtf(wave_sum(s) * (1.f / D) + EPS);
    u32x2* o8 = (u32x2*)orow + lane;
#pragma unroll
    for (int j = 0; j < 16; ++j) { const f32x4 gg = gr[64 * j]; u32x2 w; w.x = cvt_pk_bf16(v[j].x * r * gg.x, v[j].y * r * gg.y); w.y = cvt_pk_bf16(v[j].z * r * gg.z, v[j].w * r * gg.w); o8[64 * j] = w; }
}
__device__ __forceinline__ void sincos_d(double x, double& s, double& c) {
    const double n = rint(x * 0.63661977236758134308);
    const double r = (x - n * 1.5707963267948966192) - n * 6.123233995736766036e-17;
    const double r2 = r * r;
    const double sn = r * (1.0 + r2 * (-1.0 / 6 + r2 * (1.0 / 120 + r2 * (-1.0 / 5040 + r2 * (1.0 / 362880 + r2 * (-1.0 / 39916800 + r2 * (1.0 / 6227020800.0)))))));
    const double cs = 1.0 + r2 * (-0.5 + r2 * (1.0 / 24 + r2 * (-1.0 / 720 + r2 * (1.0 / 40320 + r2 * (-1.0 / 3628800 + r2 * (1.0 / 479001600.0 + r2 * (-1.0 / 87178291200.0)))))));
    const int q = ((int)n) & 3;
    s = (q == 0) ? sn : (q == 1) ? cs : (q == 2) ? -sn : -cs;
    c = (q == 0) ? cs : (q == 1) ? -sn : (q == 2) ? -cs : sn;
}
constexpr int I_GU = 64 * 172, I_DN = 172 * 64, I_WIN_ = 64 * 128, I_WOUT_ = 64 * 64, I_GLU_ = 32 * 32, I_QK_ = 32;
constexpr int IT_GU1 = 0, IT_GU2 = 2 * I_GU, IT_DN1 = 4 * I_GU, IT_DN2 = IT_DN1 + I_DN, IT_WIN = IT_DN2 + I_DN, IT_WOUT = IT_WIN + I_WIN_, IT_END = IT_WOUT + I_WOUT_ + I_GLU_ + 8 * I_QK_;
__device__ __forceinline__ void decode_item(Frame& F, int it, const float (&winv)[5], CvtItem& c) {
    int r = it; c.q8 = 0; c.scale = 1.f;
    if (r < 4 * I_GU) {
        const int which = r / I_GU; r -= which * I_GU;
        c.W = F.in[which == 0 ? I_F1G : which == 1 ? I_F1U : which == 2 ? I_F2G : I_F2U]; c.ldw = DFF; c.ldk = D;
        if (which < 2) { const int kb = r / 172, nb = r % 172, n0 = 64 * nb;
            c.k0 = 64 * kb; c.n0 = n0; c.WT = WSP(bf16, WS_W1GU); c.drow0 = (n0 >> 7) * 256 + (which & 1) * 128 + (n0 & 127); return; }
        const int kb = r / 344, nb = r % 344, n0 = 32 * nb;
        c.k0 = 128 * kb; c.n0 = n0; c.WT = WSP(signed char, WS_W2GU); c.drow0 = (n0 >> 7) * 256 + (which & 1) * 128 + (n0 & 127); c.q8 = 1; c.scale = winv[which]; return; }
    r -= 4 * I_GU;
    if (r < 2 * I_DN) { const int which = r / I_DN; r -= which * I_DN;
        if (which) { const int kb = r / 128, nb = r % 128;
            c.W = F.in[I_F2D]; c.ldw = D; c.k0 = 128 * kb; c.n0 = 32 * nb; c.WT = WSP(signed char, WS_W2D); c.ldk = DFF; c.drow0 = 32 * nb; c.q8 = 1; c.scale = winv[4]; return; }
        const int kb = r / 64, nb = r % 64;
        c.W = F.in[I_F1D]; c.ldw = D; c.k0 = 64 * kb; c.n0 = 64 * nb; c.WT = WSP(bf16, WS_W1D); c.ldk = DFF; c.drow0 = 64 * nb; return; }
    r -= 2 * I_DN;
    if (r < I_WIN_) { const int kb = r / 128, nb = r % 128; c.W = F.in[I_WIN]; c.ldw = 8200; c.k0 = 64 * kb; c.n0 = 64 * nb; c.WT = WSP(bf16, WS_WIN); c.ldk = D; c.drow0 = 64 * nb; return; }
    r -= I_WIN_;
    if (r < I_WOUT_) { const int kb = r / 64, nb = r % 64; c.W = F.in[I_WOUT]; c.ldw = D; c.k0 = 64 * kb; c.n0 = 64 * nb; c.WT = WSP(bf16, WS_WOUT); c.ldk = D; c.drow0 = 64 * nb; return; }
    r -= I_WOUT_;
    if (r < I_GLU_) { const int kb = r / 32, nb = r % 32; c.W = F.in[I_WGLU]; c.ldw = 2048; c.k0 = 64 * kb; c.n0 = 64 * nb; c.WT = WSP(bf16, WS_WGLU); c.ldk = 2048; c.drow0 = 64 * nb; return; }
    r -= I_GLU_;
    { const int hk = r / I_QK_; r -= hk * I_QK_; const int h = hk >> 1, isk = hk & 1, kb = r / 4, nb = r % 4;
      c.W = F.in[isk ? I_WK : I_WQ] + (size_t)h * 512 * 256; c.ldw = 256; c.k0 = 64 * kb; c.n0 = 64 * nb; c.WT = WSP(bf16, WS_WQK) + (size_t)h * 512 * 512; c.ldk = 512; c.drow0 = isk * 256 + 64 * nb; c.scale = isk ? 0.0625f : 1.f; }
}
__device__ __forceinline__ void convert_item(Frame& F, int it, LAS float* scr, const float (&winv)[5]) { CvtItem c; decode_item(F, it, winv, c); f32x4 v[16]; cvt_load(c, F.lane, v); cvt_finish(c, F.lane, v, scr); }
template <int SET> __device__ __forceinline__ int cvt_set_size() { return SET == 0 ? 2 * I_GU : SET == 1 ? I_DN + (IT_END - IT_WIN) : SET == 2 ? 2 * I_GU : I_DN; }
template <int SET> __device__ __forceinline__ int cvt_set_item(int q) {
    if (SET == 0) return q;
    if (SET == 1) return q < I_DN ? IT_DN1 + q : IT_WIN + (q - I_DN);
    if (SET == 2) return IT_GU2 + q;
    return IT_DN2 + q;
}
template <int SET>
__device__ __forceinline__ void convert_stream(Frame& F, int w, int nw) {
    LAS float* scr = (LAS float*)(F.lds + F.wave * SCR_STRIDE);
    const float winv[5] = {1.f, 1.f, 1.0f / wscale(F, 2), 1.0f / wscale(F, 3), 1.0f / wscale(F, 4)};
    const int n = cvt_set_size<SET>();
    CvtItem c0, c1; f32x4 v0[16], v1[16]; int q = w;
    if (q < n) { decode_item(F, cvt_set_item<SET>(q), winv, c0); cvt_load(c0, F.lane, v0); }
    while (q < n) {
        const int qn = q + nw;
        if (qn < n) { decode_item(F, cvt_set_item<SET>(qn), winv, c1); cvt_load(c1, F.lane, v1); }
        cvt_finish(c0, F.lane, v0, scr);
        c0 = c1;
#pragma unroll
        for (int i = 0; i < 16; ++i) v0[i] = v1[i];
        q = qn;
    }
}
template <int SET>
__device__ __forceinline__ void convert_static(Frame& F, int first) { convert_stream<SET>(F, ((int)blockIdx.x - first) * NWAVES + F.wave, ((int)gridDim.x - first) * NWAVES); }
__device__ __forceinline__ void p0_prologue(Frame& F) {
    const int gw = F.vcu * NWAVES + F.wave, NGW = F.G * NWAVES;
    convert_stream<0>(F, gw, NGW);
    {
        const f32x4* gr = (const f32x4*)F.in[I_F1PRE] + F.lane; f32x4 gq[16];
#pragma unroll
        for (int j = 0; j < 16; ++j) gq[j] = gr[64 * j];
        for (int m = gw; m < TP; m += NGW) {
            const f32x4* xr = (const f32x4*)(F.in[I_XP] + (size_t)m * D) + F.lane; f32x4 v[16]; float s = 0.f;
#pragma unroll
            for (int j = 0; j < 16; ++j) { v[j] = __builtin_nontemporal_load(xr + 64 * j); s += (v[j].x * v[j].x + v[j].y * v[j].y) + (v[j].z * v[j].z + v[j].w * v[j].w); }
            const float r = rsqrtf(wave_sum(s) * (1.f / D) + EPS);
            u32x2* o8 = (u32x2*)(WSP(bf16, WS_HA) + (size_t)m * D) + F.lane;
#pragma unroll
            for (int j = 0; j < 16; ++j) { const f32x4 gg = gq[j]; u32x2 w; w.x = cvt_pk_bf16(v[j].x * r * gg.x, v[j].y * r * gg.y); w.y = cvt_pk_bf16(v[j].z * r * gg.z, v[j].w * r * gg.w); o8[64 * j] = w; }
        }
        LAS float* red = (LAS float*)F.lds;
        for (int ms = TP + F.vcu; ms < T; ms += F.G) {
            const f32x4* xr = (const f32x4*)(F.in[I_XS] + (size_t)(ms - TP) * D) + F.tid; const f32x4* g2 = (const f32x4*)F.in[I_F1PRE] + F.tid;
            const f32x4 a = xr[0], b = xr[512], ga = g2[0], gb = g2[512];
            float s = wave_sum((a.x * a.x + a.y * a.y) + (a.z * a.z + a.w * a.w) + (b.x * b.x + b.y * b.y) + (b.z * b.z + b.w * b.w));
            __syncthreads();
            if (F.lane == 0) red[F.wave] = s;
            __syncthreads();
            const float r = rsqrtf((((red[0] + red[1]) + (red[2] + red[3])) + ((red[4] + red[5]) + (red[6] + red[7]))) * (1.f / D) + EPS);
            u32x2* o8 = (u32x2*)(WSP(bf16, WS_HA) + (size_t)ms * D) + F.tid; u32x2 w;
            w.x = cvt_pk_bf16(a.x * r * ga.x, a.y * r * ga.y); w.y = cvt_pk_bf16(a.z * r * ga.z, a.w * r * ga.w); o8[0] = w;
            w.x = cvt_pk_bf16(b.x * r * gb.x, b.y * r * gb.y); w.y = cvt_pk_bf16(b.z * r * gb.z, b.w * r * gb.w); o8[512] = w;
        }
    }
    const int gt = F.vcu * NTHREADS + F.tid, NT = F.G * NTHREADS;
    { bf16* WIN = WSP(bf16, WS_WIN); const float* W = F.in[I_WIN];
      for (int i = gt; i < 8 * D / 2; i += NT) { const int j = i >> 11, k = (i & 2047) * 2; *(unsigned*)(WIN + (size_t)(8192 + j) * D + k) = cvt_pk_bf16(W[(size_t)k * 8200 + 8192 + j], W[(size_t)(k + 1) * 8200 + 8192 + j]); }
      u32x4* z = (u32x4*)(WIN + (size_t)8200 * D); for (int i = gt; i < 248 * D / 8; i += NT) z[i] = (u32x4){0u, 0u, 0u, 0u}; }
    for (int i = gt; i < NG * NP; i += NT) {
        const int g = i >> 6;
        const double are = F.in[I_ARE][i], aim = F.in[I_AIM][i], dt = exp((double)F.in[I_LOGDT][g]);
        const double mag = exp(are * dt); double sn, cs; sincos_d(aim * dt, sn, cs);
        const double abre = mag * cs, abim = mag * sn, den = are * are + aim * aim, ire = are / den, iim = -aim / den, fre = abre - 1.0, fim = abim;
        const double qre = fre * ire - fim * iim, qim = fre * iim + fim * ire;
        WSP(float, WS_S5AB)[i] = (float)abre; WSP(float, WS_S5AB)[8192 + i] = (float)abim;
        const CAS float* bre = (const CAS float*)F.in[I_BRE] + (size_t)i * 16; const CAS float* bim = (const CAS float*)F.in[I_BIM] + (size_t)i * 16;
        float* obre = WSP(float, WS_S5BB) + (size_t)i * 16; float* obim = obre + 131072;
#pragma unroll
        for (int j = 0; j < 16; ++j) { const double br = bre[j], bi = bim[j]; obre[j] = (float)(qre * br - qim * bi); obim[j] = (float)(qre * bi + qim * br); }
    }
}

template <int MODE, bool SAMPLE>
__device__ __forceinline__ void row_one(Frame& F, int m, const float* dbuf, const float* gpost, float scale, const float* gnext, bf16* hout) {
    {
        int ln = F.lane; asm volatile("" : "+v"(ln));
        const f32x4* gp = (const f32x4*)gpost + ln;
        u32x2* xb = (u32x2*)(WSP(bf16, WS_XR) + (size_t)m * D) + F.lane;
        const f32x4* xr = (const f32x4*)((m < TP) ? F.in[I_XP] + (size_t)m * D : F.in[I_XS] + (size_t)(m - TP) * D) + F.lane;
        f32x4 xf[MODE == 0 ? 16 : 1]; u32x2 xw[MODE == 0 ? 1 : 16];
#define ROWPASS_LOAD_X() do { if (MODE == 0) { _Pragma("unroll") for (int j = 0; j < 16; ++j) xf[j] = __builtin_nontemporal_load(xr + 64 * j); } \
                              else { _Pragma("unroll") for (int j = 0; j < 16; ++j) xw[j] = __builtin_nontemporal_load(xb + 64 * j); } } while (0)
        f32x4 v[16]; float s = 0.f;
        if (!SAMPLE) {
            ROWPASS_LOAD_X();
            const u32x2* db = (const u32x2*)((const bf16*)dbuf + (size_t)m * D) + F.lane;
#pragma unroll
            for (int j = 0; j < 16; ++j) { const u32x2 w = __builtin_nontemporal_load(db + 64 * j); v[j] = (f32x4){bflo(w.x), bfhi(w.x), bflo(w.y), bfhi(w.y)}; }
        } else {
#pragma unroll
            for (int j = 0; j < 16; ++j) v[j] = ((const LAS f32x4*)F.lds)[64 * j + F.lane];
            ROWPASS_LOAD_X();
        }
#undef ROWPASS_LOAD_X
        f32x4 gq[8];
#pragma unroll
        for (int j = 0; j < 8; ++j) gq[j] = gp[64 * j];
#pragma unroll
        for (int j = 0; j < 16; ++j) s += (v[j].x * v[j].x + v[j].y * v[j].y) + (v[j].z * v[j].z + v[j].w * v[j].w);
        const float r = rsqrtf(wave_sum(s) * (1.f / D) + EPS) * scale; float s2 = 0.f;
        f32x4* yo = (f32x4*)(F.out + O_Y + (size_t)m * D) + F.lane;
#pragma unroll
        for (int j = 0; j < 16; ++j) { f32x4 x;
            if (j == 8) {
#pragma unroll
                for (int jj = 0; jj < 8; ++jj) gq[jj] = gp[64 * (8 + jj)]; }
            if (MODE == 0) x = xf[j]; else { const u32x2 w = xw[j]; x = (f32x4){bflo(w.x), bfhi(w.x), bflo(w.y), bfhi(w.y)}; }
            const f32x4 gg = gq[j & 7]; v[j] = x + v[j] * r * gg;
            if (MODE == 2) __builtin_nontemporal_store(v[j], yo + 64 * j); else { u32x2 w; w.x = cvt_pk_bf16(v[j].x, v[j].y); w.y = cvt_pk_bf16(v[j].z, v[j].w); xb[64 * j] = w; }
            s2 += (v[j].x * v[j].x + v[j].y * v[j].y) + (v[j].z * v[j].z + v[j].w * v[j].w); }
        if (MODE == 0) {
            const f32x4* gn = (const f32x4*)gnext + ln; u32x2* o8 = (u32x2*)(hout + (size_t)m * D) + F.lane;
#pragma unroll
            for (int j = 0; j < 8; ++j) gq[j] = gn[64 * j];
            const float r2 = rsqrtf(wave_sum(s2) * (1.f / D) + EPS);
#pragma unroll
            for (int j = 0; j < 16; ++j) {
                if (j == 8) {
#pragma unroll
                    for (int jj = 0; jj < 8; ++jj) gq[jj] = gn[64 * (8 + jj)]; }
                const f32x4 gg = gq[j & 7]; u32x2 w; w.x = cvt_pk_bf16(v[j].x * r2 * gg.x, v[j].y * r2 * gg.y); w.y = cvt_pk_bf16(v[j].z * r2 * gg.z, v[j].w * r2 * gg.w); o8[64 * j] = w; }
        }
        if (MODE == 1) {
            const f32x4* gn = (const f32x4*)gnext + ln; float am = 0.f;
            const float r2 = rsqrtf(wave_sum(s2) * (1.f / D) + EPS);
#pragma unroll
            for (int j = 0; j < 16; ++j) { const f32x4 gg = gn[64 * j]; v[j] = v[j] * r2 * gg; am = fmaxf(fmaxf(am, fmaxf(fabsf(v[j].x), fabsf(v[j].y))), fmaxf(fabsf(v[j].z), fabsf(v[j].w))); }
            am = fmaxf(wave_max(am), 1e-20f); const float inv = 127.0f / am;
            unsigned* o4 = (unsigned*)((signed char*)hout + (size_t)m * D) + F.lane;
#pragma unroll
            for (int j = 0; j < 16; ++j) o4[64 * j] = q8x4(v[j].x * inv, v[j].y * inv, v[j].z * inv, v[j].w * inv);
            WSP(float, WS_SA)[(size_t)m * 64 + F.lane] = am * (1.0f / 127.0f);
        }
    }
}
template <int MODE>
__device__ __forceinline__ void row_pass(Frame& F, const float* dbuf, const float* gpost, float scale, const float* gnext, bf16* hout) {
    const int gw = F.vcu * NWAVES + F.wave, NGW = F.G * NWAVES;
    LAS f32x4* rowb = (LAS f32x4*)F.lds;
    LAS f32x4* part = rowb + 1024;
    for (int ms = TP + F.vcu; ms < T; ms += F.G) {
        __syncthreads();
        { const u32x2* s0 = (const u32x2*)(WSP(bf16, WS_SLAB) + ((size_t)(2 * F.wave) * 256 + (ms - TP)) * D) + F.lane; const u32x2* s1 = s0 + (size_t)256 * D / 4;
#pragma unroll
          for (int jh = 0; jh < 2; ++jh) { u32x2 a[8], b[8];
#pragma unroll
              for (int j = 0; j < 8; ++j) { a[j] = s0[64 * (8 * jh + j)]; b[j] = s1[64 * (8 * jh + j)]; }
#pragma unroll
              for (int j = 0; j < 8; ++j) part[F.wave * 1024 + 64 * (8 * jh + j) + F.lane] = (f32x4){bflo(a[j].x) + bflo(b[j].x), bfhi(a[j].x) + bfhi(b[j].x), bflo(a[j].y) + bflo(b[j].y), bfhi(a[j].y) + bfhi(b[j].y)}; } }
        __syncthreads();
#pragma unroll
        for (int q = 0; q < 2; ++q) { const int c = F.wave * 128 + q * 64 + F.lane; f32x4 t = part[c];
#pragma unroll
            for (int w = 1; w < 8; ++w) t += part[w * 1024 + c];
            rowb[c] = t; }
        __syncthreads();
        if (F.wave == 0) row_one<MODE, true>(F, ms, dbuf, gpost, scale, gnext, hout);
    }
    __syncthreads();
    for (int m = gw; m < TP; m += NGW) row_one<MODE, false>(F, m, dbuf, gpost, scale, gnext, hout);
}
__device__ __forceinline__ void p13_quant(Frame& F) {
    const int gw = F.vcu * NWAVES + F.wave, NGW = F.G * NWAVES;
    {
        LAS float* red = (LAS float*)F.lds;
        for (int ms = TP + F.vcu; ms < T; ms += F.G) {
            const u32x4* src = (const u32x4*)(WSP(bf16, WS_HID) + (size_t)ms * DFF); u32x4 v[3]; float am = 0.f;
#pragma unroll
            for (int i = 0; i < 3; ++i) { const int c = F.tid + 512 * i; v[i] = (u32x4){0u, 0u, 0u, 0u}; if (c < 1376) v[i] = src[c]; }
#pragma unroll
            for (int i = 0; i < 3; ++i) { const u32x4 w = v[i];
                am = fmaxf(fmaxf(fmaxf(am, fmaxf(fabsf(bflo(w.x)), fabsf(bfhi(w.x)))), fmaxf(fabsf(bflo(w.y)), fabsf(bfhi(w.y)))), fmaxf(fmaxf(fabsf(bflo(w.z)), fabsf(bfhi(w.z))), fmaxf(fabsf(bflo(w.w)), fabsf(bfhi(w.w))))); }
            am = wave_max(am);
            __syncthreads();
            if (F.lane == 0) red[F.wave] = am;
            __syncthreads();
            am = fmaxf(fmaxf(fmaxf(red[0], red[1]), fmaxf(red[2], red[3])), fmaxf(fmaxf(red[4], red[5]), fmaxf(red[6], red[7]))); am = fmaxf(am, 1e-20f);
            const float inv = 127.0f / am; u32x2* dst = (u32x2*)(WSP(signed char, WS_HID8) + (size_t)ms * DFF);
#pragma unroll
            for (int i = 0; i < 3; ++i) { const int c = F.tid + 512 * i; const u32x4 w = v[i]; u32x2 o; o.x = q8x4(bflo(w.x) * inv, bfhi(w.x) * inv, bflo(w.y) * inv, bfhi(w.y) * inv); o.y = q8x4(bflo(w.z) * inv, bfhi(w.z) * inv, bflo(w.w) * inv, bfhi(w.w) * inv);
                if (c < 1376) dst[c] = o; }
            if (F.wave == 0) WSP(float, WS_SA2)[(size_t)ms * 64 + F.lane] = am * (1.0f / 127.0f);
        }
    }
    for (int m = gw; m < TP; m += NGW) {
        const u32x4* src = (const u32x4*)(WSP(bf16, WS_HID) + (size_t)m * DFF) + F.lane;
        u32x4 v[22]; float am = 0.f;
#pragma unroll
        for (int i = 0; i < 22; ++i) { v[i] = (u32x4){0u, 0u, 0u, 0u}; if (i < 21 || F.lane < 32) v[i] = __builtin_nontemporal_load(src + 64 * i); }
#pragma unroll
        for (int i = 0; i < 22; ++i) { const u32x4 w = v[i];
            am = fmaxf(fmaxf(fmaxf(am, fmaxf(fabsf(bflo(w.x)), fabsf(bfhi(w.x)))), fmaxf(fabsf(bflo(w.y)), fabsf(bfhi(w.y)))), fmaxf(fmaxf(fabsf(bflo(w.z)), fabsf(bfhi(w.z))), fmaxf(fabsf(bflo(w.w)), fabsf(bfhi(w.w))))); }
        am = fmaxf(wave_max(am), 1e-20f); const float inv = 127.0f / am;
        u32x2* dst = (u32x2*)(WSP(signed char, WS_HID8) + (size_t)m * DFF) + F.lane;
#pragma unroll
        for (int i = 0; i < 22; ++i) { const u32x4 w = v[i]; u32x2 o; o.x = q8x4(bflo(w.x) * inv, bfhi(w.x) * inv, bflo(w.y) * inv, bfhi(w.y) * inv); o.y = q8x4(bflo(w.z) * inv, bfhi(w.z) * inv, bflo(w.w) * inv, bfhi(w.w) * inv);
            if (i < 21 || F.lane < 32) dst[64 * i] = o; }
        WSP(float, WS_SA2)[(size_t)m * 64 + F.lane] = am * (1.0f / 127.0f);
    }
}
__device__ __forceinline__ void zero_dbuf_tail(Frame& F) {
    const int gt = F.vcu * NTHREADS + F.tid, NT = F.G * NTHREADS;
    u32x4* z = (u32x4*)(WSP(float, WS_DBUF) + (size_t)TP * D);
    for (int i = gt; i < 256 * D / 4; i += NT) z[i] = (u32x4){0u, 0u, 0u, 0u};
}
template <int NT_TOTAL, bool I8 = false>
__device__ __forceinline__ void gemm_tail_splitk(Frame& F, const bf16* A, int lda, const bf16* Bt, int ldb, const float* sa = nullptr, float sw = 0.f) {
    const int c = F.vcu; if (c >= 256) return;
    const int pn = c & 15, ch = c >> 4;
    constexpr int SMALL = (NT_TOTAL / 16) & ~1, R = (NT_TOTAL - 16 * SMALL) / 2, BIG = SMALL + 2;
    static_assert(R >= 0 && R <= 16 && R * BIG + (16 - R) * SMALL == NT_TOTAL && SMALL >= 4, "split");
    const int k0 = (ch < R) ? ch * BIG : R * BIG + (ch - R) * SMALL, len = (ch < R) ? BIG : SMALL;
    pg8::Gemm g{A + (size_t)TP * lda + (size_t)k0 * 64, Bt + (size_t)k0 * 64, lda, ldb, len * 64, 0, 0};
    pg8::OneUnit S{pn};
    if constexpr (I8) { pg8::EpiBf16S E{WSP(bf16, WS_SLAB) + (size_t)ch * 256 * D, D, sa + (size_t)TP * 64, sw}; pg8::gemm_phase<pg8::EpiBf16S, pg8::OneUnit, true, true, false, true>(F.lds, g, S, E); }
    else { pg8::EpiBf16 E{WSP(bf16, WS_SLAB) + (size_t)ch * 256 * D, D}; pg8::gemm_phase<pg8::EpiBf16, pg8::OneUnit, true, true>(F.lds, g, S, E); }
}

__device__ __forceinline__ void p7_sample_qk(Frame& F) {
    for (int unit = F.vcu; unit < 64; unit += F.G) {
    const int h = unit >> 4, isk = (unit >> 3) & 1, cs = unit & 7;
    int lane_l = F.lane; asm volatile("" : "+v"(lane_l));
    const int fr = lane_l & 15, fq = lane_l >> 4;
    const bf16* A = WSP(bf16, WS_CV) + (size_t)(TP + 32 * F.wave + fr) * 2048 + h * 512 + 8 * fq;
    const bf16* B = WSP(bf16, WS_WQK) + (size_t)h * 512 * 512 + (size_t)(isk * 256 + cs * 32 + fr) * 512 + 8 * fq;
    f32x4 acc[2][2];
#pragma unroll
    for (int i = 0; i < 2; ++i)
#pragma unroll
        for (int j = 0; j < 2; ++j) acc[i][j] = (f32x4){0.f, 0.f, 0.f, 0.f};
#pragma unroll 4
    for (int ks = 0; ks < 16; ++ks) {
        bf16x8 a[2], b[2];
#pragma unroll
        for (int i = 0; i < 2; ++i) a[i] = *(const bf16x8*)(A + (size_t)(16 * i) * 2048 + 32 * ks);
#pragma unroll
        for (int j = 0; j < 2; ++j) b[j] = *(const bf16x8*)(B + (size_t)(16 * j) * 512 + 32 * ks);
#pragma unroll
        for (int i = 0; i < 2; ++i)
#pragma unroll
            for (int j = 0; j < 2; ++j) acc[i][j] = __builtin_amdgcn_mfma_f32_16x16x32_bf16(a[i], b[j], acc[i][j], 0, 0, 0);
    }
    bf16* O = (isk ? WSP(bf16, WS_K) : WSP(bf16, WS_Q)) + (size_t)(TP + 32 * F.wave) * 1024 + h * 256 + cs * 32;
#pragma unroll
    for (int i = 0; i < 2; ++i)
#pragma unroll
        for (int j = 0; j < 2; ++j)
#pragma unroll
            for (int r = 0; r < 4; ++r) { const float own = acc[i][j][r], oth = __shfl_xor(own, 1);
                if (!(fr & 1)) *(unsigned*)(O + (size_t)(16 * i + 4 * fq + r) * 1024 + 16 * j + fr) = cvt_pk_bf16(own, oth); }
    }
}
__device__ __forceinline__ void p5_conv(Frame& F) {
    const int gt = F.vcu * NTHREADS + F.tid, NT = F.G * NTHREADS;
    const bf16* PB = WSP(bf16, WS_PB);
    {
        const int c8 = (gt & 255) * 8; bf16* CV = WSP(bf16, WS_CV);
        const float* cw = F.in[I_CONVW]; const float* cb = F.in[I_CONVB]; const float* cache = F.in[I_CONV];
        float w[4][8], bb[8];
#pragma unroll
        for (int j = 0; j < 4; ++j) { const f32x4 w0 = *(const f32x4*)(cw + j * 2048 + c8), w1 = *(const f32x4*)(cw + j * 2048 + c8 + 4);
            w[j][0] = w0.x; w[j][1] = w0.y; w[j][2] = w0.z; w[j][3] = w0.w; w[j][4] = w1.x; w[j][5] = w1.y; w[j][6] = w1.z; w[j][7] = w1.w; }
        { const f32x4 b0 = *(const f32x4*)(cb + c8), b1 = *(const f32x4*)(cb + c8 + 4); bb[0] = b0.x; bb[1] = b0.y; bb[2] = b0.z; bb[3] = b0.w; bb[4] = b1.x; bb[5] = b1.y; bb[6] = b1.z; bb[7] = b1.w; }
        for (int rb = gt >> 8; rb < T / 4; rb += NT >> 8) {
            const int row = 4 * rb; int pos, sb; if (row < TP) { pos = row; sb = -1; } else { pos = (row - TP) & 15; sb = (row - TP) >> 4; }
            u32x4 raw[7];
#pragma unroll
            for (int i = 0; i < 7; ++i) { const int rr = (pos - 3 + i >= 0) ? row - 3 + i : row; raw[i] = *(const u32x4*)(PB + (size_t)rr * 8192 + c8); }
            float u[7][8];
#pragma unroll
            for (int i = 0; i < 7; ++i) { const u32x4 q = raw[i]; u[i][0] = bflo(q.x); u[i][1] = bfhi(q.x); u[i][2] = bflo(q.y); u[i][3] = bfhi(q.y); u[i][4] = bflo(q.z); u[i][5] = bfhi(q.z); u[i][6] = bflo(q.w); u[i][7] = bfhi(q.w); }
            if (pos == 0) {
#pragma unroll
                for (int i = 0; i < 3; ++i) {
                    if (sb >= 0) { const float* cp = cache + ((size_t)sb * 3 + i) * 2048 + c8; const f32x4 a = *(const f32x4*)cp, b = *(const f32x4*)(cp + 4);
                        u[i][0] = a.x; u[i][1] = a.y; u[i][2] = a.z; u[i][3] = a.w; u[i][4] = b.x; u[i][5] = b.y; u[i][6] = b.z; u[i][7] = b.w; }
                    else {
#pragma unroll
                        for (int e = 0; e < 8; ++e) u[i][e] = 0.f; } } }
#pragma unroll
            for (int r = 0; r < 4; ++r) { float acc[8];
#pragma unroll
                for (int e = 0; e < 8; ++e) { float a = bb[e];
#pragma unroll
                    for (int j = 0; j < 4; ++j) a += u[r + j][e] * w[j][e];
                    acc[e] = siluf_(a); }
                u32x4 o; o.x = cvt_pk_bf16(acc[0], acc[1]); o.y = cvt_pk_bf16(acc[2], acc[3]); o.z = cvt_pk_bf16(acc[4], acc[5]); o.w = cvt_pk_bf16(acc[6], acc[7]);
                *(u32x4*)(CV + (size_t)(row + r) * 2048 + c8) = o; }
        }
    }
    for (int idx = gt; idx < 17 * 3 * 2048; idx += NT) {
        const int c = idx & 2047, r = (idx >> 11) % 3, sq = idx / (3 * 2048);
        const int row = (sq == 0) ? (TP - 3 + r) : (TP + (sq - 1) * 16 + 13 + r);
        const float v = bf2f(PB[(size_t)row * 8192 + c]);
        if (sq == 0) F.out[O_CONVP + (size_t)r * 2048 + c] = v; else F.out[O_CONVS + ((size_t)(sq - 1) * 3 + r) * 2048 + c] = v;
    }
}
__device__ __forceinline__ void p5_gates(Frame& F) {
    const int gw = F.vcu * NWAVES + F.wave, NGW = F.G * NWAVES;
    const float* GATES = WSP(float, WS_GATES);
    for (int task = gw; task < NSU * NH; task += NGW) {
        const int su = task >> 2, h = task & 3, row0 = su_row0(su), len = su_len(su);
        const float bi = F.in[I_BI][h], bfv = F.in[I_BF][h];
        float lf[4], ig[4];
#pragma unroll
        for (int i = 0; i < 4; ++i) { const int tl = 4 * F.lane + i;
            if (tl < len) { const float* gp = GATES + (size_t)(row0 + tl) * 8; ig[i] = gp[h] + bi; lf[i] = logsigmoidf_(gp[4 + h] + bfv); } else { ig[i] = -INFINITY; lf[i] = 0.f; } }
        float c[4]; c[0] = lf[0]; c[1] = c[0] + lf[1]; c[2] = c[1] + lf[2]; c[3] = c[2] + lf[3];
        float incl = c[3];
#pragma unroll
        for (int o = 1; o < 64; o <<= 1) { const float t = __shfl_up(incl, o); if (F.lane >= o) incl += t; }
        const float excl = incl - c[3];
        float b[4], a[4], mr[4];
#pragma unroll
        for (int i = 0; i < 4; ++i) { b[i] = excl + c[i]; a[i] = ig[i] - b[i]; }
        mr[0] = a[0]; mr[1] = fmaxf(mr[0], a[1]); mr[2] = fmaxf(mr[1], a[2]); mr[3] = fmaxf(mr[2], a[3]);
        float mincl = mr[3];
#pragma unroll
        for (int o = 1; o < 64; o <<= 1) { const float t = __shfl_up(mincl, o); if (F.lane >= o) mincl = fmaxf(mincl, t); }
        float mexcl = __shfl_up(mincl, 1); if (F.lane == 0) mexcl = -INFINITY;
#pragma unroll
        for (int i = 0; i < 4; ++i) { const int tl = 4 * F.lane + i;
            if (tl < len) { const size_t o = (size_t)h * T + row0 + tl; WSP(float, WS_BARR)[o] = b[i]; WSP(float, WS_AARR)[o] = a[i]; WSP(float, WS_MRUN)[o] = fmaxf(mexcl, mr[i]); } }
        const float tot = __shfl(incl, 63), mx = __shfl(mincl, 63);
        if (F.lane == 0) { WSP(float, WS_SUA)[su * 4 + h] = mx; WSP(float, WS_SUB)[su * 4 + h] = tot; }
    }
}
struct S5C {
    float a1r[4], a1i[4], a2r[4], a2i[4], a3r[4], a3i[4], a4r[4], a4i[4], afr[4], afi[4], a8r[4], a8i[4], a16r[4], a16i[4];
    bf16x8 bfr[8];
};
#define CMULADD(orr, oi, ar_, ai_, xr_, xi_, br_, bi_) do { float _r = __builtin_fmaf((ar_), (xr_), __builtin_fmaf(-(ai_), (xi_), (br_))); asm volatile("" : "+v"(_r)); const float _i = __builtin_fmaf((ar_), (xi_), __builtin_fmaf((ai_), (xr_), (bi_))); orr = _r; oi = _i; } while (0)
__device__ __forceinline__ void s5_setup(Frame& F, int g, int fr, int fq, S5C& c) {
#pragma unroll
    for (int nb = 0; nb < 4; ++nb) {
        const int p = 16 * nb + fr; const float ar = WSP(float, WS_S5AB)[g * 64 + p], ai = WSP(float, WS_S5AB)[8192 + g * 64 + p];
        c.a1r[nb] = ar; c.a1i[nb] = ai;
        float a2r, a2i; CMULADD(a2r, a2i, ar, ai, ar, ai, 0.f, 0.f);
        c.a2r[nb] = a2r; c.a2i[nb] = a2i; CMULADD(c.a3r[nb], c.a3i[nb], a2r, a2i, ar, ai, 0.f, 0.f);
        CMULADD(c.a4r[nb], c.a4i[nb], a2r, a2i, a2r, a2i, 0.f, 0.f);
        CMULADD(c.a8r[nb], c.a8i[nb], c.a4r[nb], c.a4i[nb], c.a4r[nb], c.a4i[nb], 0.f, 0.f);
        float a12r, a12i; CMULADD(a12r, a12i, c.a8r[nb], c.a8i[nb], c.a4r[nb], c.a4i[nb], 0.f, 0.f);
        CMULADD(c.a16r[nb], c.a16i[nb], c.a8r[nb], c.a8i[nb], c.a8r[nb], c.a8i[nb], 0.f, 0.f);
        c.afr[nb] = fq == 0 ? 1.f : fq == 1 ? c.a4r[nb] : fq == 2 ? c.a8r[nb] : a12r;
        c.afi[nb] = fq == 0 ? 0.f : fq == 1 ? c.a4i[nb] : fq == 2 ? c.a8i[nb] : a12i;
    }
    f32x4 bq[8][2];
#pragma unroll
    for (int nbt = 0; nbt < 8; ++nbt) {
        const float* q = WSP(float, WS_S5BB) + (nbt >= 4 ? 131072 : 0) + ((size_t)g * 64 + 16 * (nbt & 3) + fr) * 16 + 8 * (fq & 1); bq[nbt][0] = *(const f32x4*)q; bq[nbt][1] = *(const f32x4*)(q + 4); }
#pragma unroll
    for (int nbt = 0; nbt < 8; ++nbt) { const f32x4 a = bq[nbt][0], b = bq[nbt][1];
        u32x4 w; w.x = cvt_pk_bf16(a.x, a.y); w.y = cvt_pk_bf16(a.z, a.w); w.z = cvt_pk_bf16(b.x, b.y); w.w = cvt_pk_bf16(b.z, b.w);
        if (fq >= 2) w = (u32x4){0u, 0u, 0u, 0u};
        c.bfr[nbt] = __builtin_bit_cast(bf16x8, w); }
}
template <bool FINAL>
__device__ __forceinline__ void s5_block(const S5C& c, const bf16x8 uf, int fr, int fq, float (&hr)[4], float (&hi)[4], LAS unsigned char* hs) {
    const bool odd = (fq & 1) != 0, up = (fq & 2) != 0;
#pragma unroll
    for (int nb = 0; nb < 4; ++nb) {
        const f32x4 dre = __builtin_amdgcn_mfma_f32_16x16x32_bf16(uf, c.bfr[nb], (f32x4){0.f, 0.f, 0.f, 0.f}, 0, 0, 0);
        const f32x4 dim = __builtin_amdgcn_mfma_f32_16x16x32_bf16(uf, c.bfr[nb + 4], (f32x4){0.f, 0.f, 0.f, 0.f}, 0, 0, 0);
        float lr[4], li[4];
#pragma unroll
        for (int r = 0; r < 4; ++r) { lr[r] = dre[r]; li[r] = dim[r]; }
#pragma unroll
        for (int r = 1; r < 4; ++r) CMULADD(lr[r], li[r], c.a1r[nb], c.a1i[nb], lr[r - 1], li[r - 1], lr[r], li[r]);
        const float p1r = __shfl_xor(lr[3], 16), p1i = __shfl_xor(li[3], 16);
        const float lor = odd ? p1r : lr[3], loi = odd ? p1i : li[3], hir = odd ? lr[3] : p1r, hii = odd ? li[3] : p1i;
        float tpr, tpi; CMULADD(tpr, tpi, c.a4r[nb], c.a4i[nb], lor, loi, hir, hii);
        const float p2r = __shfl_xor(tpr, 32), p2i = __shfl_xor(tpi, 32);
        const float t01r = up ? p2r : tpr, t01i = up ? p2i : tpi, t23r = up ? tpr : p2r, t23i = up ? tpi : p2i;
        if (FINAL) {
            float xr, xi; CMULADD(xr, xi, c.a4r[nb], c.a4i[nb], t01r, t01i, lor, loi);
            const float prer = up ? (odd ? xr : t01r) : (odd ? lor : 0.f), prei = up ? (odd ? xi : t01i) : (odd ? loi : 0.f);
            float cr, ci; CMULADD(cr, ci, c.afr[nb], c.afi[nb], hr[nb], hi[nb], prer, prei);
            float h0r, h0i, h1r, h1i, h2r, h2i, h3r, h3i;
            CMULADD(h0r, h0i, c.a1r[nb], c.a1i[nb], cr, ci, lr[0], li[0]);
            CMULADD(h1r, h1i, c.a2r[nb], c.a2i[nb], cr, ci, lr[1], li[1]);
            CMULADD(h2r, h2i, c.a3r[nb], c.a3i[nb], cr, ci, lr[2], li[2]);
            CMULADD(h3r, h3i, c.a4r[nb], c.a4i[nb], cr, ci, lr[3], li[3]);
            LAS unsigned char* hp = hs + (4 * fq) * 272 + (16 * nb + fr) * 4;
            *(LAS unsigned*)(hp) = cvt_pk_bf16(h0r, h0i); *(LAS unsigned*)(hp + 272) = cvt_pk_bf16(h1r, h1i); *(LAS unsigned*)(hp + 544) = cvt_pk_bf16(h2r, h2i); *(LAS unsigned*)(hp + 816) = cvt_pk_bf16(h3r, h3i);
        }
        float nr, ni; CMULADD(nr, ni, c.a8r[nb], c.a8i[nb], t01r, t01i, t23r, t23i);
        CMULADD(hr[nb], hi[nb], c.a16r[nb], c.a16i[nb], hr[nb], hi[nb], nr, ni);
    }
}
__device__ __forceinline__ bf16x8 s5_ufrag(const bf16* PB, int row, int g, int fq) {
    u32x4 w = (u32x4){0u, 0u, 0u, 0u}; if (fq < 2) w = *(const u32x4*)(PB + (size_t)row * 8192 + 6144 + g * 16 + 8 * fq);
    return __builtin_bit_cast(bf16x8, w);
}
__device__ __forceinline__ void s5_stage_u(const bf16* PB, int row0, int len, int g, LAS unsigned char* ul, int lane) {
    u32x4 st[8];
#pragma unroll
    for (int i = 0; i < 8; ++i) { const int c = lane + 64 * i, row = c >> 1, half = c & 1; const int rc = row < len ? row : len - 1;
        st[i] = *(const u32x4*)(PB + (size_t)(row0 + rc) * 8192 + 6144 + g * 16 + 8 * half); }
#pragma unroll
    for (int i = 0; i < 8; ++i) { const int c = lane + 64 * i, row = c >> 1; if (row < len) *(LAS u32x4*)(ul + c * 16) = st[i]; }
    asm volatile("s_waitcnt vmcnt(0) lgkmcnt(0)" ::: "memory"); __builtin_amdgcn_wave_barrier();
}
__device__ __forceinline__ bf16x8 s5_ufrag_lds(const LAS unsigned char* ul, int blk, int fr, int fq) {
    u32x4 w = (u32x4){0u, 0u, 0u, 0u}; if (fq < 2) w = *(const LAS u32x4*)(ul + ((16 * blk + fr) * 2 + fq) * 16);
    return __builtin_bit_cast(bf16x8, w);
}
__device__ __forceinline__ void p5_s5_local(Frame& F) {
    const int gw = F.vcu * NWAVES + F.wave, NGW = F.G * NWAVES, fr = F.lane & 15, fq = F.lane >> 4;
    const bf16* PB = WSP(bf16, WS_PB);
    unsigned* ticket = (unsigned*)(F.ws + WS_CTL) + 16384 + 64 * (4 + 16 * F.pp);
    for (;;) {
        int task = 0; if (F.lane == 0) task = (int)__hip_atomic_fetch_add(ticket, 1u, __ATOMIC_RELAXED, __HIP_MEMORY_SCOPE_AGENT);
        task = __builtin_amdgcn_readfirstlane(task);
        if (task >= 31 * NG) break;
        const int su = task >> 7, g = task & 127, row0 = su * 256;
        S5C c; s5_setup(F, g, fr, fq, c);
        float hr[4] = {0.f, 0.f, 0.f, 0.f}, hi[4] = {0.f, 0.f, 0.f, 0.f};
        LAS unsigned char* ul = F.lds + F.wave * 16384;
        s5_stage_u(PB, row0, 256, g, ul, F.lane);
        for (int blk = 0; blk < 16; ++blk) s5_block<false>(c, s5_ufrag_lds(ul, blk, fr, fq), fr, fq, hr, hi, nullptr);
        asm volatile("s_waitcnt lgkmcnt(0)" ::: "memory"); __builtin_amdgcn_wave_barrier();
        if (fq == 0) {
#pragma unroll
            for (int nb = 0; nb < 4; ++nb) { const size_t o = (size_t)su * 8192 + g * 64 + 16 * nb + fr; WSP(float, WS_S5LOC)[o] = hr[nb]; WSP(float, WS_S5LOC)[(size_t)32 * 8192 + o] = hi[nb]; }
        }
    }
}
__device__ __forceinline__ void p7_s5_final(Frame& F) {
    const int gw = F.vcu * NWAVES + F.wave, NGW = F.G * NWAVES;
    LAS unsigned char* ul = F.lds + F.wave * 16384;
    LAS unsigned char* hs = ul + 8192;
    const bf16* PB = WSP(bf16, WS_PB); bf16* Gb = WSP(bf16, WS_G);
    const int fr = F.lane & 15, fq = F.lane >> 4;
    for (int task = gw; task < NSU * NG; task += NGW) {
        const int su = task >> 7, g = task & 127, row0 = su_row0(su), len = su_len(su);
        S5C c; s5_setup(F, g, fr, fq, c);
        float hr[4], hi[4];
        if (su < 32) {
            float pr[4], pi[4];
#pragma unroll
            for (int nb = 0; nb < 4; ++nb) { pr[nb] = c.a16r[nb]; pi[nb] = c.a16i[nb];
#pragma unroll
                for (int s = 0; s < 4; ++s) CMULADD(pr[nb], pi[nb], pr[nb], pi[nb], pr[nb], pi[nb], 0.f, 0.f);
                hr[nb] = 0.f; hi[nb] = 0.f; }
            for (int s0 = 0; s0 < su; s0 += 8) {
                float lr[4][8], li[4][8];
#pragma unroll
                for (int nb = 0; nb < 4; ++nb)
#pragma unroll
                    for (int k = 0; k < 8; ++k) { const int s = (s0 + k < su) ? s0 + k : su - 1; const size_t o = (size_t)s * 8192 + g * 64 + 16 * nb + fr; lr[nb][k] = WSP(float, WS_S5LOC)[o]; li[nb][k] = WSP(float, WS_S5LOC)[(size_t)32 * 8192 + o]; }
#pragma unroll
                for (int k = 0; k < 8; ++k) if (s0 + k < su) {
#pragma unroll
                    for (int nb = 0; nb < 4; ++nb) CMULADD(hr[nb], hi[nb], pr[nb], pi[nb], hr[nb], hi[nb], lr[nb][k], li[nb][k]); }
            }
        } else {
#pragma unroll
            for (int nb = 0; nb < 4; ++nb) { const int p = 16 * nb + fr; hr[nb] = F.in[I_S5RE][(size_t)(su - 32) * 8192 + g * 64 + p]; hi[nb] = F.in[I_S5IM][(size_t)(su - 32) * 8192 + g * 64 + p]; }
        }
        bf16x8 cf[4], dmf;
#pragma unroll
        for (int ks = 0; ks < 4; ++ks) {
            const size_t o = ((size_t)g * 16 + fr) * 64 + 16 * ks + 4 * fq; const f32x4 a = *(const f32x4*)(F.in[I_CRE] + o), b = *(const f32x4*)(F.in[I_CIM] + o);
            u32x4 w; w.x = cvt_pk_bf16(a.x, -b.x); w.y = cvt_pk_bf16(a.y, -b.y); w.z = cvt_pk_bf16(a.z, -b.z); w.w = cvt_pk_bf16(a.w, -b.w);
            cf[ks] = __builtin_bit_cast(bf16x8, w); }
        { const float dj = F.in[I_S5D][g * 16 + fr]; float e[8];
#pragma unroll
          for (int k = 0; k < 8; ++k) e[k] = (8 * fq + k == fr) ? dj : 0.f;
          u32x4 w; w.x = cvt_pk_bf16(e[0], e[1]); w.y = cvt_pk_bf16(e[2], e[3]); w.z = cvt_pk_bf16(e[4], e[5]); w.w = cvt_pk_bf16(e[6], e[7]); dmf = __builtin_bit_cast(bf16x8, w); }
        const int nblk = len >> 4;
        s5_stage_u(PB, row0, len, g, ul, F.lane);
        for (int blk = 0; blk < nblk; ++blk) {
            const bf16x8 uf = s5_ufrag_lds(ul, blk, fr, fq);
            s5_block<true>(c, uf, fr, fq, hr, hi, hs);
            asm volatile("s_waitcnt lgkmcnt(0)" ::: "memory"); __builtin_amdgcn_wave_barrier();
            f32x4 acc = __builtin_amdgcn_mfma_f32_16x16x32_bf16(uf, dmf, (f32x4){0.f, 0.f, 0.f, 0.f}, 0, 0, 0);
#pragma unroll
            for (int ks = 0; ks < 4; ++ks) { const bf16x8 af = *(const LAS bf16x8*)(hs + fr * 272 + (32 * ks + 8 * fq) * 2); acc = __builtin_amdgcn_mfma_f32_16x16x32_bf16(af, cf[ks], acc, 0, 0, 0); }
#pragma unroll
            for (int r = 0; r < 4; ++r) {
                const float own = gelu_tanh(acc[r]), oth = __shfl_xor(own, 1);
                if (!(fr & 1)) *(unsigned*)(Gb + (size_t)(row0 + 16 * blk + 4 * fq + r) * 2048 + g * 16 + fr) = cvt_pk_bf16(own, oth); }
            asm volatile("s_waitcnt lgkmcnt(0)" ::: "memory"); __builtin_amdgcn_wave_barrier();
        }
        if (fq == 0) {
#pragma unroll
            for (int nb = 0; nb < 4; ++nb) { const int p = 16 * nb + fr;
                if (su == 31) { F.out[O_S5REP + g * 64 + p] = hr[nb]; F.out[O_S5IMP + g * 64 + p] = hi[nb]; }
                if (su >= 32) { F.out[O_S5RES + (size_t)(su - 32) * 8192 + g * 64 + p] = hr[nb]; F.out[O_S5IMS + (size_t)(su - 32) * 8192 + g * 64 + p] = hi[nb]; } }
        }
    }
}

__device__ __forceinline__ bf16x8 tr_frag(const LAS unsigned char* p0, const LAS unsigned char* p1) {
    const s16x4 a = __builtin_amdgcn_ds_read_tr16_b64_v4i16((LAS s16x4*)p0), b = __builtin_amdgcn_ds_read_tr16_b64_v4i16((LAS s16x4*)p1);
    bf16x8 f; f[0] = a[0]; f[1] = a[1]; f[2] = a[2]; f[3] = a[3]; f[4] = b[0]; f[5] = b[1]; f[6] = b[2]; f[7] = b[3]; return f;
}
__device__ __forceinline__ void p7_m1(Frame& F) {
    constexpr int KP = 528, VP1 = 272;
    LAS unsigned char* KT = F.lds; LAS unsigned char* VT = F.lds + 64 * KP;
    const bf16* Kg = WSP(bf16, WS_K); const bf16* PB = WSP(bf16, WS_PB); const float* AARR = WSP(float, WS_AARR);
    int lane_l = F.lane; asm volatile("" : "+v"(lane_l));
    const int w = F.wave, wd = w >> 1, we = w & 1, fr = lane_l & 15, fq = lane_l >> 4;
    for (int unit = F.vcu; unit < 512; unit += F.G) {
        const int su = unit >> 4, h = (unit >> 2) & 3, es = unit & 3, row0 = su * 256;
        const float Asu = WSP(float, WS_SUA)[su * 4 + h];
        f32x4 acc[4][4];
#pragma unroll
        for (int i = 0; i < 4; ++i)
#pragma unroll
            for (int j = 0; j < 4; ++j) acc[i][j] = (f32x4){0.f, 0.f, 0.f, 0.f};
        float nk = 0.f;
        u32x4 pk[4], pv[2]; float pa[4];
#define M1_PREFETCH(KT_) do { const int s0_ = row0 + 64 * (KT_); int tq_ = F.tid; asm volatile("" : "+v"(tq_)); \
            _Pragma("unroll") for (int i = 0; i < 4; ++i) { const int c = tq_ + 512 * i, row = c >> 5, cc = c & 31; pa[i] = AARR[(size_t)h * T + s0_ + row]; pk[i] = *(const u32x4*)(Kg + (size_t)(s0_ + row) * 1024 + h * 256 + cc * 8); } \
            _Pragma("unroll") for (int i = 0; i < 2; ++i) { const int c = tq_ + 512 * i, row = c >> 4, cc = c & 15; pv[i] = *(const u32x4*)(PB + (size_t)(s0_ + row) * 8192 + 2048 + h * 512 + es * 128 + cc * 8); } } while (0)
        M1_PREFETCH(0);
        for (int kt = 0; kt < 4; ++kt) {
            { int tq = F.tid; asm volatile("" : "+v"(tq));
#pragma unroll
              for (int i = 0; i < 4; ++i) { const int c = tq + 512 * i, row = c >> 5, cc = c & 31;
                const float wgt = __expf(pa[i] - Asu); const u32x4 kv = pk[i];
                u32x4 o; o.x = cvt_pk_bf16(bflo(kv.x) * wgt, bfhi(kv.x) * wgt); o.y = cvt_pk_bf16(bflo(kv.y) * wgt, bfhi(kv.y) * wgt); o.z = cvt_pk_bf16(bflo(kv.z) * wgt, bfhi(kv.z) * wgt); o.w = cvt_pk_bf16(bflo(kv.w) * wgt, bfhi(kv.w) * wgt);
                *(LAS u32x4*)(KT + row * KP + cc * 16) = o; }
#pragma unroll
              for (int i = 0; i < 2; ++i) { const int c = tq + 512 * i, row = c >> 4, cc = c & 15; *(LAS u32x4*)(VT + row * VP1 + cc * 16) = pv[i]; } }
            if (kt + 1 < 4) M1_PREFETCH(kt + 1);
            __syncthreads();
            if (es == 0 && F.tid < 256) { for (int r = 0; r < 64; ++r) nk += bf2f(*(const LAS bf16*)(KT + r * KP + F.tid * 2)); }
#pragma unroll
            for (int ks = 0; ks < 2; ++ks) {
                const int rbase = 32 * ks + 8 * fq + (fr >> 2);
                bf16x8 af[4];
#pragma unroll
                for (int dt = 0; dt < 4; ++dt) { const LAS unsigned char* p = KT + rbase * KP + (64 * wd + 16 * dt + 4 * (fr & 3)) * 2; af[dt] = tr_frag(p, p + 4 * KP); }
#pragma unroll
                for (int et = 0; et < 4; ++et) { const LAS unsigned char* p = VT + rbase * VP1 + (64 * we + 16 * et + 4 * (fr & 3)) * 2; const bf16x8 bfr = tr_frag(p, p + 4 * VP1);
#pragma unroll
                    for (int dt = 0; dt < 4; ++dt) acc[dt][et] = __builtin_amdgcn_mfma_f32_16x16x32_bf16(af[dt], bfr, acc[dt][et], 0, 0, 0); }
            }
            __syncthreads();
        }
        int kvo = (64 * wd + 4 * fq) * 512 + es * 128 + 64 * we + fr; asm volatile("" : "+v"(kvo));
        float* KV = WSP(float, WS_KV) + (size_t)(su * 4 + h) * 131072 + kvo;
#pragma unroll
        for (int dt = 0; dt < 4; ++dt)
#pragma unroll
            for (int et = 0; et < 4; ++et)
#pragma unroll
                for (int r = 0; r < 4; ++r) KV[(16 * dt + r) * 512 + 16 * et] = acc[dt][et][r];
        if (es == 0 && F.tid < 256) WSP(float, WS_NK)[(su * 4 + h) * 256 + F.tid] = nk;
    }
#undef M1_PREFETCH
    __syncthreads();
}
__device__ __forceinline__ void p8_m2(Frame& F) {
    const int gt = F.vcu * NTHREADS + F.tid, NT = F.G * NTHREADS;
    const float* SUA = WSP(float, WS_SUA); const float* SUB = WSP(float, WS_SUB); const float* KV = WSP(float, WS_KV); bf16* C0 = WSP(bf16, WS_C0);
    LAS float* s_ab = (LAS float*)F.lds;
    __syncthreads();
    if (F.tid < 128) { s_ab[F.tid] = SUA[F.tid]; s_ab[128 + F.tid] = SUB[F.tid]; }
    __syncthreads();
    for (int idx2 = gt; idx2 < NH * 131072 / 2; idx2 += NT) {
        const int idx = idx2 * 2, h = idx >> 17, de = idx & 131071; float st0 = 0.f, st1 = 0.f, m = 0.f;
        f32x2 kv[32];
#pragma unroll
        for (int su = 0; su < 32; ++su) kv[su] = __builtin_nontemporal_load((const f32x2*)(KV + (size_t)(su * 4 + h) * 131072 + de));
#pragma unroll
        for (int su = 0; su < 32; ++su) {
            *(unsigned*)(C0 + (size_t)(su * 4 + h) * 131072 + de) = cvt_pk_bf16(st0, st1);
            const float A = s_ab[su * 4 + h], B = s_ab[128 + su * 4 + h], Mx = fmaxf(m, A), al = __expf(m - Mx), be = __expf(A - Mx);
            st0 = al * st0 + be * kv[su].x; st1 = al * st1 + be * kv[su].y; m = B + Mx;
        }
        *(f32x2*)(F.out + O_CP + idx) = (f32x2){st0, st1};
    }
    for (int idx = gt; idx < NH * 256; idx += NT) {
        const int h = idx >> 8, d = idx & 255; float st = 0.f, m = 0.f;
        float nk[32], sa[32], sb[32];
#pragma unroll
        for (int su = 0; su < 32; ++su) { nk[su] = WSP(float, WS_NK)[(su * 4 + h) * 256 + d]; sa[su] = SUA[su * 4 + h]; sb[su] = SUB[su * 4 + h]; }
#pragma unroll
        for (int su = 0; su < 32; ++su) {
            WSP(float, WS_N0)[(su * 4 + h) * 256 + d] = st; if (d == 0) WSP(float, WS_M0)[su * 4 + h] = m;
            const float A = sa[su], B = sb[su], Mx = fmaxf(m, A);
            st = __expf(m - Mx) * st + __expf(A - Mx) * nk[su]; m = B + Mx;
        }
        F.out[O_NP + idx] = st; if (d == 0) F.out[O_MP + h] = m;
    }
    { const float* sc = F.in[I_SC]; bf16* dst = C0 + (size_t)128 * 131072;
      for (int idx = gt; idx < 64 * 131072 / 4; idx += NT) { const f32x4 v = __builtin_nontemporal_load((const f32x4*)(sc + (size_t)idx * 4)); u32x2 w; w.x = cvt_pk_bf16(v.x, v.y); w.y = cvt_pk_bf16(v.z, v.w); *(u32x2*)(dst + (size_t)idx * 4) = w; }
      for (int idx = gt; idx < 64 * 256; idx += NT) WSP(float, WS_N0)[128 * 256 + idx] = F.in[I_SN][idx];
      for (int idx = gt; idx < 64; idx += NT) WSP(float, WS_M0)[128 + idx] = F.in[I_SM][idx]; }
}
__device__ __forceinline__ void p8_m4(Frame& F) {
    LAS float* kw = (LAS float*)F.lds;
    LAS float* vv = (LAS float*)(F.lds + 16384);
    const bf16* Kg = WSP(bf16, WS_K); const bf16* PB = WSP(bf16, WS_PB);
    for (int unit4 = F.vcu; unit4 < 256; unit4 += F.G) {
        const int unit = unit4 >> 2, dq = unit4 & 3, b = unit >> 2, h = unit & 3, su = 32 + b, row0 = su_row0(su);
        const float A = WSP(float, WS_SUA)[su * 4 + h], B = WSP(float, WS_SUB)[su * 4 + h], m0 = F.in[I_SM][b * 4 + h], Mx = fmaxf(m0, A), alpha = __expf(m0 - Mx);
        __syncthreads();
        { const int s = F.tid >> 5, c8 = (F.tid & 31) * 8;
          const u32x4 kq = *(const u32x4*)(Kg + (size_t)(row0 + s) * 1024 + h * 256 + c8); const float wgt = __expf(WSP(float, WS_AARR)[(size_t)h * T + row0 + s] - Mx);
          u32x4 vq[2];
#pragma unroll
          for (int i = 0; i < 2; ++i) { const int c = F.tid + 512 * i, sv = c >> 6, cc = c & 63; vq[i] = *(const u32x4*)(PB + (size_t)(row0 + sv) * 8192 + 2048 + h * 512 + cc * 8); }
          LAS f32x4* kd = (LAS f32x4*)(kw + s * 256 + c8);
          kd[0] = (f32x4){bflo(kq.x) * wgt, bfhi(kq.x) * wgt, bflo(kq.y) * wgt, bfhi(kq.y) * wgt}; kd[1] = (f32x4){bflo(kq.z) * wgt, bfhi(kq.z) * wgt, bflo(kq.w) * wgt, bfhi(kq.w) * wgt};
#pragma unroll
          for (int i = 0; i < 2; ++i) { const int c = F.tid + 512 * i, sv = c >> 6, cc = c & 63; LAS f32x4* vd = (LAS f32x4*)(vv + sv * 512 + cc * 8);
              vd[0] = (f32x4){bflo(vq[i].x), bfhi(vq[i].x), bflo(vq[i].y), bfhi(vq[i].y)}; vd[1] = (f32x4){bflo(vq[i].z), bfhi(vq[i].z), bflo(vq[i].w), bfhi(vq[i].w)}; } }
        __syncthreads();
        const int e4 = F.tid & 127, dg = F.tid >> 7;
        f32x4 vr[16];
#pragma unroll
        for (int s = 0; s < 16; ++s) vr[s] = *(const LAS f32x4*)(vv + s * 512 + e4 * 4);
        const float* c0 = F.in[I_SC] + (size_t)(b * 4 + h) * 131072; float* co = F.out + O_CS + (size_t)(b * 4 + h) * 131072;
        for (int d0 = 64 * dq + dg; d0 < 64 * dq + 64; d0 += 32) {
            f32x4 a[8];
#pragma unroll
            for (int u = 0; u < 8; ++u) a[u] = __builtin_nontemporal_load((const f32x4*)(c0 + (size_t)(d0 + 4 * u) * 512 + e4 * 4));
#pragma unroll
            for (int u = 0; u < 8; ++u) { a[u] = a[u] * alpha;
#pragma unroll
                for (int s = 0; s < 16; ++s) a[u] += vr[s] * kw[s * 256 + d0 + 4 * u];
                __builtin_nontemporal_store(a[u], (f32x4*)(co + (size_t)(d0 + 4 * u) * 512 + e4 * 4)); }
        }
        if (dq == 0 && F.tid < 256) { float a = F.in[I_SN][(b * 4 + h) * 256 + F.tid] * alpha;
#pragma unroll
            for (int s = 0; s < 16; ++s) a += kw[s * 256 + F.tid];
            F.out[O_NS + (b * 4 + h) * 256 + F.tid] = a; }
        if (dq == 0 && F.tid == 0) F.out[O_MS + b * 4 + h] = B + Mx;
    }
    __syncthreads();
}
__device__ __forceinline__ void glu_tail_fixup(Frame& F) {
    const int gt = F.vcu * NTHREADS + F.tid, NT = F.G * NTHREADS;
    const float* SL = WSP(float, WS_SLAB); const bf16* Gb = WSP(bf16, WS_G); bf16* MIX = WSP(bf16, WS_HA);
    for (int i = gt; i < 256 * 2048 / 4; i += NT) {
        const int r = i >> 9, c4 = (i & 511) * 4;
        f32x4 z = *(const f32x4*)(F.in[I_BGLU] + c4);
#pragma unroll
        for (int ch = 0; ch < 8; ++ch) z += *(const f32x4*)(SL + ((size_t)ch * 256 + r) * 2048 + c4);
        const u32x2 gw = *(const u32x2*)(Gb + (size_t)(TP + r) * 2048 + c4);
        u32x2 o; o.x = cvt_pk_bf16(bflo(gw.x) * sigmoidf_(z.x), bfhi(gw.x) * sigmoidf_(z.y)); o.y = cvt_pk_bf16(bflo(gw.y) * sigmoidf_(z.z), bfhi(gw.y) * sigmoidf_(z.w));
        *(u32x2*)(MIX + (size_t)(TP + r) * 4096 + 2048 + c4) = o;
    }
}
__device__ __forceinline__ void p9_m3(Frame& F) {
    constexpr int QP = 528, VP = 1040, PP = 144;
    constexpr int OFF_Q = 0, OFF_K = 64 * QP, OFF_V = OFF_K + 64 * QP, OFF_P = OFF_V + 64 * VP, OFF_S = OFF_P + 64 * PP;
    static_assert(OFF_S + 8192 <= LDS_MISC, "M3 LDS");
    LAS unsigned char* QT = F.lds + OFF_Q; LAS unsigned char* KT = F.lds + OFF_K; LAS unsigned char* VT = F.lds + OFF_V; LAS unsigned char* PT = F.lds + OFF_P;
    LAS float* s_a = (LAS float*)(F.lds + OFF_S);
    LAS float* s_M = s_a + 64;
    LAS float* s_w = s_M + 64;
    LAS float* s_em = s_w + 64;
    LAS float* s_den = s_em + 64;
    LAS float* s_n0 = s_den + 64;
    LAS float* s_dp = s_n0 + 256;
    LAS float* s_rs = s_dp + 256;
    volatile LAS int* s_unit = (volatile LAS int*)(s_rs + 256);
    const bf16* Qg = WSP(bf16, WS_Q); const bf16* Kg = WSP(bf16, WS_K); const bf16* PB = WSP(bf16, WS_PB); const bf16* C0 = WSP(bf16, WS_C0); bf16* MIX = WSP(bf16, WS_HA);
    unsigned* ticket = (unsigned*)(F.ws + WS_CTL) + 16384 + 64 * (3 + 16 * F.pp);
    int lane_l = F.lane, tid_l = F.tid; asm volatile("" : "+v"(lane_l), "+v"(tid_l));
    const int w = F.wave, fr = lane_l & 15, fq = lane_l >> 4, tid = tid_l, wt2 = w >> 2, we = w & 3;
    if (tid == 0) s_unit[0] = (int)__hip_atomic_fetch_add(ticket, 1u, __ATOMIC_RELAXED, __HIP_MEMORY_SCOPE_AGENT);
    for (;;) {
        __syncthreads();
        const int unit = s_unit[0];
        if (unit >= 576) break;
        int nextu = 0; if (tid == 0) nextu = (int)__hip_atomic_fetch_add(ticket, 1u, __ATOMIC_RELAXED, __HIP_MEMORY_SCOPE_AGENT);
        int su, h, lt;
        if (unit < 512) { lt = 3 - (unit >> 7); su = (unit & 127) >> 2; h = unit & 3; } else { lt = 0; su = 32 + ((unit - 512) >> 2); h = unit & 3; }
        const int row0 = su_row0(su), len = su_len(su), t0 = row0 + 64 * lt, nvt = (len - 64 * lt) < 64 ? (len - 64 * lt) : 64;
        const float m0 = WSP(float, WS_M0)[su * 4 + h];
        const bf16* C0u = C0 + (size_t)(su * 4 + h) * 131072;
        const int nit = lt + 5;
        u32x4 pk[4], pv[8]; float pa = 0.f;
#define M3_PREFETCH(IT) do { const int it_ = (IT); int tq_ = tid; asm volatile("" : "+v"(tq_)); \
        if (it_ <= lt) { const int s0_ = row0 + 64 * it_, nvs_ = (len - 64 * it_) < 64 ? (len - 64 * it_) : 64; \
            _Pragma("unroll") for (int i = 0; i < 4; ++i) { const int c = tq_ + 512 * i, row = c >> 5, cc = c & 31; \
                pk[i] = (u32x4){0u, 0u, 0u, 0u}; if (row < nvs_) pk[i] = *(const u32x4*)(Kg + (size_t)(s0_ + row) * 1024 + h * 256 + cc * 8); } \
            _Pragma("unroll") for (int i = 0; i < 8; ++i) { const int c = tq_ + 512 * i, row = c >> 6, cc = c & 63; \
                pv[i] = (u32x4){0u, 0u, 0u, 0u}; if (row < nvs_) pv[i] = *(const u32x4*)(PB + (size_t)(s0_ + row) * 8192 + 2048 + h * 512 + cc * 8); } \
            if (tq_ < 64) pa = (tq_ < nvs_) ? WSP(float, WS_AARR)[(size_t)h * T + s0_ + tq_] : -INFINITY; } \
        else { const int ds_ = it_ - lt - 1; \
            _Pragma("unroll") for (int i = 0; i < 8; ++i) { const int c = tq_ + 512 * i, row = c >> 6, cc = c & 63; pv[i] = *(const u32x4*)(C0u + (size_t)(64 * ds_ + row) * 512 + cc * 8); } } } while (0)
        M3_PREFETCH(0);
        { u32x4 qv[4];
#pragma unroll
          for (int i = 0; i < 4; ++i) { const int c = tid + 512 * i, row = c >> 5, cc = c & 31; const int rc = row < nvt ? row : nvt - 1;
              qv[i] = *(const u32x4*)(Qg + (size_t)(t0 + rc) * 1024 + h * 256 + cc * 8); if (row >= nvt) qv[i] = (u32x4){0u, 0u, 0u, 0u}; }
#pragma unroll
          for (int i = 0; i < 4; ++i) { const int c = tid + 512 * i, row = c >> 5, cc = c & 31; *(LAS u32x4*)(QT + row * QP + cc * 16) = qv[i]; } }
        if (tid < 256) s_n0[tid] = WSP(float, WS_N0)[(su * 4 + h) * 256 + tid];
        if (tid < 64) { float Mt = m0, wt = 1.f, em = 1.f;
            if (tid < nvt) { const size_t o = (size_t)h * T + t0 + tid; const float mr = WSP(float, WS_MRUN)[o], b = WSP(float, WS_BARR)[o]; Mt = fmaxf(m0, mr); wt = __expf(m0 - Mt); em = __expf(-(b + Mt)); }
            s_M[tid] = Mt; s_w[tid] = wt; s_em[tid] = em; }
        f32x4 acc[2][8];
#pragma unroll
        for (int i = 0; i < 2; ++i)
#pragma unroll
            for (int j = 0; j < 8; ++j) acc[i][j] = (f32x4){0.f, 0.f, 0.f, 0.f};
        for (int it = 0; it < nit; ++it) {
            const bool key = it <= lt;
            if (it > 0) __syncthreads();
            if (key) { int tq = tid; asm volatile("" : "+v"(tq));
#pragma unroll
                for (int i = 0; i < 4; ++i) { const int c = tq + 512 * i, row = c >> 5, cc = c & 31; *(LAS u32x4*)(KT + row * QP + cc * 16) = pk[i]; }
                if (tid < 64) s_a[tid] = pa;
            }
            { int tq = tid; asm volatile("" : "+v"(tq));
#pragma unroll
              for (int i = 0; i < 8; ++i) { const int c = tq + 512 * i, row = c >> 6, cc = c & 63; *(LAS u32x4*)(VT + row * VP + cc * 16) = pv[i]; } }
            if (it + 1 < nit) M3_PREFETCH(it + 1);
            if (!key) {
                const int ds = it - lt - 1, t = tid >> 3, part = tid & 7; const float wt = s_w[t]; const u32x4 qv = *(const LAS u32x4*)(QT + t * QP + (64 * ds + 8 * part) * 2);
                u32x4 o; o.x = cvt_pk_bf16(bflo(qv.x) * wt, bfhi(qv.x) * wt); o.y = cvt_pk_bf16(bflo(qv.y) * wt, bfhi(qv.y) * wt); o.z = cvt_pk_bf16(bflo(qv.z) * wt, bfhi(qv.z) * wt); o.w = cvt_pk_bf16(bflo(qv.w) * wt, bfhi(qv.w) * wt);
                *(LAS u32x4*)(PT + t * PP + part * 16) = o; }
            __syncthreads();
            if (key) {
                const int kt = it;
                if (kt == 0) {
                    const int t = tid >> 3, part = tid & 7; float s = 0.f;
#pragma unroll
                    for (int c4 = 0; c4 < 4; ++c4) { const u32x4 qv = *(const LAS u32x4*)(QT + t * QP + (32 * part + 8 * c4) * 2); const LAS float* nn = s_n0 + 32 * part + 8 * c4;
                        s += bflo(qv.x) * nn[0] + bfhi(qv.x) * nn[1] + bflo(qv.y) * nn[2] + bfhi(qv.y) * nn[3] + bflo(qv.z) * nn[4] + bfhi(qv.z) * nn[5] + bflo(qv.w) * nn[6] + bfhi(qv.w) * nn[7]; }
                    s += __shfl_xor(s, 1); s += __shfl_xor(s, 2); s += __shfl_xor(s, 4);
                    if (part == 0) s_den[t] = s_w[t] * s;
                }
                { const int st = w & 3, tp = w >> 2;
                  f32x4 sacc[2] = {(f32x4){0.f, 0.f, 0.f, 0.f}, (f32x4){0.f, 0.f, 0.f, 0.f}};
#pragma unroll
                  for (int kk = 0; kk < 8; ++kk) { const bf16x8 af = *(const LAS bf16x8*)(KT + (16 * st + fr) * QP + (32 * kk + 8 * fq) * 2);
#pragma unroll
                      for (int j = 0; j < 2; ++j) { const bf16x8 bq = *(const LAS bf16x8*)(QT + (16 * (2 * tp + j) + fr) * QP + (32 * kk + 8 * fq) * 2); sacc[j] = __builtin_amdgcn_mfma_f32_16x16x32_bf16(af, bq, sacc[j], 0, 0, 0); } }
#pragma unroll
                  for (int j = 0; j < 2; ++j) { const int tl = 16 * (2 * tp + j) + fr; const float Mt = s_M[tl]; float pvv[4], ps = 0.f;
#pragma unroll
                      for (int r = 0; r < 4; ++r) { const int sl = 16 * st + 4 * fq + r; const bool ok = (64 * kt + sl) <= (64 * lt + tl);
                          const float e = ok ? __expf(s_a[sl] - Mt) : 0.f; pvv[r] = ok ? sacc[j][r] * e : 0.f; ps += pvv[r]; }
                      ps += __shfl_xor(ps, 16); ps += __shfl_xor(ps, 32);
                      if (fq == 0) s_dp[tl * 4 + st] = ps;
                      u32x2 pw; pw.x = cvt_pk_bf16(pvv[0], pvv[1]); pw.y = cvt_pk_bf16(pvv[2], pvv[3]);
                      *(LAS u32x2*)(PT + tl * PP + (16 * st + 4 * fq) * 2) = pw; } }
                __syncthreads();
                if (tid < 64) s_den[tid] += (s_dp[tid * 4] + s_dp[tid * 4 + 1]) + (s_dp[tid * 4 + 2] + s_dp[tid * 4 + 3]);
            }
#pragma unroll
            for (int ks = 0; ks < 2; ++ks) {
                bf16x8 pf[2];
#pragma unroll
                for (int j = 0; j < 2; ++j) pf[j] = *(const LAS bf16x8*)(PT + (16 * (2 * wt2 + j) + fr) * PP + (32 * ks + 8 * fq) * 2);
#pragma unroll
                for (int et = 0; et < 8; ++et) { const LAS unsigned char* p = VT + (32 * ks + 8 * fq + (fr >> 2)) * VP + (128 * we + 16 * et + 4 * (fr & 3)) * 2; const bf16x8 vf = tr_frag(p, p + 4 * VP);
#pragma unroll
                    for (int j = 0; j < 2; ++j) acc[j][et] = __builtin_amdgcn_mfma_f32_16x16x32_bf16(pf[j], vf, acc[j][et], 0, 0, 0); }
            }
        }
#undef M3_PREFETCH
#pragma unroll
        for (int j = 0; j < 2; ++j)
#pragma unroll
            for (int r = 0; r < 4; ++r) { const int tl = 16 * (2 * wt2 + j) + 4 * fq + r; const float inv = 1.0f / fmaxf(fabsf(s_den[tl]), s_em[tl]); float ss = 0.f;
#pragma unroll
                for (int et = 0; et < 8; ++et) { const float hv = acc[j][et][r] * inv; acc[j][et][r] = hv; ss += hv * hv; }
                ss += __shfl_xor(ss, 1); ss += __shfl_xor(ss, 2); ss += __shfl_xor(ss, 4); ss += __shfl_xor(ss, 8);
                if (fr == 0) s_rs[tl * 4 + we] = ss; }
        __syncthreads();
        const CAS float* hn = (const CAS float*)F.in[I_HN] + h * 512 + 128 * we + fr;
        float hnv[8];
#pragma unroll
        for (int et = 0; et < 8; ++et) hnv[et] = hn[16 * et];
#pragma unroll
        for (int j = 0; j < 2; ++j) {
            bf16 ogr[4][8];
#pragma unroll
            for (int r = 0; r < 4; ++r) { const int tl = 16 * (2 * wt2 + j) + 4 * fq + r; const size_t row = (size_t)(t0 + (tl < nvt ? tl : nvt - 1));
#pragma unroll
                for (int et = 0; et < 8; ++et) ogr[r][et] = PB[row * 8192 + 4096 + h * 512 + 128 * we + 16 * et + fr]; }
#pragma unroll
            for (int r = 0; r < 4; ++r) { const int tl = 16 * (2 * wt2 + j) + 4 * fq + r;
                const float rn = rsqrtf(((s_rs[tl * 4] + s_rs[tl * 4 + 1]) + (s_rs[tl * 4 + 2] + s_rs[tl * 4 + 3])) * (1.f / 512.f) + EPS); const size_t row = (size_t)(t0 + tl);
#pragma unroll
                for (int et = 0; et < 8; ++et) { const int e = 128 * we + 16 * et + fr;
                    const float own = acc[j][et][r] * rn * hnv[et] * sigmoidf_(bf2f(ogr[r][et])), oth = __shfl_xor(own, 1);
                    if (tl < nvt && !(fr & 1)) *(unsigned*)(MIX + row * 4096 + h * 512 + e) = cvt_pk_bf16(own, oth); } } }
        if (tid == 0) s_unit[0] = nextu;
    }
}

constexpr int N_PHASES = 16;
__global__ void __launch_bounds__(NTHREADS, 2) fwd_kernel(Args args) {
    extern __shared__ __attribute__((aligned(16))) unsigned char lds_raw[];
    Frame F;
    F.lds = (LAS unsigned char*)lds_raw;
    F.tid = threadIdx.x; F.lane = F.tid & 63; F.wave = __builtin_amdgcn_readfirstlane(F.tid >> 6);
    F.G = gridDim.x; { const int bx = blockIdx.x; F.vcu = (F.G % 8 == 0) ? (bx % 8) * (F.G / 8) + bx / 8 : bx; }
    F.in = args.in; F.out = args.out; F.ws = args.ws; F.pp = 0;
    volatile LAS unsigned* MISC = (volatile LAS unsigned*)(F.lds + LDS_MISC);
    if (F.tid < 32) MISC[F.tid] = 0u;
    __syncthreads();
    const int lo = args.ph_lo, hi = args.ph_hi;
    const bool multi = (hi - lo) > 1;
    XcdBarrier bar; bar.bar = (unsigned*)(F.ws + WS_CTL) + 4096; bar.x = 0; bar.st = MISC + 8;
    if (multi) bar = xcd_barrier_post((unsigned*)(F.ws + WS_CTL) + 4096, MISC + 8);
#define IN(k) (lo <= (k) && (k) < hi)
#define SEAM(k) do { if (IN(k) && IN((k) + 1)) xcd_barrier(bar); } while (0)
    const int bx = blockIdx.x;

#define PHASE(k, ...) if (IN(k)) { __VA_ARGS__ } SEAM(k); if constexpr (((PROBE_MASK) >> (k)) & 1) { F.pp = 1; if (IN(k)) { __VA_ARGS__ } SEAM(k); F.pp = 0; }
    PHASE(0, p0_stats(F); p0_prologue(F);)
    PHASE(1,
        if (F.G == 256 && bx >= 240) convert_static<1>(F, 240);
        else { const int GG = (F.G == 256) ? 240 : F.G;
        pg8::Gemm g{WSP(bf16, WS_HA), WSP(bf16, WS_W1GU), D, D, D, 0, 0}; pg8::StaticOrder S; S.init(T / 256, 2 * DFF / 256, 1, GG, bx);
        pg8::EpiSwiGLU E{WSP(bf16, WS_HID), DFF};
        pg8::gemm_phase<pg8::EpiSwiGLU, pg8::StaticOrder, true, true>(F.lds, g, S, E);
        if (F.G != 256) convert_static<1>(F, 0); })
    PHASE(2,
        pg8::Gemm g{WSP(bf16, WS_HID), WSP(bf16, WS_W1D), DFF, DFF, DFF, 0, 0}; pg8::StaticOrder S; S.init(32, D / 256, 1, F.G, bx);
        pg8::EpiBf16 E{WSP(bf16, WS_DBUF), D};
        pg8::gemm_phase<pg8::EpiBf16, pg8::StaticOrder, true, true>(F.lds, g, S, E);
        gemm_tail_splitk<172>(F, WSP(bf16, WS_HID), DFF, WSP(bf16, WS_W1D), DFF);)
    PHASE(3, row_pass<0>(F, WSP(float, WS_DBUF), F.in[I_F1POST], 0.5f, F.in[I_MIXPRE], WSP(bf16, WS_HA));)
    PHASE(4,
        if (F.G == 256 && bx >= 224) convert_static<2>(F, 224);
        else { const int GG = (F.G == 256) ? 224 : F.G;
        pg8::Gemm g{WSP(bf16, WS_HA), WSP(bf16, WS_WIN), D, D, D, 0, 0}; pg8::StaticOrder S; S.init(T / 256, 33, 1, GG, bx);
        pg8::EpiWin E{WSP(bf16, WS_PB), WSP(float, WS_GATES)};
        pg8::gemm_phase<pg8::EpiWin, pg8::StaticOrder, true, true>(F.lds, g, S, E);
        if (F.G != 256) convert_static<2>(F, 0); })
    PHASE(5, p5_conv(F); p5_gates(F); p5_s5_local(F);)
    PHASE(6,
        pg8::Gemm g{WSP(bf16, WS_CV), WSP(bf16, WS_WQK), 2048, 512, 512, 512, (size_t)512 * 512}; pg8::StaticOrder S; S.init(32, 2, 4, F.G, bx);
        pg8::EpiQK E{WSP(bf16, WS_Q), WSP(bf16, WS_K)};
        pg8::gemm_phase<pg8::EpiQK, pg8::StaticOrder, true, true>(F.lds, g, S, E);)
    PHASE(7, p7_m1(F); p7_sample_qk(F); p7_s5_final(F);)
    PHASE(8,
        p8_m2(F); p8_m4(F);
        pg8::Gemm g{WSP(bf16, WS_G), WSP(bf16, WS_WGLU), 2048, 2048, 2048, 0, 0}; pg8::StaticOrder S; S.init(32, 8, 1, F.G, bx);
        pg8::EpiGLU E{WSP(bf16, WS_G), F.in[I_BGLU], WSP(bf16, WS_HA)};
        pg8::gemm_phase<pg8::EpiGLU, pg8::StaticOrder, true, true>(F.lds, g, S, E);
        if (F.vcu >= 64 && F.vcu < 128) {
            const int c = F.vcu - 64, pn = c & 7, ch = c >> 3;
            pg8::Gemm gt{WSP(bf16, WS_G) + (size_t)TP * 2048 + (size_t)ch * 256, WSP(bf16, WS_WGLU) + (size_t)ch * 256, 2048, 2048, 256, 0, 0};
            pg8::OneUnit S1{pn}; pg8::EpiF32 E1{WSP(float, WS_SLAB) + (size_t)ch * 256 * 2048, 2048};
            pg8::gemm_phase<pg8::EpiF32, pg8::OneUnit, true, true>(F.lds, gt, S1, E1); })
    PHASE(9, glu_tail_fixup(F); p9_m3(F);)
    PHASE(10,
        pg8::Gemm g{WSP(bf16, WS_HA), WSP(bf16, WS_WOUT), D, D, D, 0, 0}; pg8::StaticOrder S; S.init(32, D / 256, 1, F.G, bx);
        pg8::EpiBf16 E{WSP(bf16, WS_DBUF), D};
        pg8::gemm_phase<pg8::EpiBf16, pg8::StaticOrder, true, true>(F.lds, g, S, E);
        gemm_tail_splitk<64>(F, WSP(bf16, WS_HA), D, WSP(bf16, WS_WOUT), D);)
    if (IN(11)) { row_pass<1>(F, WSP(float, WS_DBUF), F.in[I_MIXPOST], 1.0f, F.in[I_F2PRE], WSP(bf16, WS_HQ)); } SEAM(11);
    PHASE(12,
        if (F.G == 256 && bx >= 240) convert_static<3>(F, 240);
        else { const int GG = (F.G == 256) ? 240 : F.G;
        pg8::Gemm g{WSP(bf16, WS_HQ), WSP(bf16, WS_W2GU), D / 2, D / 2, D / 2, 0, 0}; pg8::StaticOrder S; S.init(T / 256, 2 * DFF / 256, 1, GG, bx);
        pg8::EpiSwiGLU8 E{WSP(bf16, WS_HID), DFF, WSP(float, WS_SA), wscale(F, 2), wscale(F, 3)};
        pg8::gemm_phase<pg8::EpiSwiGLU8, pg8::StaticOrder, true, true, false, true>(F.lds, g, S, E);
        if (F.G != 256) convert_static<3>(F, 0); })
    PHASE(13, p13_quant(F);)
    PHASE(14,
        pg8::Gemm g{WSP(bf16, WS_HID8), WSP(bf16, WS_W2D), DFF / 2, DFF / 2, DFF / 2, 0, 0}; pg8::StaticOrder S; S.init(32, D / 256, 1, F.G, bx);
        pg8::EpiBf16S E{WSP(bf16, WS_DBUF), D, WSP(float, WS_SA2), wscale(F, 4)};
        pg8::gemm_phase<pg8::EpiBf16S, pg8::StaticOrder, true, true, false, true>(F.lds, g, S, E);
        gemm_tail_splitk<86, true>(F, WSP(bf16, WS_HID8), DFF / 2, WSP(bf16, WS_W2D), DFF / 2, WSP(float, WS_SA2), wscale(F, 4));)
    if (IN(15)) { row_pass<2>(F, WSP(float, WS_DBUF), F.in[I_F2POST], 0.5f, nullptr, nullptr); }
#undef PHASE
#undef IN
#undef SEAM
}

extern "C" void kernel_launch(void* const* d_in, const int* in_sizes, int n_in, void* d_out, int out_size, void* d_ws, size_t ws_size, hipStream_t stream) {
    static int grid = 0;
    if (grid == 0) {
        if (n_in != N_IN || out_size != (int)O_END || ws_size < WS_END) { fprintf(stderr, "kernel_launch: unexpected shapes (n_in %d, out %d, ws %zu, need %zu)\n", n_in, out_size, ws_size, (size_t)WS_END); grid = -1; return; }
        int dev = 0, cus = 0;
        if (hipGetDevice(&dev) != hipSuccess || hipDeviceGetAttribute(&cus, hipDeviceAttributeMultiprocessorCount, dev) != hipSuccess) { grid = -1; return; }
        if (hipFuncSetAttribute((const void*)fwd_kernel, hipFuncAttributeMaxDynamicSharedMemorySize, LDS_BYTES) != hipSuccess) { fprintf(stderr, "kernel_launch: hipFuncSetAttribute failed\n"); grid = -1; return; }
        int per_cu = 0; (void)hipOccupancyMaxActiveBlocksPerMultiprocessor(&per_cu, (const void*)fwd_kernel, NTHREADS, LDS_BYTES); (void)hipGetLastError();
        grid = cus;
    }
    if (grid < 0) return;
    (void)hipMemsetAsync((char*)d_ws + WS_CTL, 0, CTL_BYTES, stream);
    Args a{};
    for (int i = 0; i < N_IN; ++i) a.in[i] = (const float*)d_in[i];
    a.out = (float*)d_out; a.ws = (unsigned char*)d_ws;
#if MK_ONE_LAUNCH
    a.ph_lo = 0; a.ph_hi = N_PHASES;
    hipLaunchKernelGGL(fwd_kernel, dim3(grid), dim3(NTHREADS), LDS_BYTES, stream, a);
#else
    for (int p = 0; p < N_PHASES; ++p) { a.ph_lo = p; a.ph_hi = p + 1; hipLaunchKernelGGL(fwd_kernel, dim3(grid), dim3(NTHREADS), LDS_BYTES, stream, a); }
#endif
}
```

```cpp
#include <hip/hip_runtime.h>
#include <cstdio>
#include <cstdint>
#include <type_traits>

#define MK_ONE_LAUNCH 1
#ifndef PROBE_MASK
#define PROBE_MASK 0
#endif

#define GAS __attribute__((address_space(1)))
#define LAS __attribute__((address_space(3)))
#define CAS __attribute__((address_space(4)))
typedef unsigned short bf16;
typedef short bf16x8 __attribute__((ext_vector_type(8)));
typedef short s16x4 __attribute__((ext_vector_type(4)));
typedef float f32x4 __attribute__((ext_vector_type(4)));
typedef float f32x2 __attribute__((ext_vector_type(2)));
typedef unsigned u32x4 __attribute__((ext_vector_type(4)));
typedef unsigned u32x2 __attribute__((ext_vector_type(2)));
typedef int i32x4 __attribute__((ext_vector_type(4)));

constexpr int D = 4096, TP = 8192, T = 8448, DFF = 11008, DM = 2048, NH = 4, DV = 512, DQK = 256;
constexpr int NG = 128, NP = 64, NJ = 16;
constexpr int NSU = 48;
constexpr float EPS = 1e-6f;
constexpr int NWAVES = 8, NTHREADS = 512;

__host__ __device__ __forceinline__ int su_row0(int su) { return su < 32 ? su * 256 : TP + (su - 32) * 16; }
__host__ __device__ __forceinline__ int su_len(int su) { return su < 32 ? 256 : 16; }

constexpr size_t O_Y = 0, O_CP = 34603008, O_NP = O_CP + 524288, O_MP = O_NP + 1024, O_CONVP = O_MP + 4, O_S5REP = O_CONVP + 6144, O_S5IMP = O_S5REP + 8192,
                 O_CS = O_S5IMP + 8192, O_NS = O_CS + 8388608, O_MS = O_NS + 16384, O_CONVS = O_MS + 64, O_S5RES = O_CONVS + 98304, O_S5IMS = O_S5RES + 131072, O_END = O_S5IMS + 131072;
static_assert(O_END == 43916356, "output size");

enum { I_XP = 0, I_XS, I_SC, I_SN, I_SM, I_CONV, I_S5RE, I_S5IM, I_F1PRE, I_F1POST, I_F1G, I_F1U, I_F1D, I_MIXPRE, I_WIN, I_CONVW, I_CONVB, I_WQ, I_WK, I_BI, I_BF, I_HN,
       I_ARE, I_AIM, I_LOGDT, I_BRE, I_BIM, I_CRE, I_CIM, I_S5D, I_WGLU, I_BGLU, I_WOUT, I_MIXPOST, I_F2PRE, I_F2POST, I_F2G, I_F2U, I_F2D, N_IN };
static_assert(N_IN == 39, "inputs");

constexpr size_t al256(size_t x) { return (x + 255) & ~(size_t)255; }
constexpr size_t WS_CTL = 0, CTL_BYTES = 1u << 20;
constexpr size_t WS_W1GU = WS_CTL + CTL_BYTES;
constexpr size_t SZ_WGU = (size_t)2 * DFF * D * 2, SZ_WD = (size_t)D * DFF * 2;
constexpr size_t WS_W1D = WS_W1GU + SZ_WGU;
constexpr size_t WS_W2GU = WS_W1D + SZ_WD;
constexpr size_t WS_W2D = WS_W2GU + SZ_WGU;
constexpr size_t WS_WIN = WS_W2D + SZ_WD;
constexpr size_t WS_WQK = WS_WIN + (size_t)8448 * D * 2;
constexpr size_t WS_WGLU = WS_WQK + (size_t)4 * 512 * 512 * 2;
constexpr size_t WS_WOUT = WS_WGLU + (size_t)2048 * 2048 * 2;
constexpr size_t WS_HA = WS_WOUT + (size_t)D * D * 2;
constexpr size_t WS_HID = WS_HA + (size_t)T * D * 2;
constexpr size_t WS_PB = WS_HID, WS_CV = WS_PB + (size_t)T * 8192 * 2;
constexpr size_t WS_DBUF = WS_HID + (size_t)T * DFF * 2;
static_assert(WS_CV + (size_t)T * 2048 * 2 <= WS_DBUF, "HID alias");
constexpr size_t WS_KV = WS_DBUF, WS_C0 = WS_KV + (size_t)128 * 131072 * 4;
constexpr size_t WS_Q = WS_DBUF + (size_t)T * D * 4;
static_assert(WS_C0 + (size_t)192 * 131072 * 2 <= WS_Q, "DBUF alias");
constexpr size_t WS_K = WS_Q + (size_t)T * 1024 * 2;
constexpr size_t WS_G = WS_K + (size_t)T * 1024 * 2;
constexpr size_t WS_GATES = WS_G + (size_t)T * 2048 * 2;
constexpr size_t WS_BARR = al256(WS_GATES + (size_t)T * 8 * 4);
constexpr size_t WS_AARR = WS_BARR + (size_t)4 * T * 4;
constexpr size_t WS_MRUN = WS_AARR + (size_t)4 * T * 4;
constexpr size_t WS_SUA = WS_MRUN + (size_t)4 * T * 4;
constexpr size_t WS_SUB = WS_SUA + 1024;
constexpr size_t WS_NK = WS_SUB + 1024;
constexpr size_t WS_N0 = WS_NK + (size_t)128 * 256 * 4;
constexpr size_t WS_M0 = WS_N0 + (size_t)192 * 256 * 4;
constexpr size_t WS_S5AB = WS_M0 + 1024;
constexpr size_t WS_S5BB = WS_S5AB + (size_t)2 * 8192 * 4;
constexpr size_t WS_S5LOC = WS_S5BB + (size_t)2 * 131072 * 4;
constexpr size_t WS_S5HIN = WS_S5LOC + (size_t)2 * 32 * 8192 * 4;
constexpr size_t WS_SLAB = al256(WS_S5HIN + (size_t)2 * 32 * 8192 * 4);
constexpr size_t WS_XR = WS_SLAB + (size_t)16 * 256 * D * 4;
constexpr size_t WS_SA = WS_XR + (size_t)T * D * 2;
constexpr size_t WS_WSTAT = al256(WS_SA + (size_t)T * 256);
constexpr size_t WS_HQ = al256(WS_WSTAT + 4 * 256 * 4);
constexpr size_t WS_SA2 = al256(WS_HQ + (size_t)T * D);
constexpr size_t WS_END = WS_SA2 + (size_t)T * 256;
constexpr size_t WS_HID8 = WS_W1GU;
static_assert((size_t)T * DFF <= SZ_WGU, "HID8 alias");

constexpr int LDS_BYTES = 155648;
constexpr int LDS_MISC = 151552;

__device__ __forceinline__ float wave_sum(float v) {
#pragma unroll
    for (int o = 1; o < 64; o <<= 1) v += __shfl_xor(v, o);
    return v;
}
__device__ __forceinline__ float wave_max(float v) {
#pragma unroll
    for (int o = 1; o < 64; o <<= 1) v = fmaxf(v, __shfl_xor(v, o));
    return v;
}
__device__ __forceinline__ unsigned q8(float x) { return (unsigned)(int)fminf(fmaxf(rintf(x), -127.f), 127.f) & 0xffu; }
__device__ __forceinline__ unsigned q8x4(float a, float b, float c, float d) { return q8(a) | (q8(b) << 8) | (q8(c) << 16) | (q8(d) << 24); }
__device__ __forceinline__ unsigned cvt_pk_bf16(float lo, float hi) { unsigned r; asm volatile("v_cvt_pk_bf16_f32 %0, %1, %2" : "=v"(r) : "v"(lo), "v"(hi)); return r; }
__device__ __forceinline__ float bflo(unsigned w) { return __uint_as_float(w << 16); }
__device__ __forceinline__ float bfhi(unsigned w) { return __uint_as_float(w & 0xffff0000u); }
__device__ __forceinline__ float bf2f(bf16 v) { return __uint_as_float(((unsigned)v) << 16); }
__device__ __forceinline__ bf16 f2bf(float f) { return (bf16)(cvt_pk_bf16(f, 0.f) & 0xffffu); }
__device__ __forceinline__ float sigmoidf_(float x) { return __builtin_amdgcn_rcpf(1.0f + __builtin_amdgcn_exp2f(-1.4426950408889634f * x)); }
__device__ __forceinline__ float siluf_(float x) { return x * __builtin_amdgcn_rcpf(1.0f + __builtin_amdgcn_exp2f(-1.4426950408889634f * x)); }
__device__ __forceinline__ float gelu_tanh(float x) { const float u = -2.302208198f * (x + 0.044715f * x * x * x); return x * __builtin_amdgcn_rcpf(1.0f + __builtin_amdgcn_exp2f(u)); }
__device__ __forceinline__ float logsigmoidf_(float x) { return fminf(x, 0.f) - log1pf(__expf(-fabsf(x))); }

namespace pg8 {
typedef unsigned short bf16_t;
constexpr int BM = 256, BK = 64, HALF = 128, HTB = HALF * BK * 2, STAGE_BYTES = 8 * HTB, NXCD = 8, WGM = 8;
__host__ __device__ __forceinline__ int lds_byte(int r, int c) { const int st = (r >> 4) * 2 + (c >> 5), rr = r & 15, cc = c & 31, ob = rr * 64 + cc * 2; return st * 1024 + (ob ^ (((ob >> 9) & 1) << 5)); }
__host__ __device__ __forceinline__ void stage_rc(int b, int& R, int& C) { const int st = b / 1024, sb = b % 1024, swz = sb ^ (((sb >> 9) & 1) << 5); R = (st >> 1) * 16 + swz / 64; C = (st & 1) * 32 + (swz % 64) / 2; }
__host__ __device__ __forceinline__ int perm32(int rho) { const int n = rho >> 4, i = rho & 15; return 8 * (i >> 2) + 4 * n + (i & 3); }

struct Unit { int pm, pn, z; };
struct Gemm { const bf16_t* A; const bf16_t* Bt; int lda, ldb, K; size_t zA, zB; };

struct StaticOrder {
    int nM, nN, nZ, nwg, G, c;
    __host__ __device__ void init(int nM_, int nN_, int nZ_, int G_, int c_) { nM = nM_; nN = nN_; nZ = nZ_; nwg = nM * nN; G = G_; c = c_; }
    __host__ __device__ bool next(int i, Unit& u) const {
        const long L = (long)i * G + c; if (L >= (long)nwg * nZ) return false;
        u.z = (int)(L / nwg);
        int wgid = (int)(L % nwg); { const int q = nwg / NXCD, r = nwg % NXCD, xcd = wgid % NXCD, off = wgid / NXCD; wgid = (xcd < r ? xcd * (q + 1) : r * (q + 1) + (xcd - r) * q) + off; }
        const int nig = WGM * nN, gid = wgid / nig, fm = gid * WGM, gsz = (nM - fm) < WGM ? (nM - fm) : WGM;
        u.pm = fm + ((wgid % nig) % gsz); u.pn = (wgid % nig) / gsz; return true;
    }
    __device__ __forceinline__ void a_ready(const Unit&) const {}
    __device__ __forceinline__ void done(const Unit&) const {}
};

struct EpiF32 {
    static constexpr bool PERM = false;
    float* C; int ldc;
    __device__ __forceinline__ void operator()(const f32x4 (&acc)[2][2][4][2], const Unit& u, int wr, int wc, int fr, int fq) const {
        const int row0 = u.pm * BM + wr * 64 + fr, col0 = u.pn * BM + wc * 32 + 4 * fq;
#pragma unroll
        for (int ai = 0; ai < 2; ++ai)
#pragma unroll
            for (int m = 0; m < 4; ++m) { float* rowp = C + (size_t)(row0 + ai * HALF + m * 16) * ldc + col0;
#pragma unroll
                for (int bj = 0; bj < 2; ++bj)
#pragma unroll
                    for (int n = 0; n < 2; ++n) *(f32x4*)(rowp + bj * HALF + n * 16) = acc[ai][bj][m][n]; }
    }
};
struct EpiBf16 {
    static constexpr bool PERM = true;
    bf16_t* O; int ldc;
    __device__ __forceinline__ void operator()(const f32x4 (&acc)[2][2][4][2], const Unit& u, int wr, int wc, int fr, int fq) const {
        const int row0 = u.pm * BM + wr * 64 + fr, col0 = u.pn * BM + wc * 32 + 8 * fq;
#pragma unroll
        for (int ai = 0; ai < 2; ++ai)
#pragma unroll
            for (int m = 0; m < 4; ++m) { bf16_t* rowp = O + (size_t)(row0 + ai * HALF + m * 16) * ldc + col0;
#pragma unroll
                for (int bj = 0; bj < 2; ++bj) { const f32x4 v0 = acc[ai][bj][m][0], v1 = acc[ai][bj][m][1];
                    u32x4 w; w.x = cvt_pk_bf16(v0[0], v0[1]); w.y = cvt_pk_bf16(v0[2], v0[3]); w.z = cvt_pk_bf16(v1[0], v1[1]); w.w = cvt_pk_bf16(v1[2], v1[3]);
                    *(u32x4*)(rowp + bj * HALF) = w; } }
    }
};
struct EpiBf16S {
    static constexpr bool PERM = true;
    bf16_t* O; int ldc; const float* sa; float sw;
    __device__ __forceinline__ void operator()(const i32x4 (&acc)[2][2][4][2], const Unit& u, int wr, int wc, int fr, int fq) const {
        const int row0 = u.pm * BM + wr * 64 + fr, col0 = u.pn * BM + wc * 32 + 8 * fq;
        float s8[2][4];
#pragma unroll
        for (int ai = 0; ai < 2; ++ai)
#pragma unroll
            for (int m = 0; m < 4; ++m) s8[ai][m] = sa[(size_t)(row0 + ai * HALF + m * 16) * 64] * sw;
#pragma unroll
        for (int ai = 0; ai < 2; ++ai)
#pragma unroll
            for (int m = 0; m < 4; ++m) { bf16_t* rowp = O + (size_t)(row0 + ai * HALF + m * 16) * ldc + col0; const float s = s8[ai][m];
#pragma unroll
                for (int bj = 0; bj < 2; ++bj) { const i32x4 v0 = acc[ai][bj][m][0], v1 = acc[ai][bj][m][1];
                    u32x4 w; w.x = cvt_pk_bf16((float)v0[0] * s, (float)v0[1] * s); w.y = cvt_pk_bf16((float)v0[2] * s, (float)v0[3] * s); w.z = cvt_pk_bf16((float)v1[0] * s, (float)v1[1] * s); w.w = cvt_pk_bf16((float)v1[2] * s, (float)v1[3] * s);
                    *(u32x4*)(rowp + bj * HALF) = w; } }
    }
};
struct EpiF32S {
    static constexpr bool PERM = false;
    float* C; int ldc; const float* sa; float sw;
    __device__ __forceinline__ void operator()(const i32x4 (&acc)[2][2][4][2], const Unit& u, int wr, int wc, int fr, int fq) const {
        const int row0 = u.pm * BM + wr * 64 + fr, col0 = u.pn * BM + wc * 32 + 4 * fq;
        float s8[2][4];
#pragma unroll
        for (int ai = 0; ai < 2; ++ai)
#pragma unroll
            for (int m = 0; m < 4; ++m) s8[ai][m] = sa[(size_t)(row0 + ai * HALF + m * 16) * 64] * sw;
#pragma unroll
        for (int ai = 0; ai < 2; ++ai)
#pragma unroll
            for (int m = 0; m < 4; ++m) { float* rowp = C + (size_t)(row0 + ai * HALF + m * 16) * ldc + col0; const float s = s8[ai][m];
#pragma unroll
                for (int bj = 0; bj < 2; ++bj)
#pragma unroll
                    for (int n = 0; n < 2; ++n) { const i32x4 v = acc[ai][bj][m][n]; *(f32x4*)(rowp + bj * HALF + n * 16) = (f32x4){(float)v[0] * s, (float)v[1] * s, (float)v[2] * s, (float)v[3] * s}; } }
    }
};
struct OneUnit {
    int pn;
    __device__ __forceinline__ bool next(int i, Unit& u) const { if (i) return false; u.pm = 0; u.pn = pn; u.z = 0; return true; }
    __device__ __forceinline__ void a_ready(const Unit&) const {}
    __device__ __forceinline__ void done(const Unit&) const {}
};
struct EpiF32Atomic {
    static constexpr bool PERM = false;
    float* C; int ldc;
    __device__ __forceinline__ void operator()(const f32x4 (&acc)[2][2][4][2], const Unit& u, int wr, int wc, int fr, int fq) const {
        const int row0 = u.pm * BM + wr * 64 + fr, col0 = u.pn * BM + wc * 32 + 4 * fq;
#pragma unroll
        for (int ai = 0; ai < 2; ++ai)
#pragma unroll
            for (int m = 0; m < 4; ++m) { float* rowp = C + (size_t)(row0 + ai * HALF + m * 16) * ldc + col0;
#pragma unroll
                for (int bj = 0; bj < 2; ++bj)
#pragma unroll
                    for (int n = 0; n < 2; ++n) { float* p = rowp + bj * HALF + n * 16; const f32x4 v = acc[ai][bj][m][n];
                        unsafeAtomicAdd(p, v[0]); unsafeAtomicAdd(p + 1, v[1]); unsafeAtomicAdd(p + 2, v[2]); unsafeAtomicAdd(p + 3, v[3]); } }
    }
};
struct EpiSwiGLU {
    static constexpr bool PERM = true;
    bf16_t* O; int ldc;
    __device__ __forceinline__ void operator()(const f32x4 (&acc)[2][2][4][2], const Unit& u, int wr, int wc, int fr, int fq) const {
        const int row0 = u.pm * BM + wr * 64 + fr, col0 = u.pn * HALF + wc * 32 + 8 * fq;
#pragma unroll
        for (int ai = 0; ai < 2; ++ai)
#pragma unroll
            for (int m = 0; m < 4; ++m) { bf16_t* rowp = O + (size_t)(row0 + ai * HALF + m * 16) * ldc + col0;
                const f32x4 g0 = acc[ai][0][m][0], g1 = acc[ai][0][m][1], u0 = acc[ai][1][m][0], u1 = acc[ai][1][m][1];
                float h[8];
#pragma unroll
                for (int j = 0; j < 4; ++j) { h[j] = siluf_(g0[j]) * u0[j]; h[4 + j] = siluf_(g1[j]) * u1[j]; }
                u32x4 w; w.x = cvt_pk_bf16(h[0], h[1]); w.y = cvt_pk_bf16(h[2], h[3]); w.z = cvt_pk_bf16(h[4], h[5]); w.w = cvt_pk_bf16(h[6], h[7]);
                *(u32x4*)rowp = w; }
    }
};
struct EpiSwiGLU8 {
    static constexpr bool PERM = true;
    bf16_t* O; int ldc; const float* sa; float swg, swu;
    __device__ __forceinline__ void operator()(const i32x4 (&acc)[2][2][4][2], const Unit& u, int wr, int wc, int fr, int fq) const {
        const int row0 = u.pm * BM + wr * 64 + fr, col0 = u.pn * HALF + wc * 32 + 8 * fq;
        float s8[2][4];
#pragma unroll
        for (int ai = 0; ai < 2; ++ai)
#pragma unroll
            for (int m = 0; m < 4; ++m) s8[ai][m] = sa[(size_t)(row0 + ai * HALF + m * 16) * 64];
#pragma unroll
        for (int ai = 0; ai < 2; ++ai)
#pragma unroll
            for (int m = 0; m < 4; ++m) { const int row = row0 + ai * HALF + m * 16; bf16_t* rowp = O + (size_t)row * ldc + col0;
                const float s = s8[ai][m], sg = s * swg, su = s * swu;
                const i32x4 g0 = acc[ai][0][m][0], g1 = acc[ai][0][m][1], u0 = acc[ai][1][m][0], u1 = acc[ai][1][m][1];
                float h[8];
#pragma unroll
                for (int j = 0; j < 4; ++j) { h[j] = siluf_((float)g0[j] * sg) * ((float)u0[j] * su); h[4 + j] = siluf_((float)g1[j] * sg) * ((float)u1[j] * su); }
                u32x4 w; w.x = cvt_pk_bf16(h[0], h[1]); w.y = cvt_pk_bf16(h[2], h[3]); w.z = cvt_pk_bf16(h[4], h[5]); w.w = cvt_pk_bf16(h[6], h[7]);
                *(u32x4*)rowp = w; }
    }
};
struct EpiWin {
    static constexpr bool PERM = true;
    bf16_t* PB; float* GATES;
    __device__ __forceinline__ void operator()(const f32x4 (&acc)[2][2][4][2], const Unit& u, int wr, int wc, int fr, int fq) const {
        const int row0 = u.pm * BM + wr * 64 + fr;
        if (u.pn < 32) {
            const int col0 = u.pn * BM + wc * 32 + 8 * fq;
#pragma unroll
            for (int ai = 0; ai < 2; ++ai)
#pragma unroll
                for (int m = 0; m < 4; ++m) { bf16_t* rowp = PB + (size_t)(row0 + ai * HALF + m * 16) * 8192 + col0;
#pragma unroll
                    for (int bj = 0; bj < 2; ++bj) { const f32x4 v0 = acc[ai][bj][m][0], v1 = acc[ai][bj][m][1];
                        u32x4 w; w.x = cvt_pk_bf16(v0[0], v0[1]); w.y = cvt_pk_bf16(v0[2], v0[3]); w.z = cvt_pk_bf16(v1[0], v1[1]); w.w = cvt_pk_bf16(v1[2], v1[3]);
                        *(u32x4*)(rowp + bj * HALF) = w; } }
        } else if (wc == 0 && fq == 0) {
#pragma unroll
            for (int ai = 0; ai < 2; ++ai)
#pragma unroll
                for (int m = 0; m < 4; ++m) { float* gp = GATES + (size_t)(row0 + ai * HALF + m * 16) * 8;
                    *(f32x4*)gp = acc[ai][0][m][0]; *(f32x4*)(gp + 4) = acc[ai][0][m][1]; }
        }
    }
};
struct EpiQK {
    static constexpr bool PERM = true;
    bf16_t* Q; bf16_t* Kd;
    __device__ __forceinline__ void operator()(const f32x4 (&acc)[2][2][4][2], const Unit& u, int wr, int wc, int fr, int fq) const {
        const int row0 = u.pm * BM + wr * 64 + fr, col0 = u.z * 256 + wc * 32 + 8 * fq; bf16_t* base = u.pn ? Kd : Q;
#pragma unroll
        for (int ai = 0; ai < 2; ++ai)
#pragma unroll
            for (int m = 0; m < 4; ++m) { bf16_t* rowp = base + (size_t)(row0 + ai * HALF + m * 16) * 1024 + col0;
#pragma unroll
                for (int bj = 0; bj < 2; ++bj) { const f32x4 v0 = acc[ai][bj][m][0], v1 = acc[ai][bj][m][1];
                    u32x4 w; w.x = cvt_pk_bf16(v0[0], v0[1]); w.y = cvt_pk_bf16(v0[2], v0[3]); w.z = cvt_pk_bf16(v1[0], v1[1]); w.w = cvt_pk_bf16(v1[2], v1[3]);
                    *(u32x4*)(rowp + bj * HALF) = w; } }
    }
};
struct EpiGLU {
    static constexpr bool PERM = true;
    const bf16_t* Gb; const float* bias; bf16_t* MIX;
    __device__ __forceinline__ void operator()(const f32x4 (&acc)[2][2][4][2], const Unit& u, int wr, int wc, int fr, int fq) const {
        const int row0 = u.pm * BM + wr * 64 + fr, col0 = u.pn * BM + wc * 32 + 8 * fq;
        f32x4 bv[2][2];
#pragma unroll
        for (int bj = 0; bj < 2; ++bj)
#pragma unroll
            for (int n = 0; n < 2; ++n) bv[bj][n] = *(const f32x4*)(bias + col0 + bj * HALF + 4 * n);
#pragma unroll
        for (int ai = 0; ai < 2; ++ai) {
            u32x4 gws[4][2];
#pragma unroll
            for (int m = 0; m < 4; ++m)
#pragma unroll
                for (int bj = 0; bj < 2; ++bj) gws[m][bj] = *(const u32x4*)(Gb + (size_t)(row0 + ai * HALF + m * 16) * 2048 + col0 + bj * HALF);
#pragma unroll
            for (int m = 0; m < 4; ++m) { const size_t row = (size_t)(row0 + ai * HALF + m * 16);
#pragma unroll
                for (int bj = 0; bj < 2; ++bj) { const f32x4 v0 = acc[ai][bj][m][0] + bv[bj][0], v1 = acc[ai][bj][m][1] + bv[bj][1];
                    const u32x4 gw = gws[m][bj];
                    float o[8];
                    o[0] = bflo(gw.x) * sigmoidf_(v0[0]); o[1] = bfhi(gw.x) * sigmoidf_(v0[1]); o[2] = bflo(gw.y) * sigmoidf_(v0[2]); o[3] = bfhi(gw.y) * sigmoidf_(v0[3]);
                    o[4] = bflo(gw.z) * sigmoidf_(v1[0]); o[5] = bfhi(gw.z) * sigmoidf_(v1[1]); o[6] = bflo(gw.w) * sigmoidf_(v1[2]); o[7] = bfhi(gw.w) * sigmoidf_(v1[3]);
                    u32x4 w; w.x = cvt_pk_bf16(o[0], o[1]); w.y = cvt_pk_bf16(o[2], o[3]); w.z = cvt_pk_bf16(o[4], o[5]); w.w = cvt_pk_bf16(o[6], o[7]);
                    *(u32x4*)(MIX + row * 4096 + 2048 + col0 + bj * HALF) = w; } } }
    }
};

template <class Epi, class Sched, bool ALIGN_EPI = false, bool SP2 = false, bool PFB = false, bool I8 = false>
__device__ __forceinline__ void gemm_phase(LAS unsigned char* lds, const Gemm g, const Sched& S, const Epi& E) {
    int tid = threadIdx.x; asm volatile("" : "+v"(tid));
    const int wid = __builtin_amdgcn_readfirstlane(tid >> 6), lane = tid & 63, wr = wid >> 2, wc = wid & 3, fr = lane & 15, fq = lane >> 4;
    const int K = g.K, nt = K / BK;
    unsigned voffA[2], voffB[2];
#pragma unroll
    for (int i = 0; i < 2; ++i) { int R, C; stage_rc(tid * 16 + i * 8192, R, C); const int Rb = Epi::PERM ? ((R & ~31) + perm32(R & 31)) : R;
        voffA[i] = (unsigned)(R * g.lda + C) * 2u; voffB[i] = (unsigned)(Rb * g.ldb + C) * 2u; }
    const size_t kstep = (size_t)(BK * 2);
    const size_t hstepA = (size_t)HALF * g.lda * 2, hstepB = (size_t)HALF * g.ldb * 2;
    const unsigned ldsw = (unsigned)wid * 1024u;
    const int aoff = lds_byte(wr * 64 + fr, fq * 8), boff = lds_byte(wc * 32 + fr, fq * 8);
#define PG8_SA(b, h) (((b) * 2 + (h)) * HTB)
#define PG8_SB(b, h) ((4 + (b) * 2 + (h)) * HTB)
#define PG8_STAGE(bufoff, gbase, voff) do { _Pragma("unroll") for (int _i = 0; _i < 2; ++_i) \
        __builtin_amdgcn_global_load_lds((const unsigned*)((const char*)(gbase) + (voff)[_i]), (LAS unsigned*)(lds + (bufoff) + ldsw + _i * 8192), 16, 0, 0); } while (0)
#define PG8_LDA(dst, b, h) do { _Pragma("unroll") for (int m = 0; m < 4; ++m) _Pragma("unroll") for (int k = 0; k < 2; ++k) dst[m][k] = *(const LAS bf16x8*)(lds + PG8_SA(b, h) + aoff + m * 2048 + k * 1024); } while (0)
#define PG8_LDB(dst, b, h) do { _Pragma("unroll") for (int n = 0; n < 2; ++n) _Pragma("unroll") for (int k = 0; k < 2; ++k) dst[n][k] = *(const LAS bf16x8*)(lds + PG8_SB(b, h) + boff + n * 2048 + k * 1024); } while (0)
#define PG8_MMA(ai, bj, At, Bt) do { __builtin_amdgcn_s_setprio(1); _Pragma("unroll") for (int m = 0; m < 4; ++m) _Pragma("unroll") for (int n = 0; n < 2; ++n) _Pragma("unroll") for (int k = 0; k < 2; ++k) { \
        if constexpr (I8) acc[ai][bj][m][n] = __builtin_bit_cast(AccT, __builtin_amdgcn_mfma_i32_16x16x64_i8(__builtin_bit_cast(i32x4, Bt[n][k]), __builtin_bit_cast(i32x4, At[m][k]), __builtin_bit_cast(i32x4, acc[ai][bj][m][n]), 0, 0, 0)); \
        else acc[ai][bj][m][n] = __builtin_bit_cast(AccT, __builtin_amdgcn_mfma_f32_16x16x32_bf16(Bt[n][k], At[m][k], __builtin_bit_cast(f32x4, acc[ai][bj][m][n]), 0, 0, 0)); } __builtin_amdgcn_s_setprio(0); } while (0)
#define PG8_WAIT_V(n) asm volatile("s_waitcnt vmcnt(" #n ")" ::: "memory")
#define PG8_WAIT_L(n) asm volatile("s_waitcnt lgkmcnt(" #n ")" ::: "memory")
#define PG8_BAR __builtin_amdgcn_s_barrier()
#define PG8_SCHED __builtin_amdgcn_sched_barrier(0)
    Unit cur, nxt; int ui = 0;
    if (!S.next(0, cur)) return;
    typedef typename std::conditional<I8, i32x4, f32x4>::type AccT;
    AccT acc[2][2][4][2];
#pragma unroll
    for (int a = 0; a < 2; ++a)
#pragma unroll
        for (int b = 0; b < 2; ++b)
#pragma unroll
            for (int m = 0; m < 4; ++m)
#pragma unroll
                for (int n = 0; n < 2; ++n) acc[a][b][m][n] = AccT{};
    bf16x8 At[4][2], B0[2][2], B1[2][2];
    const char* cA = (const char*)(g.A + (size_t)cur.pm * BM * g.lda + (size_t)cur.z * g.zA);
    const char* cB = (const char*)(g.Bt + (size_t)cur.pn * BM * g.ldb + (size_t)cur.z * g.zB);
    S.a_ready(cur);
    if constexpr (SP2) {
        PG8_STAGE(PG8_SB(0, 0), cB, voffB); PG8_STAGE(PG8_SB(0, 1), cB + hstepB, voffB); PG8_STAGE(PG8_SA(0, 0), cA, voffA); PG8_STAGE(PG8_SA(0, 1), cA + hstepA, voffA);
        if (wr == 1) PG8_BAR;
        PG8_WAIT_V(2); PG8_BAR;
        PG8_STAGE(PG8_SB(1, 0), cB + kstep, voffB); PG8_STAGE(PG8_SA(1, 0), cA + kstep, voffA); PG8_STAGE(PG8_SB(1, 1), cB + hstepB + kstep, voffB);
        PG8_WAIT_V(6); PG8_BAR;
    } else {
        PG8_STAGE(PG8_SB(0, 0), cB, voffB); PG8_STAGE(PG8_SA(0, 0), cA, voffA); PG8_STAGE(PG8_SB(0, 1), cB + hstepB, voffB); PG8_STAGE(PG8_SA(0, 1), cA + hstepA, voffA);
        if (wr == 1) PG8_BAR;
        PG8_WAIT_V(4); PG8_BAR;
        PG8_STAGE(PG8_SB(1, 0), cB + kstep, voffB); PG8_STAGE(PG8_SA(1, 0), cA + kstep, voffA); PG8_STAGE(PG8_SB(1, 1), cB + hstepB + kstep, voffB);
        PG8_WAIT_V(6); PG8_BAR;
    }
    for (;;) {
        const bool has_next = S.next(ui + 1, nxt);
        const char* nA = has_next ? (const char*)(g.A + (size_t)nxt.pm * BM * g.lda + (size_t)nxt.z * g.zA) : cA;
        const char* nB = has_next ? (const char*)(g.Bt + (size_t)nxt.pn * BM * g.ldb + (size_t)nxt.z * g.zB) : cB;
        for (int t = 0; t < nt; t += 2) {
            const bool last = (t == nt - 2);
            const char* a1 = cA + (size_t)(t + 1) * kstep;
            const char* a2 = last ? nA : cA + (size_t)(t + 2) * kstep; const char* b2 = last ? nB : cB + (size_t)(t + 2) * kstep;
            const char* a3 = a2 + kstep; const char* b3 = b2 + kstep;
            if (last && has_next) S.a_ready(nxt);
            if constexpr (SP2) {
            PG8_LDB(B0, 0, 0); PG8_LDB(B1, 0, 1); PG8_SCHED; PG8_LDA(At, 0, 0); PG8_STAGE(PG8_SA(1, 1), a1 + hstepA, voffA);
            PG8_WAIT_V(8); PG8_WAIT_L(0); PG8_BAR; PG8_MMA(0, 0, At, B0); PG8_MMA(0, 1, At, B1); PG8_BAR; PG8_SCHED;
            PG8_LDA(At, 0, 1); PG8_STAGE(PG8_SB(0, 0), b2, voffB); PG8_STAGE(PG8_SB(0, 1), b2 + hstepB, voffB); PG8_STAGE(PG8_SA(0, 0), a2, voffA);
            PG8_WAIT_V(8); PG8_WAIT_L(0); PG8_BAR; PG8_MMA(1, 0, At, B0); PG8_MMA(1, 1, At, B1); PG8_BAR; PG8_SCHED;
            PG8_LDB(B0, 1, 0); PG8_LDB(B1, 1, 1); PG8_SCHED; PG8_LDA(At, 1, 0); PG8_STAGE(PG8_SA(0, 1), a2 + hstepA, voffA);
            PG8_WAIT_V(8); PG8_WAIT_L(0); PG8_BAR; PG8_MMA(0, 0, At, B0); PG8_MMA(0, 1, At, B1); PG8_BAR; PG8_SCHED;
            PG8_LDA(At, 1, 1); PG8_STAGE(PG8_SB(1, 0), b3, voffB); PG8_STAGE(PG8_SB(1, 1), b3 + hstepB, voffB); PG8_STAGE(PG8_SA(1, 0), a3, voffA);
            PG8_WAIT_V(8); PG8_WAIT_L(0); PG8_BAR; PG8_MMA(1, 0, At, B0); PG8_MMA(1, 1, At, B1); PG8_BAR; PG8_SCHED;
            } else {
            PG8_LDB(B0, 0, 0); PG8_SCHED; PG8_LDA(At, 0, 0); PG8_STAGE(PG8_SA(1, 1), a1 + hstepA, voffA);
            PG8_WAIT_L(8); PG8_BAR; PG8_WAIT_L(0); PG8_MMA(0, 0, At, B0); PG8_BAR; PG8_SCHED;
            PG8_LDB(B1, 0, 1); PG8_STAGE(PG8_SB(0, 0), b2, voffB);
            PG8_BAR; PG8_WAIT_L(0); PG8_MMA(0, 1, At, B1); PG8_BAR;
            PG8_LDA(At, 0, 1); PG8_STAGE(PG8_SA(0, 0), a2, voffA);
            PG8_BAR; PG8_WAIT_L(0); PG8_MMA(1, 0, At, B0); PG8_BAR; PG8_SCHED;
            PG8_STAGE(PG8_SB(0, 1), b2 + hstepB, voffB);
            PG8_WAIT_V(6); PG8_BAR; PG8_MMA(1, 1, At, B1); PG8_BAR;
            PG8_LDB(B0, 1, 0); PG8_SCHED; PG8_LDA(At, 1, 0); PG8_STAGE(PG8_SA(0, 1), a2 + hstepA, voffA);
            PG8_WAIT_L(8); PG8_BAR; PG8_WAIT_L(0); PG8_MMA(0, 0, At, B0); PG8_BAR; PG8_SCHED;
            PG8_LDB(B1, 1, 1); PG8_STAGE(PG8_SB(1, 0), b3, voffB);
            PG8_BAR; PG8_WAIT_L(0); PG8_MMA(0, 1, At, B1); PG8_BAR;
            PG8_LDA(At, 1, 1); PG8_STAGE(PG8_SA(1, 0), a3, voffA);
            PG8_BAR; PG8_WAIT_L(0); PG8_MMA(1, 0, At, B0); PG8_BAR; PG8_SCHED;
            PG8_STAGE(PG8_SB(1, 1), b3 + hstepB, voffB);
            PG8_WAIT_V(6); PG8_BAR; PG8_MMA(1, 1, At, B1); PG8_BAR;
            }
        }
        if constexpr (ALIGN_EPI) { if (wr == 0) PG8_BAR; }
        E(acc, cur, wr, wc, fr, fq); S.done(cur);
        if (!has_next) break;
        if constexpr (PFB) {
            const char* pb = nB + (size_t)((nxt.pm & 7) * 32 + wid * 4) * g.ldb * 2 + lane * 128;
#pragma unroll
            for (int r = 0; r < 4; ++r) __builtin_amdgcn_global_load_lds((const unsigned*)(pb + (size_t)r * g.ldb * 2), (LAS unsigned*)(lds + STAGE_BYTES + wid * 256), 4, 0, 0);
        }
#pragma unroll
        for (int a = 0; a < 2; ++a)
#pragma unroll
            for (int b = 0; b < 2; ++b)
#pragma unroll
                for (int m = 0; m < 4; ++m)
#pragma unroll
                    for (int n = 0; n < 2; ++n) acc[a][b][m][n] = AccT{};
        cur = nxt; cA = nA; cB = nB; ++ui;
        if constexpr (ALIGN_EPI) { if (wr == 1) PG8_BAR; }
    }
    PG8_WAIT_V(0);
    if constexpr (!ALIGN_EPI) { if (wr == 0) PG8_BAR; }
    PG8_BAR;
#undef PG8_SA
#undef PG8_SB
#undef PG8_STAGE
#undef PG8_LDA
#undef PG8_LDB
#undef PG8_MMA
#undef PG8_WAIT_V
#undef PG8_WAIT_L
#undef PG8_BAR
#undef PG8_SCHED
}
}

#define XB_TMO      128
#define XB_XCNT(j)  (256  + 64 * (j))
#define XB_XSUB(j)  (1280 + 64 * (j))
#define XB_XGEN(j)  (2304 + 64 * (j))
#define XB_TOP      3328
#define XB_TOPGEN   3392
#define XCD_BAR_WORDS 3456
#define XB_SPIN_CAP (1u << 18)
__device__ __forceinline__ unsigned xb_ld(unsigned* p)              { return __hip_atomic_load(p, __ATOMIC_RELAXED, __HIP_MEMORY_SCOPE_AGENT); }
__device__ __forceinline__ unsigned xb_add(unsigned* p, unsigned v) { return __hip_atomic_fetch_add(p, v, __ATOMIC_RELAXED, __HIP_MEMORY_SCOPE_AGENT); }
__device__ __forceinline__ unsigned xb_xcc_id() { return (unsigned)__builtin_amdgcn_s_getreg((3 << 11) | 20) & 0xFu; }
#define XB_SPIN(cond, bar) do { unsigned _sp = 0; while (cond) { __builtin_amdgcn_s_sleep(1); \
    if ((++_sp & 255u) == 0u) { if (xb_ld(&(bar)[XB_TMO])) break; if (_sp > XB_SPIN_CAP) { atomicAdd(&(bar)[XB_TMO], 1u); break; } } } } while (0)
struct XcdBarrier { unsigned* bar; unsigned x; volatile LAS unsigned* st; };
__device__ __forceinline__ XcdBarrier xcd_barrier_post(unsigned* bar, volatile LAS unsigned* st) {
    XcdBarrier b; b.bar = bar; b.x = xb_xcc_id(); b.st = st;
    if (threadIdx.x == 0) (void)xb_add(&bar[XB_XCNT(b.x)], 1u);
    return b;
}
__device__ __forceinline__ void xcd_barrier_complete(unsigned* bar, unsigned x, unsigned& nloc, unsigned& nx) {
    const unsigned G = gridDim.x * gridDim.y * gridDim.z;
    unsigned sum, cnt, mine, sp = 0u;
    for (;;) {
        sum = 0u; cnt = 0u; mine = 0u;
#pragma unroll
        for (unsigned j = 0; j < 16; ++j) { const unsigned c = xb_ld(&bar[XB_XCNT(j)]); sum += c; cnt += (c > 0u) ? 1u : 0u; mine = (j == x) ? c : mine; }
        if (sum == G) break;
        __builtin_amdgcn_s_sleep(1);
        if ((++sp & 255u) == 0u) { if (xb_ld(&bar[XB_TMO])) break; if (sp > XB_SPIN_CAP) { atomicAdd(&bar[XB_TMO], 1u); break; } }
    }
    nloc = mine > 0u ? mine : 1u; nx = cnt > 0u ? cnt : 1u;
}
__device__ __forceinline__ void xcd_barrier(const XcdBarrier& b) {
    asm volatile("s_waitcnt vmcnt(0)" ::: "memory");
    __syncthreads();
    if (threadIdx.x == 0) {
        unsigned* bar = b.bar;
        __builtin_amdgcn_s_waitcnt(0);
        unsigned nloc = b.st[0], nx = b.st[1];
        if (nloc == 0u) { xcd_barrier_complete(bar, b.x, nloc, nx); b.st[0] = nloc; b.st[1] = nx; }
        const unsigned old = xb_add(&bar[XB_XSUB(b.x)], 1u);
        const unsigned gen = old / nloc;
        if (old + 1u == (gen + 1u) * nloc) {
            __builtin_amdgcn_fence(__ATOMIC_RELEASE, "agent");
            asm volatile("s_waitcnt vmcnt(0)" ::: "memory");
            const unsigned og = xb_add(&bar[XB_TOP], 1u);
            const unsigned tg = og / nx;
            if (og + 1u == (tg + 1u) * nx) xb_add(&bar[XB_TOPGEN], 1u);
            else XB_SPIN(xb_ld(&bar[XB_TOPGEN]) == tg, bar);
            __builtin_amdgcn_fence(__ATOMIC_ACQUIRE, "agent");
            xb_add(&bar[XB_XGEN(b.x)], 1u);
            asm volatile("s_waitcnt vmcnt(0)" ::: "memory");
        } else {
            XB_SPIN(xb_ld(&bar[XB_XGEN(b.x)]) == gen, bar);
            __builtin_amdgcn_fence(__ATOMIC_ACQUIRE, "agent");
            asm volatile("s_waitcnt vmcnt(0)" ::: "memory");
        }
    }
    __syncthreads();
}

struct Args { const float* in[N_IN]; float* out; unsigned char* ws; int ph_lo, ph_hi; };
static_assert(sizeof(Args) == (N_IN + 2) * 8 + 8, "Args has no padding holes");

struct Frame {
    LAS unsigned char* lds;
    int tid, lane, wave, G, vcu, pp;
    const float* const* in; float* out; unsigned char* ws;
};
#define WSP(type, off) ((type*)(F.ws + (off)))

constexpr int SCR_STRIDE = 16896;
struct CvtItem { const float* W; void* WT; int ldw, k0, n0, ldk, drow0, q8; float scale; };
__device__ __forceinline__ void cvt_load(const CvtItem& c, int lane, f32x4 (&v)[16]) {
    const int rr = c.q8 ? lane >> 3 : lane >> 4, cc = c.q8 ? lane & 7 : lane & 15;
    const float* src = c.W + (size_t)(c.k0 + rr) * c.ldw + c.n0 + 4 * cc; const size_t step = (size_t)(c.q8 ? 8 : 4) * c.ldw;
#pragma unroll
    for (int i = 0; i < 16; ++i) v[i] = __builtin_nontemporal_load((const f32x4*)(src + i * step));
}
__device__ __forceinline__ void cvt_finish(const CvtItem& c, int lane, const f32x4 (&v)[16], LAS float* scr) {
    const float scale = c.scale; const int cl = lane & 7;
    if (!c.q8) {
        { const int r4 = lane >> 4, c16 = lane & 15;
#pragma unroll
          for (int i = 0; i < 16; ++i) { LAS float* d = scr + (4 * i + r4) * 65 + 4 * c16; d[0] = v[i].x; d[1] = v[i].y; d[2] = v[i].z; d[3] = v[i].w; } }
        asm volatile("s_waitcnt lgkmcnt(0)" ::: "memory");
        bf16* WT = (bf16*)c.WT;
#pragma unroll
        for (int j = 0; j < 8; ++j) { const int n = (lane >> 3) + 8 * j; const LAS float* s = scr + (8 * cl) * 65 + n;
            u32x4 o; o.x = cvt_pk_bf16(s[0 * 65] * scale, s[1 * 65] * scale); o.y = cvt_pk_bf16(s[2 * 65] * scale, s[3 * 65] * scale);
            o.z = cvt_pk_bf16(s[4 * 65] * scale, s[5 * 65] * scale); o.w = cvt_pk_bf16(s[6 * 65] * scale, s[7 * 65] * scale);
            *(u32x4*)(WT + (size_t)(c.drow0 + n) * c.ldk + c.k0 + 8 * cl) = o; }
    } else {
        { const int r8 = lane >> 3, c8 = lane & 7;
#pragma unroll
          for (int i = 0; i < 16; ++i) { LAS float* d = scr + (8 * i + r8) * 33 + 4 * c8; d[0] = v[i].x; d[1] = v[i].y; d[2] = v[i].z; d[3] = v[i].w; } }
        asm volatile("s_waitcnt lgkmcnt(0)" ::: "memory");
        signed char* WT8 = (signed char*)c.WT;
#pragma unroll
        for (int j = 0; j < 4; ++j) { const int n = (lane >> 3) + 8 * j; const LAS float* s = scr + (16 * cl) * 33 + n;
            u32x4 o; o.x = q8x4(s[0 * 33] * scale, s[1 * 33] * scale, s[2 * 33] * scale, s[3 * 33] * scale); o.y = q8x4(s[4 * 33] * scale, s[5 * 33] * scale, s[6 * 33] * scale, s[7 * 33] * scale);
            o.z = q8x4(s[8 * 33] * scale, s[9 * 33] * scale, s[10 * 33] * scale, s[11 * 33] * scale); o.w = q8x4(s[12 * 33] * scale, s[13 * 33] * scale, s[14 * 33] * scale, s[15 * 33] * scale);
            *(u32x4*)(WT8 + (size_t)(c.drow0 + n) * c.ldk + c.k0 + 16 * cl) = o; }
    }
    asm volatile("s_waitcnt lgkmcnt(0)" ::: "memory");
}
__device__ __forceinline__ float wscale(Frame& F, int t) { return ((volatile LAS float*)(F.lds + LDS_MISC))[64 + t]; }
__device__ __forceinline__ void p0_stats(Frame& F) {
    LAS float* red = (LAS float*)F.lds;
#pragma unroll
    for (int t = 2; t < 5; ++t) {
        const float* W = F.in[t == 2 ? I_F2G : t == 3 ? I_F2U : I_F2D]; float s = 0.f;
        for (int i = F.tid; i < DFF / 4; i += NTHREADS) {
            const f32x4 v = (t < 4) ? *(const f32x4*)(W + (size_t)2048 * DFF + 4 * i) : *(const f32x4*)(W + (size_t)(4000 + 1000 * (i / 1024)) * D + 4 * (i % 1024)); s += (v.x * v.x + v.y * v.y) + (v.z * v.z + v.w * v.w); }
        s = wave_sum(s);
        __syncthreads();
        if (F.lane == 0) red[F.wave] = s;
        __syncthreads();
        if (F.tid == 0) { const float tot = ((red[0] + red[1]) + (red[2] + red[3])) + ((red[4] + red[5]) + (red[6] + red[7]));
            ((volatile LAS float*)(F.lds + LDS_MISC))[64 + t] = 6.0f * sqrtf(tot * (1.0f / DFF)) * (1.0f / 127.0f); }
    }
    __syncthreads();
}
__device__ __forceinline__ void rms_row_to_i8(const float* xrow, const float* gain, signed char* qrow, float* sa, int lane) {
    const f32x4* xr = (const f32x4*)xrow + lane; const f32x4* gr = (const f32x4*)gain + lane;
    f32x4 v[16]; float s = 0.f;
#pragma unroll
    for (int j = 0; j < 16; ++j) { v[j] = xr[64 * j]; s += (v[j].x * v[j].x + v[j].y * v[j].y) + (v[j].z * v[j].z + v[j].w * v[j].w); }
    const float r = rsqrtf(wave_sum(s) * (1.f / D) + EPS); float am = 0.f;
#pragma unroll
    for (int j = 0; j < 16; ++j) { const f32x4 gg = gr[64 * j]; v[j] = v[j] * r * gg; am = fmaxf(fmaxf(am, fmaxf(fabsf(v[j].x), fabsf(v[j].y))), fmaxf(fabsf(v[j].z), fabsf(v[j].w))); }
    am = fmaxf(wave_max(am), 1e-20f); const float inv = 127.0f / am;
    unsigned* o4 = (unsigned*)qrow + lane;
#pragma unroll
    for (int j = 0; j < 16; ++j) o4[64 * j] = q8x4(v[j].x * inv, v[j].y * inv, v[j].z * inv, v[j].w * inv);
    if (lane == 0) *sa = am * (1.0f / 127.0f);
}
__device__ __forceinline__ void rms_row_to_bf16(const float* xrow, const float* gain, bf16* orow, int lane) {
    const f32x4* xr = (const f32x4*)xrow + lane; const f32x4* gr = (const f32x4*)gain + lane;
    f32x4 v[16]; float s = 0.f;
#pragma unroll
    for (int j = 0; j < 16; ++j) { v[j] = xr[64 * j]; s += (v[j].x * v[j].x + v[j].y * v[j].y) + (v[j].z * v[j].z + v[j].w * v[j].w); }
    const float r = rsqrtf(wave_sum(s) * (1.f / D) + EPS);
    u32x2* o8 = (u32x2*)orow + lane;
#pragma unroll
    for (int j = 0; j < 16; ++j) { const f32x4 gg = gr[64 * j]; u32x2 w; w.x = cvt_pk_bf16(v[j].x * r * gg.x, v[j].y * r * gg.y); w.y = cvt_pk_bf16(v[j].z * r * gg.z, v[j].w * r * gg.w); o8[64 * j] = w; }
}
__device__ __forceinline__ void sincos_d(double x, double& s, double& c) {
    const double n = rint(x * 0.63661977236758134308);
    const double r = (x - n * 1.5707963267948966192) - n * 6.123233995736766036e-17;
    const double r2 = r * r;
    const double sn = r * (1.0 + r2 * (-1.0 / 6 + r2 * (1.0 / 120 + r2 * (-1.0 / 5040 + r2 * (1.0 / 362880 + r2 * (-1.0 / 39916800 + r2 * (1.0 / 6227020800.0)))))));
    const double cs = 1.0 + r2 * (-0.5 + r2 * (1.0 / 24 + r2 * (-1.0 / 720 + r2 * (1.0 / 40320 + r2 * (-1.0 / 3628800 + r2 * (1.0 / 479001600.0 + r2 * (-1.0 / 87178291200.0)))))));
    const int q = ((int)n) & 3;
    s = (q == 0) ? sn : (q == 1) ? cs : (q == 2) ? -sn : -cs;
    c = (q == 0) ? cs : (q == 1) ? -sn : (q == 2) ? -cs : sn;
}
constexpr int I_GU = 64 * 172, I_DN = 172 * 64, I_WIN_ = 64 * 128, I_WOUT_ = 64 * 64, I_GLU_ = 32 * 32, I_QK_ = 32;
constexpr int IT_GU1 = 0, IT_GU2 = 2 * I_GU, IT_DN1 = 4 * I_GU, IT_DN2 = IT_DN1 + I_DN, IT_WIN = IT_DN2 + I_DN, IT_WOUT = IT_WIN + I_WIN_, IT_END = IT_WOUT + I_WOUT_ + I_GLU_ + 8 * I_QK_;
__device__ __forceinline__ void decode_item(Frame& F, int it, const float (&winv)[5], CvtItem& c) {
    int r = it; c.q8 = 0; c.scale = 1.f;
    if (r < 4 * I_GU) {
        const int which = r / I_GU; r -= which * I_GU;
        c.W = F.in[which == 0 ? I_F1G : which == 1 ? I_F1U : which == 2 ? I_F2G : I_F2U]; c.ldw = DFF; c.ldk = D;
        if (which < 2) { const int kb = r / 172, nb = r % 172, n0 = 64 * nb;
            c.k0 = 64 * kb; c.n0 = n0; c.WT = WSP(bf16, WS_W1GU); c.drow0 = (n0 >> 7) * 256 + (which & 1) * 128 + (n0 & 127); return; }
        const int kb = r / 344, nb = r % 344, n0 = 32 * nb;
        c.k0 = 128 * kb; c.n0 = n0; c.WT = WSP(signed char, WS_W2GU); c.drow0 = (n0 >> 7) * 256 + (which & 1) * 128 + (n0 & 127); c.q8 = 1; c.scale = winv[which]; return; }
    r -= 4 * I_GU;
    if (r < 2 * I_DN) { const int which = r / I_DN; r -= which * I_DN;
        if (which) { const int kb = r / 128, nb = r % 128;
            c.W = F.in[I_F2D]; c.ldw = D; c.k0 = 128 * kb; c.n0 = 32 * nb; c.WT = WSP(signed char, WS_W2D); c.ldk = DFF; c.drow0 = 32 * nb; c.q8 = 1; c.scale = winv[4]; return; }
        const int kb = r / 64, nb = r % 64;
        c.W = F.in[I_F1D]; c.ldw = D; c.k0 = 64 * kb; c.n0 = 64 * nb; c.WT = WSP(bf16, WS_W1D); c.ldk = DFF; c.drow0 = 64 * nb; return; }
    r -= 2 * I_DN;
    if (r < I_WIN_) { const int kb = r / 128, nb = r % 128; c.W = F.in[I_WIN]; c.ldw = 8200; c.k0 = 64 * kb; c.n0 = 64 * nb; c.WT = WSP(bf16, WS_WIN); c.ldk = D; c.drow0 = 64 * nb; return; }
    r -= I_WIN_;
    if (r < I_WOUT_) { const int kb = r / 64, nb = r % 64; c.W = F.in[I_WOUT]; c.ldw = D; c.k0 = 64 * kb; c.n0 = 64 * nb; c.WT = WSP(bf16, WS_WOUT); c.ldk = D; c.drow0 = 64 * nb; return; }
    r -= I_WOUT_;
    if (r < I_GLU_) { const int kb = r / 32, nb = r % 32; c.W = F.in[I_WGLU]; c.ldw = 2048; c.k0 = 64 * kb; c.n0 = 64 * nb; c.WT = WSP(bf16, WS_WGLU); c.ldk = 2048; c.drow0 = 64 * nb; return; }
    r -= I_GLU_;
    { const int hk = r / I_QK_; r -= hk * I_QK_; const int h = hk >> 1, isk = hk & 1, kb = r / 4, nb = r % 4;
      c.W = F.in[isk ? I_WK : I_WQ] + (size_t)h * 512 * 256; c.ldw = 256; c.k0 = 64 * kb; c.n0 = 64 * nb; c.WT = WSP(bf16, WS_WQK) + (size_t)h * 512 * 512; c.ldk = 512; c.drow0 = isk * 256 + 64 * nb; c.scale = isk ? 0.0625f : 1.f; }
}
__device__ __forceinline__ void convert_item(Frame& F, int it, LAS float* scr, const float (&winv)[5]) { CvtItem c; decode_item(F, it, winv, c); f32x4 v[16]; cvt_load(c, F.lane, v); cvt_finish(c, F.lane, v, scr); }
template <int SET> __device__ __forceinline__ int cvt_set_size() { return SET == 0 ? 2 * I_GU : SET == 1 ? I_DN + (IT_END - IT_WIN) : SET == 2 ? 2 * I_GU : I_DN; }
template <int SET> __device__ __forceinline__ int cvt_set_item(int q) {
    if (SET == 0) return q;
    if (SET == 1) return q < I_DN ? IT_DN1 + q : IT_WIN + (q - I_DN);
    if (SET == 2) return IT_GU2 + q;
    return IT_DN2 + q;
}
template <int SET>
__device__ __forceinline__ void convert_stream(Frame& F, int w, int nw) {
    LAS float* scr = (LAS float*)(F.lds + F.wave * SCR_STRIDE);
    const float winv[5] = {1.f, 1.f, 1.0f / wscale(F, 2), 1.0f / wscale(F, 3), 1.0f / wscale(F, 4)};
    const int n = cvt_set_size<SET>();
    CvtItem c0, c1; f32x4 v0[16], v1[16]; int q = w;
    if (q < n) { decode_item(F, cvt_set_item<SET>(q), winv, c0); cvt_load(c0, F.lane, v0); }
    while (q < n) {
        const int qn = q + nw;
        if (qn < n) { decode_item(F, cvt_set_item<SET>(qn), winv, c1); cvt_load(c1, F.lane, v1); }
        cvt_finish(c0, F.lane, v0, scr);
        c0 = c1;
#pragma unroll
        for (int i = 0; i < 16; ++i) v0[i] = v1[i];
        q = qn;
    }
}
template <int SET>
__device__ __forceinline__ void convert_static(Frame& F, int first) { convert_stream<SET>(F, ((int)blockIdx.x - first) * NWAVES + F.wave, ((int)gridDim.x - first) * NWAVES); }
__device__ __forceinline__ void p0_prologue(Frame& F) {
    const int gw = F.vcu * NWAVES + F.wave, NGW = F.G * NWAVES;
    convert_stream<0>(F, gw, NGW);
    {
        const f32x4* gr = (const f32x4*)F.in[I_F1PRE] + F.lane; f32x4 gq[16];
#pragma unroll
        for (int j = 0; j < 16; ++j) gq[j] = gr[64 * j];
        for (int m = gw; m < TP; m += NGW) {
            const f32x4* xr = (const f32x4*)(F.in[I_XP] + (size_t)m * D) + F.lane; f32x4 v[16]; float s = 0.f;
#pragma unroll
            for (int j = 0; j < 16; ++j) { v[j] = __builtin_nontemporal_load(xr + 64 * j); s += (v[j].x * v[j].x + v[j].y * v[j].y) + (v[j].z * v[j].z + v[j].w * v[j].w); }
            const float r = rsqrtf(wave_sum(s) * (1.f / D) + EPS);
            u32x2* o8 = (u32x2*)(WSP(bf16, WS_HA) + (size_t)m * D) + F.lane;
#pragma unroll
            for (int j = 0; j < 16; ++j) { const f32x4 gg = gq[j]; u32x2 w; w.x = cvt_pk_bf16(v[j].x * r * gg.x, v[j].y * r * gg.y); w.y = cvt_pk_bf16(v[j].z * r * gg.z, v[j].w * r * gg.w); o8[64 * j] = w; }
        }
        LAS float* red = (LAS float*)F.lds;
        for (int ms = TP + F.vcu; ms < T; ms += F.G) {
            const f32x4* xr = (const f32x4*)(F.in[I_XS] + (size_t)(ms - TP) * D) + F.tid; const f32x4* g2 = (const f32x4*)F.in[I_F1PRE] + F.tid;
            const f32x4 a = xr[0], b = xr[512], ga = g2[0], gb = g2[512];
            float s = wave_sum((a.x * a.x + a.y * a.y) + (a.z * a.z + a.w * a.w) + (b.x * b.x + b.y * b.y) + (b.z * b.z + b.w * b.w));
            __syncthreads();
            if (F.lane == 0) red[F.wave] = s;
            __syncthreads();
            const float r = rsqrtf((((red[0] + red[1]) + (red[2] + red[3])) + ((red[4] + red[5]) + (red[6] + red[7]))) * (1.f / D) + EPS);
            u32x2* o8 = (u32x2*)(WSP(bf16, WS_HA) + (size_t)ms * D) + F.tid; u32x2 w;
            w.x = cvt_pk_bf16(a.x * r * ga.x, a.y * r * ga.y); w.y = cvt_pk_bf16(a.z * r * ga.z, a.w * r * ga.w); o8[0] = w;
            w.x = cvt_pk_bf16(b.x * r * gb.x, b.y * r * gb.y); w.y = cvt_pk_bf16(b.z * r * gb.z, b.w * r * gb.w); o8[512] = w;
        }
    }
    const int gt = F.vcu * NTHREADS + F.tid, NT = F.G * NTHREADS;
    { bf16* WIN = WSP(bf16, WS_WIN); const float* W = F.in[I_WIN];
      for (int i = gt; i < 8 * D / 2; i += NT) { const int j = i >> 11, k = (i & 2047) * 2; *(unsigned*)(WIN + (size_t)(8192 + j) * D + k) = cvt_pk_bf16(W[(size_t)k * 8200 + 8192 + j], W[(size_t)(k + 1) * 8200 + 8192 + j]); }
      u32x4* z = (u32x4*)(WIN + (size_t)8200 * D); for (int i = gt; i < 248 * D / 8; i += NT) z[i] = (u32x4){0u, 0u, 0u, 0u}; }
    for (int i = gt; i < NG * NP; i += NT) {
        const int g = i >> 6;
        const double are = F.in[I_ARE][i], aim = F.in[I_AIM][i], dt = exp((double)F.in[I_LOGDT][g]);
        const double mag = exp(are * dt); double sn, cs; sincos_d(aim * dt, sn, cs);
        const double abre = mag * cs, abim = mag * sn, den = are * are + aim * aim, ire = are / den, iim = -aim / den, fre = abre - 1.0, fim = abim;
        const double qre = fre * ire - fim * iim, qim = fre * iim + fim * ire;
        WSP(float, WS_S5AB)[i] = (float)abre; WSP(float, WS_S5AB)[8192 + i] = (float)abim;
        const CAS float* bre = (const CAS float*)F.in[I_BRE] + (size_t)i * 16; const CAS float* bim = (const CAS float*)F.in[I_BIM] + (size_t)i * 16;
        float* obre = WSP(float, WS_S5BB) + (size_t)i * 16; float* obim = obre + 131072;
#pragma unroll
        for (int j = 0; j < 16; ++j) { const double br = bre[j], bi = bim[j]; obre[j] = (float)(qre * br - qim * bi); obim[j] = (float)(qre * bi + qim * br); }
    }
}

template <int MODE, bool SAMPLE>
__device__ __forceinline__ void row_one(Frame& F, int m, const float* dbuf, const float* gpost, float scale, const float* gnext, bf16* hout) {
    {
        int ln = F.lane; asm volatile("" : "+v"(ln));
        const f32x4* gp = (const f32x4*)gpost + ln;
        u32x2* xb = (u32x2*)(WSP(bf16, WS_XR) + (size_t)m * D) + F.lane;
        const f32x4* xr = (const f32x4*)((m < TP) ? F.in[I_XP] + (size_t)m * D : F.in[I_XS] + (size_t)(m - TP) * D) + F.lane;
        f32x4 xf[MODE == 0 ? 16 : 1]; u32x2 xw[MODE == 0 ? 1 : 16];
#define ROWPASS_LOAD_X() do { if (MODE == 0) { _Pragma("unroll") for (int j = 0; j < 16; ++j) xf[j] = __builtin_nontemporal_load(xr + 64 * j); } \
                              else { _Pragma("unroll") for (int j = 0; j < 16; ++j) xw[j] = __builtin_nontemporal_load(xb + 64 * j); } } while (0)
        f32x4 v[16]; float s = 0.f;
        if (!SAMPLE) {
            ROWPASS_LOAD_X();
            const u32x2* db = (const u32x2*)((const bf16*)dbuf + (size_t)m * D) + F.lane;
#pragma unroll
            for (int j = 0; j < 16; ++j) { const u32x2 w = __builtin_nontemporal_load(db + 64 * j); v[j] = (f32x4){bflo(w.x), bfhi(w.x), bflo(w.y), bfhi(w.y)}; }
        } else {
#pragma unroll
            for (int j = 0; j < 16; ++j) v[j] = ((const LAS f32x4*)F.lds)[64 * j + F.lane];
            ROWPASS_LOAD_X();
        }
#undef ROWPASS_LOAD_X
        f32x4 gq[8];
#pragma unroll
        for (int j = 0; j < 8; ++j) gq[j] = gp[64 * j];
#pragma unroll
        for (int j = 0; j < 16; ++j) s += (v[j].x * v[j].x + v[j].y * v[j].y) + (v[j].z * v[j].z + v[j].w * v[j].w);
        const float r = rsqrtf(wave_sum(s) * (1.f / D) + EPS) * scale; float s2 = 0.f;
        f32x4* yo = (f32x4*)(F.out + O_Y + (size_t)m * D) + F.lane;
#pragma unroll
        for (int j = 0; j < 16; ++j) { f32x4 x;
            if (j == 8) {
#pragma unroll
                for (int jj = 0; jj < 8; ++jj) gq[jj] = gp[64 * (8 + jj)]; }
            if (MODE == 0) x = xf[j]; else { const u32x2 w = xw[j]; x = (f32x4){bflo(w.x), bfhi(w.x), bflo(w.y), bfhi(w.y)}; }
            const f32x4 gg = gq[j & 7]; v[j] = x + v[j] * r * gg;
            if (MODE == 2) __builtin_nontemporal_store(v[j], yo + 64 * j); else { u32x2 w; w.x = cvt_pk_bf16(v[j].x, v[j].y); w.y = cvt_pk_bf16(v[j].z, v[j].w); __builtin_nontemporal_store(w, xb + 64 * j); }
            s2 += (v[j].x * v[j].x + v[j].y * v[j].y) + (v[j].z * v[j].z + v[j].w * v[j].w); }
        if (MODE == 0) {
            const f32x4* gn = (const f32x4*)gnext + ln; u32x2* o8 = (u32x2*)(hout + (size_t)m * D) + F.lane;
#pragma unroll
            for (int j = 0; j < 8; ++j) gq[j] = gn[64 * j];
            const float r2 = rsqrtf(wave_sum(s2) * (1.f / D) + EPS);
#pragma unroll
            for (int j = 0; j < 16; ++j) {
                if (j == 8) {
#pragma unroll
                    for (int jj = 0; jj < 8; ++jj) gq[jj] = gn[64 * (8 + jj)]; }
                const f32x4 gg = gq[j & 7]; u32x2 w; w.x = cvt_pk_bf16(v[j].x * r2 * gg.x, v[j].y * r2 * gg.y); w.y = cvt_pk_bf16(v[j].z * r2 * gg.z, v[j].w * r2 * gg.w); o8[64 * j] = w; }
        }
        if (MODE == 1) {
            const f32x4* gn = (const f32x4*)gnext + ln; float am = 0.f;
            const float r2 = rsqrtf(wave_sum(s2) * (1.f / D) + EPS);
#pragma unroll
            for (int j = 0; j < 16; ++j) { const f32x4 gg = gn[64 * j]; v[j] = v[j] * r2 * gg; am = fmaxf(fmaxf(am, fmaxf(fabsf(v[j].x), fabsf(v[j].y))), fmaxf(fabsf(v[j].z), fabsf(v[j].w))); }
            am = fmaxf(wave_max(am), 1e-20f); const float inv = 127.0f / am;
            unsigned* o4 = (unsigned*)((signed char*)hout + (size_t)m * D) + F.lane;
#pragma unroll
            for (int j = 0; j < 16; ++j) o4[64 * j] = q8x4(v[j].x * inv, v[j].y * inv, v[j].z * inv, v[j].w * inv);
            WSP(float, WS_SA)[(size_t)m * 64 + F.lane] = am * (1.0f / 127.0f);
        }
    }
}
template <int MODE>
__device__ __forceinline__ void row_pass(Frame& F, const float* dbuf, const float* gpost, float scale, const float* gnext, bf16* hout) {
    const int gw = F.vcu * NWAVES + F.wave, NGW = F.G * NWAVES;
    LAS f32x4* rowb = (LAS f32x4*)F.lds;
    LAS f32x4* part = rowb + 1024;
    for (int ms = TP + F.vcu; ms < T; ms += F.G) {
        __syncthreads();
        { const u32x2* s0 = (const u32x2*)(WSP(bf16, WS_SLAB) + ((size_t)(2 * F.wave) * 256 + (ms - TP)) * D) + F.lane; const u32x2* s1 = s0 + (size_t)256 * D / 4;
#pragma unroll
          for (int jh = 0; jh < 2; ++jh) { u32x2 a[8], b[8];
#pragma unroll
              for (int j = 0; j < 8; ++j) { a[j] = s0[64 * (8 * jh + j)]; b[j] = s1[64 * (8 * jh + j)]; }
#pragma unroll
              for (int j = 0; j < 8; ++j) part[F.wave * 1024 + 64 * (8 * jh + j) + F.lane] = (f32x4){bflo(a[j].x) + bflo(b[j].x), bfhi(a[j].x) + bfhi(b[j].x), bflo(a[j].y) + bflo(b[j].y), bfhi(a[j].y) + bfhi(b[j].y)}; } }
        __syncthreads();
#pragma unroll
        for (int q = 0; q < 2; ++q) { const int c = F.wave * 128 + q * 64 + F.lane; f32x4 t = part[c];
#pragma unroll
            for (int w = 1; w < 8; ++w) t += part[w * 1024 + c];
            rowb[c] = t; }
        __syncthreads();
        if (F.wave == 0) row_one<MODE, true>(F, ms, dbuf, gpost, scale, gnext, hout);
    }
    __syncthreads();
    for (int m = gw; m < TP; m += NGW) row_one<MODE, false>(F, m, dbuf, gpost, scale, gnext, hout);
}
__device__ __forceinline__ void p13_quant(Frame& F) {
    const int gw = F.vcu * NWAVES + F.wave, NGW = F.G * NWAVES;
    {
        LAS float* red = (LAS float*)F.lds;
        for (int ms = TP + F.vcu; ms < T; ms += F.G) {
            const u32x4* src = (const u32x4*)(WSP(bf16, WS_HID) + (size_t)ms * DFF); u32x4 v[3]; float am = 0.f;
#pragma unroll
            for (int i = 0; i < 3; ++i) { const int c = F.tid + 512 * i; v[i] = (u32x4){0u, 0u, 0u, 0u}; if (c < 1376) v[i] = src[c]; }
#pragma unroll
            for (int i = 0; i < 3; ++i) { const u32x4 w = v[i];
                am = fmaxf(fmaxf(fmaxf(am, fmaxf(fabsf(bflo(w.x)), fabsf(bfhi(w.x)))), fmaxf(fabsf(bflo(w.y)), fabsf(bfhi(w.y)))), fmaxf(fmaxf(fabsf(bflo(w.z)), fabsf(bfhi(w.z))), fmaxf(fabsf(bflo(w.w)), fabsf(bfhi(w.w))))); }
            am = wave_max(am);
            __syncthreads();
            if (F.lane == 0) red[F.wave] = am;
            __syncthreads();
            am = fmaxf(fmaxf(fmaxf(red[0], red[1]), fmaxf(red[2], red[3])), fmaxf(fmaxf(red[4], red[5]), fmaxf(red[6], red[7]))); am = fmaxf(am, 1e-20f);
            const float inv = 127.0f / am; u32x2* dst = (u32x2*)(WSP(signed char, WS_HID8) + (size_t)ms * DFF);
#pragma unroll
            for (int i = 0; i < 3; ++i) { const int c = F.tid + 512 * i; const u32x4 w = v[i]; u32x2 o; o.x = q8x4(bflo(w.x) * inv, bfhi(w.x) * inv, bflo(w.y) * inv, bfhi(w.y) * inv); o.y = q8x4(bflo(w.z) * inv, bfhi(w.z) * inv, bflo(w.w) * inv, bfhi(w.w) * inv);
                if (c < 1376) dst[c] = o; }
            if (F.wave == 0) WSP(float, WS_SA2)[(size_t)ms * 64 + F.lane] = am * (1.0f / 127.0f);
        }
    }
    for (int m = gw; m < TP; m += NGW) {
        const u32x4* src = (const u32x4*)(WSP(bf16, WS_HID) + (size_t)m * DFF) + F.lane;
        u32x4 v[22]; float am = 0.f;
#pragma unroll
        for (int i = 0; i < 22; ++i) { v[i] = (u32x4){0u, 0u, 0u, 0u}; if (i < 21 || F.lane < 32) v[i] = __builtin_nontemporal_load(src + 64 * i); }
#pragma unroll
        for (int i = 0; i < 22; ++i) { const u32x4 w = v[i];
            am = fmaxf(fmaxf(fmaxf(am, fmaxf(fabsf(bflo(w.x)), fabsf(bfhi(w.x)))), fmaxf(fabsf(bflo(w.y)), fabsf(bfhi(w.y)))), fmaxf(fmaxf(fabsf(bflo(w.z)), fabsf(bfhi(w.z))), fmaxf(fabsf(bflo(w.w)), fabsf(bfhi(w.w))))); }
        am = fmaxf(wave_max(am), 1e-20f); const float inv = 127.0f / am;
        u32x2* dst = (u32x2*)(WSP(signed char, WS_HID8) + (size_t)m * DFF) + F.lane;
#pragma unroll
        for (int i = 0; i < 22; ++i) { const u32x4 w = v[i]; u32x2 o; o.x = q8x4(bflo(w.x) * inv, bfhi(w.x) * inv, bflo(w.y) * inv, bfhi(w.y) * inv); o.y = q8x4(bflo(w.z) * inv, bfhi(w.z) * inv, bflo(w.w) * inv, bfhi(w.w) * inv);
            if (i < 21 || F.lane < 32) dst[64 * i] = o; }
        WSP(float, WS_SA2)[(size_t)m * 64 + F.lane] = am * (1.0f / 127.0f);
    }
}
__device__ __forceinline__ void zero_dbuf_tail(Frame& F) {
    const int gt = F.vcu * NTHREADS + F.tid, NT = F.G * NTHREADS;
    u32x4* z = (u32x4*)(WSP(float, WS_DBUF) + (size_t)TP * D);
    for (int i = gt; i < 256 * D / 4; i += NT) z[i] = (u32x4){0u, 0u, 0u, 0u};
}
template <int NT_TOTAL, bool I8 = false>
__device__ __forceinline__ void gemm_tail_splitk(Frame& F, const bf16* A, int lda, const bf16* Bt, int ldb, const float* sa = nullptr, float sw = 0.f) {
    const int c = F.vcu; if (c >= 256) return;
    const int pn = c & 15, ch = c >> 4;
    constexpr int SMALL = (NT_TOTAL / 16) & ~1, R = (NT_TOTAL - 16 * SMALL) / 2, BIG = SMALL + 2;
    static_assert(R >= 0 && R <= 16 && R * BIG + (16 - R) * SMALL == NT_TOTAL && SMALL >= 4, "split");
    const int k0 = (ch < R) ? ch * BIG : R * BIG + (ch - R) * SMALL, len = (ch < R) ? BIG : SMALL;
    pg8::Gemm g{A + (size_t)TP * lda + (size_t)k0 * 64, Bt + (size_t)k0 * 64, lda, ldb, len * 64, 0, 0};
    pg8::OneUnit S{pn};
    if constexpr (I8) { pg8::EpiBf16S E{WSP(bf16, WS_SLAB) + (size_t)ch * 256 * D, D, sa + (size_t)TP * 64, sw}; pg8::gemm_phase<pg8::EpiBf16S, pg8::OneUnit, true, true, false, true>(F.lds, g, S, E); }
    else { pg8::EpiBf16 E{WSP(bf16, WS_SLAB) + (size_t)ch * 256 * D, D}; pg8::gemm_phase<pg8::EpiBf16, pg8::OneUnit, true, true>(F.lds, g, S, E); }
}

__device__ __forceinline__ void p7_sample_qk(Frame& F) {
    for (int unit = F.vcu; unit < 64; unit += F.G) {
    const int h = unit >> 4, isk = (unit >> 3) & 1, cs = unit & 7;
    int lane_l = F.lane; asm volatile("" : "+v"(lane_l));
    const int fr = lane_l & 15, fq = lane_l >> 4;
    const bf16* A = WSP(bf16, WS_CV) + (size_t)(TP + 32 * F.wave + fr) * 2048 + h * 512 + 8 * fq;
    const bf16* B = WSP(bf16, WS_WQK) + (size_t)h * 512 * 512 + (size_t)(isk * 256 + cs * 32 + fr) * 512 + 8 * fq;
    f32x4 acc[2][2];
#pragma unroll
    for (int i = 0; i < 2; ++i)
#pragma unroll
        for (int j = 0; j < 2; ++j) acc[i][j] = (f32x4){0.f, 0.f, 0.f, 0.f};
#pragma unroll 4
    for (int ks = 0; ks < 16; ++ks) {
        bf16x8 a[2], b[2];
#pragma unroll
        for (int i = 0; i < 2; ++i) a[i] = *(const bf16x8*)(A + (size_t)(16 * i) * 2048 + 32 * ks);
#pragma unroll
        for (int j = 0; j < 2; ++j) b[j] = *(const bf16x8*)(B + (size_t)(16 * j) * 512 + 32 * ks);
#pragma unroll
        for (int i = 0; i < 2; ++i)
#pragma unroll
            for (int j = 0; j < 2; ++j) acc[i][j] = __builtin_amdgcn_mfma_f32_16x16x32_bf16(a[i], b[j], acc[i][j], 0, 0, 0);
    }
    bf16* O = (isk ? WSP(bf16, WS_K) : WSP(bf16, WS_Q)) + (size_t)(TP + 32 * F.wave) * 1024 + h * 256 + cs * 32;
#pragma unroll
    for (int i = 0; i < 2; ++i)
#pragma unroll
        for (int j = 0; j < 2; ++j)
#pragma unroll
            for (int r = 0; r < 4; ++r) { const float own = acc[i][j][r], oth = __shfl_xor(own, 1);
                if (!(fr & 1)) *(unsigned*)(O + (size_t)(16 * i + 4 * fq + r) * 1024 + 16 * j + fr) = cvt_pk_bf16(own, oth); }
    }
}
__device__ __forceinline__ void p5_conv(Frame& F) {
    const int gt = F.vcu * NTHREADS + F.tid, NT = F.G * NTHREADS;
    const bf16* PB = WSP(bf16, WS_PB);
    {
        const int c8 = (gt & 255) * 8; bf16* CV = WSP(bf16, WS_CV);
        const float* cw = F.in[I_CONVW]; const float* cb = F.in[I_CONVB]; const float* cache = F.in[I_CONV];
        float w[4][8], bb[8];
#pragma unroll
        for (int j = 0; j < 4; ++j) { const f32x4 w0 = *(const f32x4*)(cw + j * 2048 + c8), w1 = *(const f32x4*)(cw + j * 2048 + c8 + 4);
            w[j][0] = w0.x; w[j][1] = w0.y; w[j][2] = w0.z; w[j][3] = w0.w; w[j][4] = w1.x; w[j][5] = w1.y; w[j][6] = w1.z; w[j][7] = w1.w; }
        { const f32x4 b0 = *(const f32x4*)(cb + c8), b1 = *(const f32x4*)(cb + c8 + 4); bb[0] = b0.x; bb[1] = b0.y; bb[2] = b0.z; bb[3] = b0.w; bb[4] = b1.x; bb[5] = b1.y; bb[6] = b1.z; bb[7] = b1.w; }
        for (int rb = gt >> 8; rb < T / 4; rb += NT >> 8) {
            const int row = 4 * rb; int pos, sb; if (row < TP) { pos = row; sb = -1; } else { pos = (row - TP) & 15; sb = (row - TP) >> 4; }
            u32x4 raw[7];
#pragma unroll
            for (int i = 0; i < 7; ++i) { const int rr = (pos - 3 + i >= 0) ? row - 3 + i : row; raw[i] = *(const u32x4*)(PB + (size_t)rr * 8192 + c8); }
            float u[7][8];
#pragma unroll
            for (int i = 0; i < 7; ++i) { const u32x4 q = raw[i]; u[i][0] = bflo(q.x); u[i][1] = bfhi(q.x); u[i][2] = bflo(q.y); u[i][3] = bfhi(q.y); u[i][4] = bflo(q.z); u[i][5] = bfhi(q.z); u[i][6] = bflo(q.w); u[i][7] = bfhi(q.w); }
            if (pos == 0) {
#pragma unroll
                for (int i = 0; i < 3; ++i) {
                    if (sb >= 0) { const float* cp = cache + ((size_t)sb * 3 + i) * 2048 + c8; const f32x4 a = *(const f32x4*)cp, b = *(const f32x4*)(cp + 4);
                        u[i][0] = a.x; u[i][1] = a.y; u[i][2] = a.z; u[i][3] = a.w; u[i][4] = b.x; u[i][5] = b.y; u[i][6] = b.z; u[i][7] = b.w; }
                    else {
#pragma unroll
                        for (int e = 0; e < 8; ++e) u[i][e] = 0.f; } } }
#pragma unroll
            for (int r = 0; r < 4; ++r) { float acc[8];
#pragma unroll
                for (int e = 0; e < 8; ++e) { float a = bb[e];
#pragma unroll
                    for (int j = 0; j < 4; ++j) a += u[r + j][e] * w[j][e];
                    acc[e] = siluf_(a); }
                u32x4 o; o.x = cvt_pk_bf16(acc[0], acc[1]); o.y = cvt_pk_bf16(acc[2], acc[3]); o.z = cvt_pk_bf16(acc[4], acc[5]); o.w = cvt_pk_bf16(acc[6], acc[7]);
                *(u32x4*)(CV + (size_t)(row + r) * 2048 + c8) = o; }
        }
    }
    for (int idx = gt; idx < 17 * 3 * 2048; idx += NT) {
        const int c = idx & 2047, r = (idx >> 11) % 3, sq = idx / (3 * 2048);
        const int row = (sq == 0) ? (TP - 3 + r) : (TP + (sq - 1) * 16 + 13 + r);
        const float v = bf2f(PB[(size_t)row * 8192 + c]);
        if (sq == 0) F.out[O_CONVP + (size_t)r * 2048 + c] = v; else F.out[O_CONVS + ((size_t)(sq - 1) * 3 + r) * 2048 + c] = v;
    }
}
__device__ __forceinline__ void p5_gates(Frame& F) {
    const int gw = F.vcu * NWAVES + F.wave, NGW = F.G * NWAVES;
    const float* GATES = WSP(float, WS_GATES);
    for (int task = gw; task < NSU * NH; task += NGW) {
        const int su = task >> 2, h = task & 3, row0 = su_row0(su), len = su_len(su);
        const float bi = F.in[I_BI][h], bfv = F.in[I_BF][h];
        float lf[4], ig[4];
#pragma unroll
        for (int i = 0; i < 4; ++i) { const int tl = 4 * F.lane + i;
            if (tl < len) { const float* gp = GATES + (size_t)(row0 + tl) * 8; ig[i] = gp[h] + bi; lf[i] = logsigmoidf_(gp[4 + h] + bfv); } else { ig[i] = -INFINITY; lf[i] = 0.f; } }
        float c[4]; c[0] = lf[0]; c[1] = c[0] + lf[1]; c[2] = c[1] + lf[2]; c[3] = c[2] + lf[3];
        float incl = c[3];
#pragma unroll
        for (int o = 1; o < 64; o <<= 1) { const float t = __shfl_up(incl, o); if (F.lane >= o) incl += t; }
        const float excl = incl - c[3];
        float b[4], a[4], mr[4];
#pragma unroll
        for (int i = 0; i < 4; ++i) { b[i] = excl + c[i]; a[i] = ig[i] - b[i]; }
        mr[0] = a[0]; mr[1] = fmaxf(mr[0], a[1]); mr[2] = fmaxf(mr[1], a[2]); mr[3] = fmaxf(mr[2], a[3]);
        float mincl = mr[3];
#pragma unroll
        for (int o = 1; o < 64; o <<= 1) { const float t = __shfl_up(mincl, o); if (F.lane >= o) mincl = fmaxf(mincl, t); }
        float mexcl = __shfl_up(mincl, 1); if (F.lane == 0) mexcl = -INFINITY;
#pragma unroll
        for (int i = 0; i < 4; ++i) { const int tl = 4 * F.lane + i;
            if (tl < len) { const size_t o = (size_t)h * T + row0 + tl; WSP(float, WS_BARR)[o] = b[i]; WSP(float, WS_AARR)[o] = a[i]; WSP(float, WS_MRUN)[o] = fmaxf(mexcl, mr[i]); } }
        const float tot = __shfl(incl, 63), mx = __shfl(mincl, 63);
        if (F.lane == 0) { WSP(float, WS_SUA)[su * 4 + h] = mx; WSP(float, WS_SUB)[su * 4 + h] = tot; }
    }
}
struct S5C {
    float a1r[4], a1i[4], a2r[4], a2i[4], a3r[4], a3i[4], a4r[4], a4i[4], afr[4], afi[4], a8r[4], a8i[4], a16r[4], a16i[4];
    bf16x8 bfr[8];
};
#define CMULADD(orr, oi, ar_, ai_, xr_, xi_, br_, bi_) do { float _r = __builtin_fmaf((ar_), (xr_), __builtin_fmaf(-(ai_), (xi_), (br_))); asm volatile("" : "+v"(_r)); const float _i = __builtin_fmaf((ar_), (xi_), __builtin_fmaf((ai_), (xr_), (bi_))); orr = _r; oi = _i; } while (0)
__device__ __forceinline__ void s5_setup(Frame& F, int g, int fr, int fq, S5C& c) {
#pragma unroll
    for (int nb = 0; nb < 4; ++nb) {
        const int p = 16 * nb + fr; const float ar = WSP(float, WS_S5AB)[g * 64 + p], ai = WSP(float, WS_S5AB)[8192 + g * 64 + p];
        c.a1r[nb] = ar; c.a1i[nb] = ai;
        float a2r, a2i; CMULADD(a2r, a2i, ar, ai, ar, ai, 0.f, 0.f);
        c.a2r[nb] = a2r; c.a2i[nb] = a2i; CMULADD(c.a3r[nb], c.a3i[nb], a2r, a2i, ar, ai, 0.f, 0.f);
        CMULADD(c.a4r[nb], c.a4i[nb], a2r, a2i, a2r, a2i, 0.f, 0.f);
        CMULADD(c.a8r[nb], c.a8i[nb], c.a4r[nb], c.a4i[nb], c.a4r[nb], c.a4i[nb], 0.f, 0.f);
        float a12r, a12i; CMULADD(a12r, a12i, c.a8r[nb], c.a8i[nb], c.a4r[nb], c.a4i[nb], 0.f, 0.f);
        CMULADD(c.a16r[nb], c.a16i[nb], c.a8r[nb], c.a8i[nb], c.a8r[nb], c.a8i[nb], 0.f, 0.f);
        c.afr[nb] = fq == 0 ? 1.f : fq == 1 ? c.a4r[nb] : fq == 2 ? c.a8r[nb] : a12r;
        c.afi[nb] = fq == 0 ? 0.f : fq == 1 ? c.a4i[nb] : fq == 2 ? c.a8i[nb] : a12i;
    }
    f32x4 bq[8][2];
#pragma unroll
    for (int nbt = 0; nbt < 8; ++nbt) {
        const float* q = WSP(float, WS_S5BB) + (nbt >= 4 ? 131072 : 0) + ((size_t)g * 64 + 16 * (nbt & 3) + fr) * 16 + 8 * (fq & 1); bq[nbt][0] = *(const f32x4*)q; bq[nbt][1] = *(const f32x4*)(q + 4); }
#pragma unroll
    for (int nbt = 0; nbt < 8; ++nbt) { const f32x4 a = bq[nbt][0], b = bq[nbt][1];
        u32x4 w; w.x = cvt_pk_bf16(a.x, a.y); w.y = cvt_pk_bf16(a.z, a.w); w.z = cvt_pk_bf16(b.x, b.y); w.w = cvt_pk_bf16(b.z, b.w);
        if (fq >= 2) w = (u32x4){0u, 0u, 0u, 0u};
        c.bfr[nbt] = __builtin_bit_cast(bf16x8, w); }
}
template <bool FINAL>
__device__ __forceinline__ void s5_block(const S5C& c, const bf16x8 uf, int fr, int fq, float (&hr)[4], float (&hi)[4], LAS unsigned char* hs) {
    const bool odd = (fq & 1) != 0, up = (fq & 2) != 0;
#pragma unroll
    for (int nb = 0; nb < 4; ++nb) {
        const f32x4 dre = __builtin_amdgcn_mfma_f32_16x16x32_bf16(uf, c.bfr[nb], (f32x4){0.f, 0.f, 0.f, 0.f}, 0, 0, 0);
        const f32x4 dim = __builtin_amdgcn_mfma_f32_16x16x32_bf16(uf, c.bfr[nb + 4], (f32x4){0.f, 0.f, 0.f, 0.f}, 0, 0, 0);
        float lr[4], li[4];
#pragma unroll
        for (int r = 0; r < 4; ++r) { lr[r] = dre[r]; li[r] = dim[r]; }
#pragma unroll
        for (int r = 1; r < 4; ++r) CMULADD(lr[r], li[r], c.a1r[nb], c.a1i[nb], lr[r - 1], li[r - 1], lr[r], li[r]);
        const float p1r = __shfl_xor(lr[3], 16), p1i = __shfl_xor(li[3], 16);
        const float lor = odd ? p1r : lr[3], loi = odd ? p1i : li[3], hir = odd ? lr[3] : p1r, hii = odd ? li[3] : p1i;
        float tpr, tpi; CMULADD(tpr, tpi, c.a4r[nb], c.a4i[nb], lor, loi, hir, hii);
        const float p2r = __shfl_xor(tpr, 32), p2i = __shfl_xor(tpi, 32);
        const float t01r = up ? p2r : tpr, t01i = up ? p2i : tpi, t23r = up ? tpr : p2r, t23i = up ? tpi : p2i;
        if (FINAL) {
            float xr, xi; CMULADD(xr, xi, c.a4r[nb], c.a4i[nb], t01r, t01i, lor, loi);
            const float prer = up ? (odd ? xr : t01r) : (odd ? lor : 0.f), prei = up ? (odd ? xi : t01i) : (odd ? loi : 0.f);
            float cr, ci; CMULADD(cr, ci, c.afr[nb], c.afi[nb], hr[nb], hi[nb], prer, prei);
            float h0r, h0i, h1r, h1i, h2r, h2i, h3r, h3i;
            CMULADD(h0r, h0i, c.a1r[nb], c.a1i[nb], cr, ci, lr[0], li[0]);
            CMULADD(h1r, h1i, c.a2r[nb], c.a2i[nb], cr, ci, lr[1], li[1]);
            CMULADD(h2r, h2i, c.a3r[nb], c.a3i[nb], cr, ci, lr[2], li[2]);
            CMULADD(h3r, h3i, c.a4r[nb], c.a4i[nb], cr, ci, lr[3], li[3]);
            LAS unsigned char* hp = hs + (4 * fq) * 272 + (16 * nb + fr) * 4;
            *(LAS unsigned*)(hp) = cvt_pk_bf16(h0r, h0i); *(LAS unsigned*)(hp + 272) = cvt_pk_bf16(h1r, h1i); *(LAS unsigned*)(hp + 544) = cvt_pk_bf16(h2r, h2i); *(LAS unsigned*)(hp + 816) = cvt_pk_bf16(h3r, h3i);
        }
        float nr, ni; CMULADD(nr, ni, c.a8r[nb], c.a8i[nb], t01r, t01i, t23r, t23i);
        CMULADD(hr[nb], hi[nb], c.a16r[nb], c.a16i[nb], hr[nb], hi[nb], nr, ni);
    }
}
__device__ __forceinline__ bf16x8 s5_ufrag(const bf16* PB, int row, int g, int fq) {
    u32x4 w = (u32x4){0u, 0u, 0u, 0u}; if (fq < 2) w = *(const u32x4*)(PB + (size_t)row * 8192 + 6144 + g * 16 + 8 * fq);
    return __builtin_bit_cast(bf16x8, w);
}
__device__ __forceinline__ void s5_stage_u(const bf16* PB, int row0, int len, int g, LAS unsigned char* ul, int lane) {
    u32x4 st[8];
#pragma unroll
    for (int i = 0; i < 8; ++i) { const int c = lane + 64 * i, row = c >> 1, half = c & 1; const int rc = row < len ? row : len - 1;
        st[i] = *(const u32x4*)(PB + (size_t)(row0 + rc) * 8192 + 6144 + g * 16 + 8 * half); }
#pragma unroll
    for (int i = 0; i < 8; ++i) { const int c = lane + 64 * i, row = c >> 1; if (row < len) *(LAS u32x4*)(ul + c * 16) = st[i]; }
    asm volatile("s_waitcnt vmcnt(0) lgkmcnt(0)" ::: "memory"); __builtin_amdgcn_wave_barrier();
}
__device__ __forceinline__ bf16x8 s5_ufrag_lds(const LAS unsigned char* ul, int blk, int fr, int fq) {
    u32x4 w = (u32x4){0u, 0u, 0u, 0u}; if (fq < 2) w = *(const LAS u32x4*)(ul + ((16 * blk + fr) * 2 + fq) * 16);
    return __builtin_bit_cast(bf16x8, w);
}
__device__ __forceinline__ void p5_s5_local(Frame& F) {
    const int gw = F.vcu * NWAVES + F.wave, NGW = F.G * NWAVES, fr = F.lane & 15, fq = F.lane >> 4;
    const bf16* PB = WSP(bf16, WS_PB);
    unsigned* ticket = (unsigned*)(F.ws + WS_CTL) + 16384 + 64 * (4 + 16 * F.pp);
    for (;;) {
        int task = 0; if (F.lane == 0) task = (int)__hip_atomic_fetch_add(ticket, 1u, __ATOMIC_RELAXED, __HIP_MEMORY_SCOPE_AGENT);
        task = __builtin_amdgcn_readfirstlane(task);
        if (task >= 31 * NG) break;
        const int su = task >> 7, g = task & 127, row0 = su * 256;
        S5C c; s5_setup(F, g, fr, fq, c);
        float hr[4] = {0.f, 0.f, 0.f, 0.f}, hi[4] = {0.f, 0.f, 0.f, 0.f};
        LAS unsigned char* ul = F.lds + F.wave * 16384;
        s5_stage_u(PB, row0, 256, g, ul, F.lane);
        for (int blk = 0; blk < 16; ++blk) s5_block<false>(c, s5_ufrag_lds(ul, blk, fr, fq), fr, fq, hr, hi, nullptr);
        asm volatile("s_waitcnt lgkmcnt(0)" ::: "memory"); __builtin_amdgcn_wave_barrier();
        if (fq == 0) {
#pragma unroll
            for (int nb = 0; nb < 4; ++nb) { const size_t o = (size_t)su * 8192 + g * 64 + 16 * nb + fr; WSP(float, WS_S5LOC)[o] = hr[nb]; WSP(float, WS_S5LOC)[(size_t)32 * 8192 + o] = hi[nb]; }
        }
    }
}
__device__ __forceinline__ void p7_s5_final(Frame& F) {
    const int gw = F.vcu * NWAVES + F.wave, NGW = F.G * NWAVES;
    LAS unsigned char* ul = F.lds + F.wave * 16384;
    LAS unsigned char* hs = ul + 8192;
    const bf16* PB = WSP(bf16, WS_PB); bf16* Gb = WSP(bf16, WS_G);
    const int fr = F.lane & 15, fq = F.lane >> 4;
    for (int task = gw; task < NSU * NG; task += NGW) {
        const int su = task >> 7, g = task & 127, row0 = su_row0(su), len = su_len(su);
        S5C c; s5_setup(F, g, fr, fq, c);
        float hr[4], hi[4];
        if (su < 32) {
            float pr[4], pi[4];
#pragma unroll
            for (int nb = 0; nb < 4; ++nb) { pr[nb] = c.a16r[nb]; pi[nb] = c.a16i[nb];
#pragma unroll
                for (int s = 0; s < 4; ++s) CMULADD(pr[nb], pi[nb], pr[nb], pi[nb], pr[nb], pi[nb], 0.f, 0.f);
                hr[nb] = 0.f; hi[nb] = 0.f; }
            for (int s0 = 0; s0 < su; s0 += 8) {
                float lr[4][8], li[4][8];
#pragma unroll
                for (int nb = 0; nb < 4; ++nb)
#pragma unroll
                    for (int k = 0; k < 8; ++k) { const int s = (s0 + k < su) ? s0 + k : su - 1; const size_t o = (size_t)s * 8192 + g * 64 + 16 * nb + fr; lr[nb][k] = WSP(float, WS_S5LOC)[o]; li[nb][k] = WSP(float, WS_S5LOC)[(size_t)32 * 8192 + o]; }
#pragma unroll
                for (int k = 0; k < 8; ++k) if (s0 + k < su) {
#pragma unroll
                    for (int nb = 0; nb < 4; ++nb) CMULADD(hr[nb], hi[nb], pr[nb], pi[nb], hr[nb], hi[nb], lr[nb][k], li[nb][k]); }
            }
        } else {
#pragma unroll
            for (int nb = 0; nb < 4; ++nb) { const int p = 16 * nb + fr; hr[nb] = F.in[I_S5RE][(size_t)(su - 32) * 8192 + g * 64 + p]; hi[nb] = F.in[I_S5IM][(size_t)(su - 32) * 8192 + g * 64 + p]; }
        }
        bf16x8 cf[4], dmf;
#pragma unroll
        for (int ks = 0; ks < 4; ++ks) {
            const size_t o = ((size_t)g * 16 + fr) * 64 + 16 * ks + 4 * fq; const f32x4 a = *(const f32x4*)(F.in[I_CRE] + o), b = *(const f32x4*)(F.in[I_CIM] + o);
            u32x4 w; w.x = cvt_pk_bf16(a.x, -b.x); w.y = cvt_pk_bf16(a.y, -b.y); w.z = cvt_pk_bf16(a.z, -b.z); w.w = cvt_pk_bf16(a.w, -b.w);
            cf[ks] = __builtin_bit_cast(bf16x8, w); }
        { const float dj = F.in[I_S5D][g * 16 + fr]; float e[8];
#pragma unroll
          for (int k = 0; k < 8; ++k) e[k] = (8 * fq + k == fr) ? dj : 0.f;
          u32x4 w; w.x = cvt_pk_bf16(e[0], e[1]); w.y = cvt_pk_bf16(e[2], e[3]); w.z = cvt_pk_bf16(e[4], e[5]); w.w = cvt_pk_bf16(e[6], e[7]); dmf = __builtin_bit_cast(bf16x8, w); }
        const int nblk = len >> 4;
        s5_stage_u(PB, row0, len, g, ul, F.lane);
        for (int blk = 0; blk < nblk; ++blk) {
            const bf16x8 uf = s5_ufrag_lds(ul, blk, fr, fq);
            s5_block<true>(c, uf, fr, fq, hr, hi, hs);
            asm volatile("s_waitcnt lgkmcnt(0)" ::: "memory"); __builtin_amdgcn_wave_barrier();
            f32x4 acc = __builtin_amdgcn_mfma_f32_16x16x32_bf16(uf, dmf, (f32x4){0.f, 0.f, 0.f, 0.f}, 0, 0, 0);
#pragma unroll
            for (int ks = 0; ks < 4; ++ks) { const bf16x8 af = *(const LAS bf16x8*)(hs + fr * 272 + (32 * ks + 8 * fq) * 2); acc = __builtin_amdgcn_mfma_f32_16x16x32_bf16(af, cf[ks], acc, 0, 0, 0); }
#pragma unroll
            for (int r = 0; r < 4; ++r) {
                const float own = gelu_tanh(acc[r]), oth = __shfl_xor(own, 1);
                if (!(fr & 1)) *(unsigned*)(Gb + (size_t)(row0 + 16 * blk + 4 * fq + r) * 2048 + g * 16 + fr) = cvt_pk_bf16(own, oth); }
            asm volatile("s_waitcnt lgkmcnt(0)" ::: "memory"); __builtin_amdgcn_wave_barrier();
        }
        if (fq == 0) {
#pragma unroll
            for (int nb = 0; nb < 4; ++nb) { const int p = 16 * nb + fr;
                if (su == 31) { F.out[O_S5REP + g * 64 + p] = hr[nb]; F.out[O_S5IMP + g * 64 + p] = hi[nb]; }
                if (su >= 32) { F.out[O_S5RES + (size_t)(su - 32) * 8192 + g * 64 + p] = hr[nb]; F.out[O_S5IMS + (size_t)(su - 32) * 8192 + g * 64 + p] = hi[nb]; } }
        }
    }
}

__device__ __forceinline__ bf16x8 tr_frag(const LAS unsigned char* p0, const LAS unsigned char* p1) {
    const s16x4 a = __builtin_amdgcn_ds_read_tr16_b64_v4i16((LAS s16x4*)p0), b = __builtin_amdgcn_ds_read_tr16_b64_v4i16((LAS s16x4*)p1);
    bf16x8 f; f[0] = a[0]; f[1] = a[1]; f[2] = a[2]; f[3] = a[3]; f[4] = b[0]; f[5] = b[1]; f[6] = b[2]; f[7] = b[3]; return f;
}
__device__ __forceinline__ void p7_m1(Frame& F) {
    constexpr int KP = 528, VP1 = 272;
    LAS unsigned char* KT = F.lds; LAS unsigned char* VT = F.lds + 64 * KP;
    const bf16* Kg = WSP(bf16, WS_K); const bf16* PB = WSP(bf16, WS_PB); const float* AARR = WSP(float, WS_AARR);
    int lane_l = F.lane; asm volatile("" : "+v"(lane_l));
    const int w = F.wave, wd = w >> 1, we = w & 1, fr = lane_l & 15, fq = lane_l >> 4;
    for (int unit = F.vcu; unit < 512; unit += F.G) {
        const int su = unit >> 4, h = (unit >> 2) & 3, es = unit & 3, row0 = su * 256;
        const float Asu = WSP(float, WS_SUA)[su * 4 + h];
        f32x4 acc[4][4];
#pragma unroll
        for (int i = 0; i < 4; ++i)
#pragma unroll
            for (int j = 0; j < 4; ++j) acc[i][j] = (f32x4){0.f, 0.f, 0.f, 0.f};
        float nk = 0.f;
        u32x4 pk[4], pv[2]; float pa[4];
#define M1_PREFETCH(KT_) do { const int s0_ = row0 + 64 * (KT_); int tq_ = F.tid; asm volatile("" : "+v"(tq_)); \
            _Pragma("unroll") for (int i = 0; i < 4; ++i) { const int c = tq_ + 512 * i, row = c >> 5, cc = c & 31; pa[i] = AARR[(size_t)h * T + s0_ + row]; pk[i] = *(const u32x4*)(Kg + (size_t)(s0_ + row) * 1024 + h * 256 + cc * 8); } \
            _Pragma("unroll") for (int i = 0; i < 2; ++i) { const int c = tq_ + 512 * i, row = c >> 4, cc = c & 15; pv[i] = *(const u32x4*)(PB + (size_t)(s0_ + row) * 8192 + 2048 + h * 512 + es * 128 + cc * 8); } } while (0)
        M1_PREFETCH(0);
        for (int kt = 0; kt < 4; ++kt) {
            { int tq = F.tid; asm volatile("" : "+v"(tq));
#pragma unroll
              for (int i = 0; i < 4; ++i) { const int c = tq + 512 * i, row = c >> 5, cc = c & 31;
                const float wgt = __expf(pa[i] - Asu); const u32x4 kv = pk[i];
                u32x4 o; o.x = cvt_pk_bf16(bflo(kv.x) * wgt, bfhi(kv.x) * wgt); o.y = cvt_pk_bf16(bflo(kv.y) * wgt, bfhi(kv.y) * wgt); o.z = cvt_pk_bf16(bflo(kv.z) * wgt, bfhi(kv.z) * wgt); o.w = cvt_pk_bf16(bflo(kv.w) * wgt, bfhi(kv.w) * wgt);
                *(LAS u32x4*)(KT + row * KP + cc * 16) = o; }
#pragma unroll
              for (int i = 0; i < 2; ++i) { const int c = tq + 512 * i, row = c >> 4, cc = c & 15; *(LAS u32x4*)(VT + row * VP1 + cc * 16) = pv[i]; } }
            if (kt + 1 < 4) M1_PREFETCH(kt + 1);
            __syncthreads();
            if (es == 0 && F.tid < 256) { for (int r = 0; r < 64; ++r) nk += bf2f(*(const LAS bf16*)(KT + r * KP + F.tid * 2)); }
#pragma unroll
            for (int ks = 0; ks < 2; ++ks) {
                const int rbase = 32 * ks + 8 * fq + (fr >> 2);
                bf16x8 af[4];
#pragma unroll
                for (int dt = 0; dt < 4; ++dt) { const LAS unsigned char* p = KT + rbase * KP + (64 * wd + 16 * dt + 4 * (fr & 3)) * 2; af[dt] = tr_frag(p, p + 4 * KP); }
#pragma unroll
                for (int et = 0; et < 4; ++et) { const LAS unsigned char* p = VT + rbase * VP1 + (64 * we + 16 * et + 4 * (fr & 3)) * 2; const bf16x8 bfr = tr_frag(p, p + 4 * VP1);
#pragma unroll
                    for (int dt = 0; dt < 4; ++dt) acc[dt][et] = __builtin_amdgcn_mfma_f32_16x16x32_bf16(af[dt], bfr, acc[dt][et], 0, 0, 0); }
            }
            __syncthreads();
        }
        int kvo = (64 * wd + 4 * fq) * 512 + es * 128 + 64 * we + fr; asm volatile("" : "+v"(kvo));
        float* KV = WSP(float, WS_KV) + (size_t)(su * 4 + h) * 131072 + kvo;
#pragma unroll
        for (int dt = 0; dt < 4; ++dt)
#pragma unroll
            for (int et = 0; et < 4; ++et)
#pragma unroll
                for (int r = 0; r < 4; ++r) KV[(16 * dt + r) * 512 + 16 * et] = acc[dt][et][r];
        if (es == 0 && F.tid < 256) WSP(float, WS_NK)[(su * 4 + h) * 256 + F.tid] = nk;
    }
#undef M1_PREFETCH
    __syncthreads();
}
__device__ __forceinline__ void p8_m2(Frame& F) {
    const int gt = F.vcu * NTHREADS + F.tid, NT = F.G * NTHREADS;
    const float* SUA = WSP(float, WS_SUA); const float* SUB = WSP(float, WS_SUB); const float* KV = WSP(float, WS_KV); bf16* C0 = WSP(bf16, WS_C0);
    LAS float* s_ab = (LAS float*)F.lds;
    __syncthreads();
    if (F.tid < 128) { s_ab[F.tid] = SUA[F.tid]; s_ab[128 + F.tid] = SUB[F.tid]; }
    __syncthreads();
    for (int idx2 = gt; idx2 < NH * 131072 / 2; idx2 += NT) {
        const int idx = idx2 * 2, h = idx >> 17, de = idx & 131071; float st0 = 0.f, st1 = 0.f, m = 0.f;
        f32x2 kv[32];
#pragma unroll
        for (int su = 0; su < 32; ++su) kv[su] = __builtin_nontemporal_load((const f32x2*)(KV + (size_t)(su * 4 + h) * 131072 + de));
#pragma unroll
        for (int su = 0; su < 32; ++su) {
            *(unsigned*)(C0 + (size_t)(su * 4 + h) * 131072 + de) = cvt_pk_bf16(st0, st1);
            const float A = s_ab[su * 4 + h], B = s_ab[128 + su * 4 + h], Mx = fmaxf(m, A), al = __expf(m - Mx), be = __expf(A - Mx);
            st0 = al * st0 + be * kv[su].x; st1 = al * st1 + be * kv[su].y; m = B + Mx;
        }
        *(f32x2*)(F.out + O_CP + idx) = (f32x2){st0, st1};
    }
    for (int idx = gt; idx < NH * 256; idx += NT) {
        const int h = idx >> 8, d = idx & 255; float st = 0.f, m = 0.f;
        float nk[32], sa[32], sb[32];
#pragma unroll
        for (int su = 0; su < 32; ++su) { nk[su] = WSP(float, WS_NK)[(su * 4 + h) * 256 + d]; sa[su] = SUA[su * 4 + h]; sb[su] = SUB[su * 4 + h]; }
#pragma unroll
        for (int su = 0; su < 32; ++su) {
            WSP(float, WS_N0)[(su * 4 + h) * 256 + d] = st; if (d == 0) WSP(float, WS_M0)[su * 4 + h] = m;
            const float A = sa[su], B = sb[su], Mx = fmaxf(m, A);
            st = __expf(m - Mx) * st + __expf(A - Mx) * nk[su]; m = B + Mx;
        }
        F.out[O_NP + idx] = st; if (d == 0) F.out[O_MP + h] = m;
    }
    { const float* sc = F.in[I_SC]; bf16* dst = C0 + (size_t)128 * 131072;
      for (int idx = gt; idx < 64 * 131072 / 4; idx += NT) { const f32x4 v = *(const f32x4*)(sc + (size_t)idx * 4); u32x2 w; w.x = cvt_pk_bf16(v.x, v.y); w.y = cvt_pk_bf16(v.z, v.w); *(u32x2*)(dst + (size_t)idx * 4) = w; }
      for (int idx = gt; idx < 64 * 256; idx += NT) WSP(float, WS_N0)[128 * 256 + idx] = F.in[I_SN][idx];
      for (int idx = gt; idx < 64; idx += NT) WSP(float, WS_M0)[128 + idx] = F.in[I_SM][idx]; }
}
__device__ __forceinline__ void p8_m4(Frame& F) {
    LAS float* kw = (LAS float*)F.lds;
    LAS float* vv = (LAS float*)(F.lds + 16384);
    const bf16* Kg = WSP(bf16, WS_K); const bf16* PB = WSP(bf16, WS_PB);
    for (int unit4 = F.vcu; unit4 < 256; unit4 += F.G) {
        const int unit = unit4 >> 2, dq = unit4 & 3, b = unit >> 2, h = unit & 3, su = 32 + b, row0 = su_row0(su);
        const float A = WSP(float, WS_SUA)[su * 4 + h], B = WSP(float, WS_SUB)[su * 4 + h], m0 = F.in[I_SM][b * 4 + h], Mx = fmaxf(m0, A), alpha = __expf(m0 - Mx);
        __syncthreads();
        { const int s = F.tid >> 5, c8 = (F.tid & 31) * 8;
          const u32x4 kq = *(const u32x4*)(Kg + (size_t)(row0 + s) * 1024 + h * 256 + c8); const float wgt = __expf(WSP(float, WS_AARR)[(size_t)h * T + row0 + s] - Mx);
          u32x4 vq[2];
#pragma unroll
          for (int i = 0; i < 2; ++i) { const int c = F.tid + 512 * i, sv = c >> 6, cc = c & 63; vq[i] = *(const u32x4*)(PB + (size_t)(row0 + sv) * 8192 + 2048 + h * 512 + cc * 8); }
          LAS f32x4* kd = (LAS f32x4*)(kw + s * 256 + c8);
          kd[0] = (f32x4){bflo(kq.x) * wgt, bfhi(kq.x) * wgt, bflo(kq.y) * wgt, bfhi(kq.y) * wgt}; kd[1] = (f32x4){bflo(kq.z) * wgt, bfhi(kq.z) * wgt, bflo(kq.w) * wgt, bfhi(kq.w) * wgt};
#pragma unroll
          for (int i = 0; i < 2; ++i) { const int c = F.tid + 512 * i, sv = c >> 6, cc = c & 63; LAS f32x4* vd = (LAS f32x4*)(vv + sv * 512 + cc * 8);
              vd[0] = (f32x4){bflo(vq[i].x), bfhi(vq[i].x), bflo(vq[i].y), bfhi(vq[i].y)}; vd[1] = (f32x4){bflo(vq[i].z), bfhi(vq[i].z), bflo(vq[i].w), bfhi(vq[i].w)}; } }
        __syncthreads();
        const int e4 = F.tid & 127, dg = F.tid >> 7;
        f32x4 vr[16];
#pragma unroll
        for (int s = 0; s < 16; ++s) vr[s] = *(const LAS f32x4*)(vv + s * 512 + e4 * 4);
        const float* c0 = F.in[I_SC] + (size_t)(b * 4 + h) * 131072; float* co = F.out + O_CS + (size_t)(b * 4 + h) * 131072;
        for (int d0 = 64 * dq + dg; d0 < 64 * dq + 64; d0 += 32) {
            f32x4 a[8];
#pragma unroll
            for (int u = 0; u < 8; ++u) a[u] = *(const f32x4*)(c0 + (size_t)(d0 + 4 * u) * 512 + e4 * 4);
#pragma unroll
            for (int u = 0; u < 8; ++u) { a[u] = a[u] * alpha;
#pragma unroll
                for (int s = 0; s < 16; ++s) a[u] += vr[s] * kw[s * 256 + d0 + 4 * u];
                *(f32x4*)(co + (size_t)(d0 + 4 * u) * 512 + e4 * 4) = a[u]; }
        }
        if (dq == 0 && F.tid < 256) { float a = F.in[I_SN][(b * 4 + h) * 256 + F.tid] * alpha;
#pragma unroll
            for (int s = 0; s < 16; ++s) a += kw[s * 256 + F.tid];
            F.out[O_NS + (b * 4 + h) * 256 + F.tid] = a; }
        if (dq == 0 && F.tid == 0) F.out[O_MS + b * 4 + h] = B + Mx;
    }
    __syncthreads();
}
__device__ __forceinline__ void glu_tail_fixup(Frame& F) {
    const int gt = F.vcu * NTHREADS + F.tid, NT = F.G * NTHREADS;
    const float* SL = WSP(float, WS_SLAB); const bf16* Gb = WSP(bf16, WS_G); bf16* MIX = WSP(bf16, WS_HA);
    for (int i = gt; i < 256 * 2048 / 4; i += NT) {
        const int r = i >> 9, c4 = (i & 511) * 4;
        f32x4 z = *(const f32x4*)(F.in[I_BGLU] + c4);
#pragma unroll
        for (int ch = 0; ch < 8; ++ch) z += *(const f32x4*)(SL + ((size_t)ch * 256 + r) * 2048 + c4);
        const u32x2 gw = *(const u32x2*)(Gb + (size_t)(TP + r) * 2048 + c4);
        u32x2 o; o.x = cvt_pk_bf16(bflo(gw.x) * sigmoidf_(z.x), bfhi(gw.x) * sigmoidf_(z.y)); o.y = cvt_pk_bf16(bflo(gw.y) * sigmoidf_(z.z), bfhi(gw.y) * sigmoidf_(z.w));
        *(u32x2*)(MIX + (size_t)(TP + r) * 4096 + 2048 + c4) = o;
    }
}
__device__ __forceinline__ void p9_m3(Frame& F) {
    constexpr int QP = 528, VP = 1040, PP = 144;
    constexpr int OFF_Q = 0, OFF_K = 64 * QP, OFF_V = OFF_K + 64 * QP, OFF_P = OFF_V + 64 * VP, OFF_S = OFF_P + 64 * PP;
    static_assert(OFF_S + 8192 <= LDS_MISC, "M3 LDS");
    LAS unsigned char* QT = F.lds + OFF_Q; LAS unsigned char* KT = F.lds + OFF_K; LAS unsigned char* VT = F.lds + OFF_V; LAS unsigned char* PT = F.lds + OFF_P;
    LAS float* s_a = (LAS float*)(F.lds + OFF_S);
    LAS float* s_M = s_a + 64;
    LAS float* s_w = s_M + 64;
    LAS float* s_em = s_w + 64;
    LAS float* s_den = s_em + 64;
    LAS float* s_n0 = s_den + 64;
    LAS float* s_dp = s_n0 + 256;
    LAS float* s_rs = s_dp + 256;
    volatile LAS int* s_unit = (volatile LAS int*)(s_rs + 256);
    const bf16* Qg = WSP(bf16, WS_Q); const bf16* Kg = WSP(bf16, WS_K); const bf16* PB = WSP(bf16, WS_PB); const bf16* C0 = WSP(bf16, WS_C0); bf16* MIX = WSP(bf16, WS_HA);
    unsigned* ticket = (unsigned*)(F.ws + WS_CTL) + 16384 + 64 * (3 + 16 * F.pp);
    int lane_l = F.lane, tid_l = F.tid; asm volatile("" : "+v"(lane_l), "+v"(tid_l));
    const int w = F.wave, fr = lane_l & 15, fq = lane_l >> 4, tid = tid_l, wt2 = w >> 2, we = w & 3;
    if (tid == 0) s_unit[0] = (int)__hip_atomic_fetch_add(ticket, 1u, __ATOMIC_RELAXED, __HIP_MEMORY_SCOPE_AGENT);
    for (;;) {
        __syncthreads();
        const int unit = s_unit[0];
        if (unit >= 576) break;
        int nextu = 0; if (tid == 0) nextu = (int)__hip_atomic_fetch_add(ticket, 1u, __ATOMIC_RELAXED, __HIP_MEMORY_SCOPE_AGENT);
        int su, h, lt;
        if (unit < 512) { lt = 3 - (unit >> 7); su = (unit & 127) >> 2; h = unit & 3; } else { lt = 0; su = 32 + ((unit - 512) >> 2); h = unit & 3; }
        const int row0 = su_row0(su), len = su_len(su), t0 = row0 + 64 * lt, nvt = (len - 64 * lt) < 64 ? (len - 64 * lt) : 64;
        const float m0 = WSP(float, WS_M0)[su * 4 + h];
        const bf16* C0u = C0 + (size_t)(su * 4 + h) * 131072;
        const int nit = lt + 5;
        u32x4 pk[4], pv[8]; float pa = 0.f;
#define M3_PREFETCH(IT) do { const int it_ = (IT); int tq_ = tid; asm volatile("" : "+v"(tq_)); \
        if (it_ <= lt) { const int s0_ = row0 + 64 * it_, nvs_ = (len - 64 * it_) < 64 ? (len - 64 * it_) : 64; \
            _Pragma("unroll") for (int i = 0; i < 4; ++i) { const int c = tq_ + 512 * i, row = c >> 5, cc = c & 31; \
                pk[i] = (u32x4){0u, 0u, 0u, 0u}; if (row < nvs_) pk[i] = *(const u32x4*)(Kg + (size_t)(s0_ + row) * 1024 + h * 256 + cc * 8); } \
            _Pragma("unroll") for (int i = 0; i < 8; ++i) { const int c = tq_ + 512 * i, row = c >> 6, cc = c & 63; \
                pv[i] = (u32x4){0u, 0u, 0u, 0u}; if (row < nvs_) pv[i] = *(const u32x4*)(PB + (size_t)(s0_ + row) * 8192 + 2048 + h * 512 + cc * 8); } \
            if (tq_ < 64) pa = (tq_ < nvs_) ? WSP(float, WS_AARR)[(size_t)h * T + s0_ + tq_] : -INFINITY; } \
        else { const int ds_ = it_ - lt - 1; \
            _Pragma("unroll") for (int i = 0; i < 8; ++i) { const int c = tq_ + 512 * i, row = c >> 6, cc = c & 63; pv[i] = *(const u32x4*)(C0u + (size_t)(64 * ds_ + row) * 512 + cc * 8); } } } while (0)
        M3_PREFETCH(0);
        { u32x4 qv[4];
#pragma unroll
          for (int i = 0; i < 4; ++i) { const int c = tid + 512 * i, row = c >> 5, cc = c & 31; const int rc = row < nvt ? row : nvt - 1;
              qv[i] = *(const u32x4*)(Qg + (size_t)(t0 + rc) * 1024 + h * 256 + cc * 8); if (row >= nvt) qv[i] = (u32x4){0u, 0u, 0u, 0u}; }
#pragma unroll
          for (int i = 0; i < 4; ++i) { const int c = tid + 512 * i, row = c >> 5, cc = c & 31; *(LAS u32x4*)(QT + row * QP + cc * 16) = qv[i]; } }
        if (tid < 256) s_n0[tid] = WSP(float, WS_N0)[(su * 4 + h) * 256 + tid];
        if (tid < 64) { float Mt = m0, wt = 1.f, em = 1.f;
            if (tid < nvt) { const size_t o = (size_t)h * T + t0 + tid; const float mr = WSP(float, WS_MRUN)[o], b = WSP(float, WS_BARR)[o]; Mt = fmaxf(m0, mr); wt = __expf(m0 - Mt); em = __expf(-(b + Mt)); }
            s_M[tid] = Mt; s_w[tid] = wt; s_em[tid] = em; }
        f32x4 acc[2][8];
#pragma unroll
        for (int i = 0; i < 2; ++i)
#pragma unroll
            for (int j = 0; j < 8; ++j) acc[i][j] = (f32x4){0.f, 0.f, 0.f, 0.f};
        for (int it = 0; it < nit; ++it) {
            const bool key = it <= lt;
            if (it > 0) __syncthreads();
            if (key) { int tq = tid; asm volatile("" : "+v"(tq));
#pragma unroll
                for (int i = 0; i < 4; ++i) { const int c = tq + 512 * i, row = c >> 5, cc = c & 31; *(LAS u32x4*)(KT + row * QP + cc * 16) = pk[i]; }
                if (tid < 64) s_a[tid] = pa;
            }
            { int tq = tid; asm volatile("" : "+v"(tq));
#pragma unroll
              for (int i = 0; i < 8; ++i) { const int c = tq + 512 * i, row = c >> 6, cc = c & 63; *(LAS u32x4*)(VT + row * VP + cc * 16) = pv[i]; } }
            if (it + 1 < nit) M3_PREFETCH(it + 1);
            if (!key) {
                const int ds = it - lt - 1, t = tid >> 3, part = tid & 7; const float wt = s_w[t]; const u32x4 qv = *(const LAS u32x4*)(QT + t * QP + (64 * ds + 8 * part) * 2);
                u32x4 o; o.x = cvt_pk_bf16(bflo(qv.x) * wt, bfhi(qv.x) * wt); o.y = cvt_pk_bf16(bflo(qv.y) * wt, bfhi(qv.y) * wt); o.z = cvt_pk_bf16(bflo(qv.z) * wt, bfhi(qv.z) * wt); o.w = cvt_pk_bf16(bflo(qv.w) * wt, bfhi(qv.w) * wt);
                *(LAS u32x4*)(PT + t * PP + part * 16) = o; }
            __syncthreads();
            if (key) {
                const int kt = it;
                if (kt == 0) {
                    const int t = tid >> 3, part = tid & 7; float s = 0.f;
#pragma unroll
                    for (int c4 = 0; c4 < 4; ++c4) { const u32x4 qv = *(const LAS u32x4*)(QT + t * QP + (32 * part + 8 * c4) * 2); const LAS float* nn = s_n0 + 32 * part + 8 * c4;
                        s += bflo(qv.x) * nn[0] + bfhi(qv.x) * nn[1] + bflo(qv.y) * nn[2] + bfhi(qv.y) * nn[3] + bflo(qv.z) * nn[4] + bfhi(qv.z) * nn[5] + bflo(qv.w) * nn[6] + bfhi(qv.w) * nn[7]; }
                    s += __shfl_xor(s, 1); s += __shfl_xor(s, 2); s += __shfl_xor(s, 4);
                    if (part == 0) s_den[t] = s_w[t] * s;
                }
                { const int st = w & 3, tp = w >> 2;
                  f32x4 sacc[2] = {(f32x4){0.f, 0.f, 0.f, 0.f}, (f32x4){0.f, 0.f, 0.f, 0.f}};
#pragma unroll
                  for (int kk = 0; kk < 8; ++kk) { const bf16x8 af = *(const LAS bf16x8*)(KT + (16 * st + fr) * QP + (32 * kk + 8 * fq) * 2);
#pragma unroll
                      for (int j = 0; j < 2; ++j) { const bf16x8 bq = *(const LAS bf16x8*)(QT + (16 * (2 * tp + j) + fr) * QP + (32 * kk + 8 * fq) * 2); sacc[j] = __builtin_amdgcn_mfma_f32_16x16x32_bf16(af, bq, sacc[j], 0, 0, 0); } }
#pragma unroll
                  for (int j = 0; j < 2; ++j) { const int tl = 16 * (2 * tp + j) + fr; const float Mt = s_M[tl]; float pvv[4], ps = 0.f;
#pragma unroll
                      for (int r = 0; r < 4; ++r) { const int sl = 16 * st + 4 * fq + r; const bool ok = (64 * kt + sl) <= (64 * lt + tl);
                          const float e = ok ? __expf(s_a[sl] - Mt) : 0.f; pvv[r] = ok ? sacc[j][r] * e : 0.f; ps += pvv[r]; }
                      ps += __shfl_xor(ps, 16); ps += __shfl_xor(ps, 32);
                      if (fq == 0) s_dp[tl * 4 + st] = ps;
                      u32x2 pw; pw.x = cvt_pk_bf16(pvv[0], pvv[1]); pw.y = cvt_pk_bf16(pvv[2], pvv[3]);
                      *(LAS u32x2*)(PT + tl * PP + (16 * st + 4 * fq) * 2) = pw; } }
                __syncthreads();
                if (tid < 64) s_den[tid] += (s_dp[tid * 4] + s_dp[tid * 4 + 1]) + (s_dp[tid * 4 + 2] + s_dp[tid * 4 + 3]);
            }
#pragma unroll
            for (int ks = 0; ks < 2; ++ks) {
                bf16x8 pf[2];
#pragma unroll
                for (int j = 0; j < 2; ++j) pf[j] = *(const LAS bf16x8*)(PT + (16 * (2 * wt2 + j) + fr) * PP + (32 * ks + 8 * fq) * 2);
#pragma unroll
                for (int et = 0; et < 8; ++et) { const LAS unsigned char* p = VT + (32 * ks + 8 * fq + (fr >> 2)) * VP + (128 * we + 16 * et + 4 * (fr & 3)) * 2; const bf16x8 vf = tr_frag(p, p + 4 * VP);
#pragma unroll
                    for (int j = 0; j < 2; ++j) acc[j][et] = __builtin_amdgcn_mfma_f32_16x16x32_bf16(pf[j], vf, acc[j][et], 0, 0, 0); }
            }
        }
#undef M3_PREFETCH
#pragma unroll
        for (int j = 0; j < 2; ++j)
#pragma unroll
            for (int r = 0; r < 4; ++r) { const int tl = 16 * (2 * wt2 + j) + 4 * fq + r; const float inv = 1.0f / fmaxf(fabsf(s_den[tl]), s_em[tl]); float ss = 0.f;
#pragma unroll
                for (int et = 0; et < 8; ++et) { const float hv = acc[j][et][r] * inv; acc[j][et][r] = hv; ss += hv * hv; }
                ss += __shfl_xor(ss, 1); ss += __shfl_xor(ss, 2); ss += __shfl_xor(ss, 4); ss += __shfl_xor(ss, 8);
                if (fr == 0) s_rs[tl * 4 + we] = ss; }
        __syncthreads();
        const CAS float* hn = (const CAS float*)F.in[I_HN] + h * 512 + 128 * we + fr;
        float hnv[8];
#pragma unroll
        for (int et = 0; et < 8; ++et) hnv[et] = hn[16 * et];
#pragma unroll
        for (int j = 0; j < 2; ++j) {
            bf16 ogr[4][8];
#pragma unroll
            for (int r = 0; r < 4; ++r) { const int tl = 16 * (2 * wt2 + j) + 4 * fq + r; const size_t row = (size_t)(t0 + (tl < nvt ? tl : nvt - 1));
#pragma unroll
                for (int et = 0; et < 8; ++et) ogr[r][et] = __builtin_nontemporal_load(PB + row * 8192 + 4096 + h * 512 + 128 * we + 16 * et + fr); }
#pragma unroll
            for (int r = 0; r < 4; ++r) { const int tl = 16 * (2 * wt2 + j) + 4 * fq + r;
                const float rn = rsqrtf(((s_rs[tl * 4] + s_rs[tl * 4 + 1]) + (s_rs[tl * 4 + 2] + s_rs[tl * 4 + 3])) * (1.f / 512.f) + EPS); const size_t row = (size_t)(t0 + tl);
#pragma unroll
                for (int et = 0; et < 8; ++et) { const int e = 128 * we + 16 * et + fr;
                    const float own = acc[j][et][r] * rn * hnv[et] * sigmoidf_(bf2f(ogr[r][et])), oth = __shfl_xor(own, 1);
                    if (tl < nvt && !(fr & 1)) *(unsigned*)(MIX + row * 4096 + h * 512 + e) = cvt_pk_bf16(own, oth); } } }
        if (tid == 0) s_unit[0] = nextu;
    }
}

constexpr int N_PHASES = 16;
__global__ void __launch_bounds__(NTHREADS, 2) fwd_kernel(Args args) {
    extern __shared__ __attribute__((aligned(16))) unsigned char lds_raw[];
    Frame F;
    F.lds = (LAS unsigned char*)lds_raw;
    F.tid = threadIdx.x; F.lane = F.tid & 63; F.wave = __builtin_amdgcn_readfirstlane(F.tid >> 6);
    F.G = gridDim.x; { const int bx = blockIdx.x; F.vcu = (F.G % 8 == 0) ? (bx % 8) * (F.G / 8) + bx / 8 : bx; }
    F.in = args.in; F.out = args.out; F.ws = args.ws; F.pp = 0;
    volatile LAS unsigned* MISC = (volatile LAS unsigned*)(F.lds + LDS_MISC);
    if (F.tid < 32) MISC[F.tid] = 0u;
    __syncthreads();
    const int lo = args.ph_lo, hi = args.ph_hi;
    const bool multi = (hi - lo) > 1;
    XcdBarrier bar; bar.bar = (unsigned*)(F.ws + WS_CTL) + 4096; bar.x = 0; bar.st = MISC + 8;
    if (multi) bar = xcd_barrier_post((unsigned*)(F.ws + WS_CTL) + 4096, MISC + 8);
#define IN(k) (lo <= (k) && (k) < hi)
#define SEAM(k) do { if (IN(k) && IN((k) + 1)) xcd_barrier(bar); } while (0)
    const int bx = blockIdx.x;

#define PHASE(k, ...) if (IN(k)) { __VA_ARGS__ } SEAM(k); if constexpr (((PROBE_MASK) >> (k)) & 1) { F.pp = 1; if (IN(k)) { __VA_ARGS__ } SEAM(k); F.pp = 0; }
    PHASE(0, p0_stats(F); p0_prologue(F);)
    PHASE(1,
        if (F.G == 256 && bx >= 240) convert_static<1>(F, 240);
        else { const int GG = (F.G == 256) ? 240 : F.G;
        pg8::Gemm g{WSP(bf16, WS_HA), WSP(bf16, WS_W1GU), D, D, D, 0, 0}; pg8::StaticOrder S; S.init(T / 256, 2 * DFF / 256, 1, GG, bx);
        pg8::EpiSwiGLU E{WSP(bf16, WS_HID), DFF};
        pg8::gemm_phase<pg8::EpiSwiGLU, pg8::StaticOrder, true, true>(F.lds, g, S, E);
        if (F.G != 256) convert_static<1>(F, 0); })
    PHASE(2,
        pg8::Gemm g{WSP(bf16, WS_HID), WSP(bf16, WS_W1D), DFF, DFF, DFF, 0, 0}; pg8::StaticOrder S; S.init(32, D / 256, 1, F.G, bx);
        pg8::EpiBf16 E{WSP(bf16, WS_DBUF), D};
        pg8::gemm_phase<pg8::EpiBf16, pg8::StaticOrder, true, true>(F.lds, g, S, E);
        gemm_tail_splitk<172>(F, WSP(bf16, WS_HID), DFF, WSP(bf16, WS_W1D), DFF);)
    PHASE(3, row_pass<0>(F, WSP(float, WS_DBUF), F.in[I_F1POST], 0.5f, F.in[I_MIXPRE], WSP(bf16, WS_HA));)
    PHASE(4,
        if (F.G == 256 && bx >= 224) convert_static<2>(F, 224);
        else { const int GG = (F.G == 256) ? 224 : F.G;
        pg8::Gemm g{WSP(bf16, WS_HA), WSP(bf16, WS_WIN), D, D, D, 0, 0}; pg8::StaticOrder S; S.init(T / 256, 33, 1, GG, bx);
        pg8::EpiWin E{WSP(bf16, WS_PB), WSP(float, WS_GATES)};
        pg8::gemm_phase<pg8::EpiWin, pg8::StaticOrder, true, true>(F.lds, g, S, E);
        if (F.G != 256) convert_static<2>(F, 0); })
    PHASE(5, p5_conv(F); p5_gates(F); p5_s5_local(F);)
    PHASE(6,
        pg8::Gemm g{WSP(bf16, WS_CV), WSP(bf16, WS_WQK), 2048, 512, 512, 512, (size_t)512 * 512}; pg8::StaticOrder S; S.init(32, 2, 4, F.G, bx);
        pg8::EpiQK E{WSP(bf16, WS_Q), WSP(bf16, WS_K)};
        pg8::gemm_phase<pg8::EpiQK, pg8::StaticOrder, true, true>(F.lds, g, S, E);)
    PHASE(7, p7_m1(F); p7_sample_qk(F); p7_s5_final(F);)
    PHASE(8,
        p8_m2(F); p8_m4(F);
        pg8::Gemm g{WSP(bf16, WS_G), WSP(bf16, WS_WGLU), 2048, 2048, 2048, 0, 0}; pg8::StaticOrder S; S.init(32, 8, 1, F.G, bx);
        pg8::EpiGLU E{WSP(bf16, WS_G), F.in[I_BGLU], WSP(bf16, WS_HA)};
        pg8::gemm_phase<pg8::EpiGLU, pg8::StaticOrder, true, true>(F.lds, g, S, E);
        if (F.vcu >= 64 && F.vcu < 128) {
            const int c = F.vcu - 64, pn = c & 7, ch = c >> 3;
            pg8::Gemm gt{WSP(bf16, WS_G) + (size_t)TP * 2048 + (size_t)ch * 256, WSP(bf16, WS_WGLU) + (size_t)ch * 256, 2048, 2048, 256, 0, 0};
            pg8::OneUnit S1{pn}; pg8::EpiF32 E1{WSP(float, WS_SLAB) + (size_t)ch * 256 * 2048, 2048};
            pg8::gemm_phase<pg8::EpiF32, pg8::OneUnit, true, true>(F.lds, gt, S1, E1); })
    PHASE(9, glu_tail_fixup(F); p9_m3(F);)
    PHASE(10,
        pg8::Gemm g{WSP(bf16, WS_HA), WSP(bf16, WS_WOUT), D, D, D, 0, 0}; pg8::StaticOrder S; S.init(32, D / 256, 1, F.G, bx);
        pg8::EpiBf16 E{WSP(bf16, WS_DBUF), D};
        pg8::gemm_phase<pg8::EpiBf16, pg8::StaticOrder, true, true>(F.lds, g, S, E);
        gemm_tail_splitk<64>(F, WSP(bf16, WS_HA), D, WSP(bf16, WS_WOUT), D);)
    if (IN(11)) { row_pass<1>(F, WSP(float, WS_DBUF), F.in[I_MIXPOST], 1.0f, F.in[I_F2PRE], WSP(bf16, WS_HQ)); } SEAM(11);
    PHASE(12,
        if (F.G == 256 && bx >= 240) convert_static<3>(F, 240);
        else { const int GG = (F.G == 256) ? 240 : F.G;
        pg8::Gemm g{WSP(bf16, WS_HQ), WSP(bf16, WS_W2GU), D / 2, D / 2, D / 2, 0, 0}; pg8::StaticOrder S; S.init(T / 256, 2 * DFF / 256, 1, GG, bx);
        pg8::EpiSwiGLU8 E{WSP(bf16, WS_HID), DFF, WSP(float, WS_SA), wscale(F, 2), wscale(F, 3)};
        pg8::gemm_phase<pg8::EpiSwiGLU8, pg8::StaticOrder, true, true, false, true>(F.lds, g, S, E);
        if (F.G != 256) convert_static<3>(F, 0); })
    PHASE(13, p13_quant(F);)
    PHASE(14,
        pg8::Gemm g{WSP(bf16, WS_HID8), WSP(bf16, WS_W2D), DFF / 2, DFF / 2, DFF / 2, 0, 0}; pg8::StaticOrder S; S.init(32, D / 256, 1, F.G, bx);
        pg8::EpiBf16S E{WSP(bf16, WS_DBUF), D, WSP(float, WS_SA2), wscale(F, 4)};
        pg8::gemm_phase<pg8::EpiBf16S, pg8::StaticOrder, true, true, false, true>(F.lds, g, S, E);
        gemm_tail_splitk<86, true>(F, WSP(bf16, WS_HID8), DFF / 2, WSP(bf16, WS_W2D), DFF / 2, WSP(float, WS_SA2), wscale(F, 4));)
    if (IN(15)) { row_pass<2>(F, WSP(float, WS_DBUF), F.in[I_F2POST], 0.5f, nullptr, nullptr); }
#undef PHASE
#undef IN
#undef SEAM
}

extern "C" void kernel_launch(void* const* d_in, const int* in_sizes, int n_in, void* d_out, int out_size, void* d_ws, size_t ws_size, hipStream_t stream) {
    static int grid = 0;
    if (grid == 0) {
        if (n_in != N_IN || out_size != (int)O_END || ws_size < WS_END) { fprintf(stderr, "kernel_launch: unexpected shapes (n_in %d, out %d, ws %zu, need %zu)\n", n_in, out_size, ws_size, (size_t)WS_END); grid = -1; return; }
        int dev = 0, cus = 0;
        if (hipGetDevice(&dev) != hipSuccess || hipDeviceGetAttribute(&cus, hipDeviceAttributeMultiprocessorCount, dev) != hipSuccess) { grid = -1; return; }
        if (hipFuncSetAttribute((const void*)fwd_kernel, hipFuncAttributeMaxDynamicSharedMemorySize, LDS_BYTES) != hipSuccess) { fprintf(stderr, "kernel_launch: hipFuncSetAttribute failed\n"); grid = -1; return; }
        int per_cu = 0; (void)hipOccupancyMaxActiveBlocksPerMultiprocessor(&per_cu, (const void*)fwd_kernel, NTHREADS, LDS_BYTES); (void)hipGetLastError();
        grid = cus;
    }
    if (grid < 0) return;
    (void)hipMemsetAsync((char*)d_ws + WS_CTL, 0, CTL_BYTES, stream);
    Args a{};
    for (int i = 0; i < N_IN; ++i) a.in[i] = (const float*)d_in[i];
    a.out = (float*)d_out; a.ws = (unsigned char*)d_ws;
#if MK_ONE_LAUNCH
    a.ph_lo = 0; a.ph_hi = N_PHASES;
    hipLaunchKernelGGL(fwd_kernel, dim3(grid), dim3(NTHREADS), LDS_BYTES, stream, a);
#else
    for (int p = 0; p < N_PHASES; ++p) { a.ph_lo = p; a.ph_hi = p + 1; hipLaunchKernelGGL(fwd_kernel, dim3(grid), dim3(NTHREADS), LDS_BYTES, stream, a); }
#endif
}
```

```cpp
#include <hip/hip_runtime.h>
#include <cstdio>
#include <cstdint>
#include <type_traits>

#define MK_ONE_LAUNCH 1
#ifndef PROBE_MASK
#define PROBE_MASK 0
#endif

#define GAS __attribute__((address_space(1)))
#define LAS __attribute__((address_space(3)))
#define CAS __attribute__((address_space(4)))
typedef unsigned short bf16;
typedef short bf16x8 __attribute__((ext_vector_type(8)));
typedef short s16x4 __attribute__((ext_vector_type(4)));
typedef float f32x4 __attribute__((ext_vector_type(4)));
typedef float f32x2 __attribute__((ext_vector_type(2)));
typedef unsigned u32x4 __attribute__((ext_vector_type(4)));
typedef unsigned u32x2 __attribute__((ext_vector_type(2)));
typedef int i32x4 __attribute__((ext_vector_type(4)));

constexpr int D = 4096, TP = 8192, T = 8448, DFF = 11008, DM = 2048, NH = 4, DV = 512, DQK = 256;
constexpr int NG = 128, NP = 64, NJ = 16;
constexpr int NSU = 48;
constexpr float EPS = 1e-6f;
constexpr int NWAVES = 8, NTHREADS = 512;

__host__ __device__ __forceinline__ int su_row0(int su) { return su < 32 ? su * 256 : TP + (su - 32) * 16; }
__host__ __device__ __forceinline__ int su_len(int su) { return su < 32 ? 256 : 16; }

constexpr size_t O_Y = 0, O_CP = 34603008, O_NP = O_CP + 524288, O_MP = O_NP + 1024, O_CONVP = O_MP + 4, O_S5REP = O_CONVP + 6144, O_S5IMP = O_S5REP + 8192,
                 O_CS = O_S5IMP + 8192, O_NS = O_CS + 8388608, O_MS = O_NS + 16384, O_CONVS = O_MS + 64, O_S5RES = O_CONVS + 98304, O_S5IMS = O_S5RES + 131072, O_END = O_S5IMS + 131072;
static_assert(O_END == 43916356, "output size");

enum { I_XP = 0, I_XS, I_SC, I_SN, I_SM, I_CONV, I_S5RE, I_S5IM, I_F1PRE, I_F1POST, I_F1G, I_F1U, I_F1D, I_MIXPRE, I_WIN, I_CONVW, I_CONVB, I_WQ, I_WK, I_BI, I_BF, I_HN,
       I_ARE, I_AIM, I_LOGDT, I_BRE, I_BIM, I_CRE, I_CIM, I_S5D, I_WGLU, I_BGLU, I_WOUT, I_MIXPOST, I_F2PRE, I_F2POST, I_F2G, I_F2U, I_F2D, N_IN };
static_assert(N_IN == 39, "inputs");

constexpr size_t al256(size_t x) { return (x + 255) & ~(size_t)255; }
constexpr size_t WS_CTL = 0, CTL_BYTES = 1u << 20;
constexpr size_t WS_W1GU = WS_CTL + CTL_BYTES;
constexpr size_t SZ_WGU = (size_t)2 * DFF * D * 2, SZ_WD = (size_t)D * DFF * 2;
constexpr size_t WS_W1D = WS_W1GU + SZ_WGU;
constexpr size_t WS_W2GU = WS_W1D + SZ_WD;
constexpr size_t WS_W2D = WS_W2GU + SZ_WGU;
constexpr size_t WS_WIN = WS_W2D + SZ_WD;
constexpr size_t WS_WQK = WS_WIN + (size_t)8448 * D * 2;
constexpr size_t WS_WGLU = WS_WQK + (size_t)4 * 512 * 512 * 2;
constexpr size_t WS_WOUT = WS_WGLU + (size_t)2048 * 2048 * 2;
constexpr size_t WS_HA = WS_WOUT + (size_t)D * D * 2;
constexpr size_t WS_HID = WS_HA + (size_t)T * D * 2;
constexpr size_t WS_PB = WS_HID, WS_CV = WS_PB + (size_t)T * 8192 * 2;
constexpr size_t WS_DBUF = WS_HID + (size_t)T * DFF * 2;
static_assert(WS_CV + (size_t)T * 2048 * 2 <= WS_DBUF, "HID alias");
constexpr size_t WS_KV = WS_DBUF, WS_C0 = WS_KV + (size_t)128 * 131072 * 4;
constexpr size_t WS_Q = WS_DBUF + (size_t)T * D * 4;
static_assert(WS_C0 + (size_t)192 * 131072 * 2 <= WS_Q, "DBUF alias");
constexpr size_t WS_K = WS_Q + (size_t)T * 1024 * 2;
constexpr size_t WS_G = WS_K + (size_t)T * 1024 * 2;
constexpr size_t WS_GATES = WS_G + (size_t)T * 2048 * 2;
constexpr size_t WS_BARR = al256(WS_GATES + (size_t)T * 8 * 4);
constexpr size_t WS_AARR = WS_BARR + (size_t)4 * T * 4;
constexpr size_t WS_MRUN = WS_AARR + (size_t)4 * T * 4;
constexpr size_t WS_SUA = WS_MRUN + (size_t)4 * T * 4;
constexpr size_t WS_SUB = WS_SUA + 1024;
constexpr size_t WS_NK = WS_SUB + 1024;
constexpr size_t WS_N0 = WS_NK + (size_t)128 * 256 * 4;
constexpr size_t WS_M0 = WS_N0 + (size_t)192 * 256 * 4;
constexpr size_t WS_S5AB = WS_M0 + 1024;
constexpr size_t WS_S5BB = WS_S5AB + (size_t)2 * 8192 * 4;
constexpr size_t WS_S5LOC = WS_S5BB + (size_t)2 * 131072 * 4;
constexpr size_t WS_S5HIN = WS_S5LOC + (size_t)2 * 32 * 8192 * 4;
constexpr size_t WS_SLAB = al256(WS_S5HIN + (size_t)2 * 32 * 8192 * 4);
constexpr size_t WS_XR = WS_SLAB + (size_t)16 * 256 * D * 4;
constexpr size_t WS_SA = WS_XR + (size_t)T * D * 2;
constexpr size_t WS_WSTAT = al256(WS_SA + (size_t)T * 256);
constexpr size_t WS_HQ = al256(WS_WSTAT + 4 * 256 * 4);
constexpr size_t WS_SA2 = al256(WS_HQ + (size_t)T * D);
constexpr size_t WS_END = WS_SA2 + (size_t)T * 256;
constexpr size_t WS_HID8 = WS_W1GU;
static_assert((size_t)T * DFF <= SZ_WGU, "HID8 alias");

constexpr int LDS_BYTES = 155648;
constexpr int LDS_MISC = 151552;

__device__ __forceinline__ float wave_sum(float v) {
#pragma unroll
    for (int o = 1; o < 64; o <<= 1) v += __shfl_xor(v, o);
    return v;
}
__device__ __forceinline__ float wave_max(float v) {
#pragma unroll
    for (int o = 1; o < 64; o <<= 1) v = fmaxf(v, __shfl_xor(v, o));
    return v;
}
__device__ __forceinline__ unsigned q8(float x) { return (unsigned)(int)fminf(fmaxf(rintf(x), -127.f), 127.f) & 0xffu; }
__device__ __forceinline__ unsigned q8x4(float a, float b, float c, float d) { return q8(a) | (q8(b) << 8) | (q8(c) << 16) | (q8(d) << 24); }
__device__ __forceinline__ unsigned cvt_pk_bf16(float lo, float hi) { unsigned r; asm volatile("v_cvt_pk_bf16_f32 %0, %1, %2" : "=v"(r) : "v"(lo), "v"(hi)); return r; }
__device__ __forceinline__ float bflo(unsigned w) { return __uint_as_float(w << 16); }
__device__ __forceinline__ float bfhi(unsigned w) { return __uint_as_float(w & 0xffff0000u); }
__device__ __forceinline__ float bf2f(bf16 v) { return __uint_as_float(((unsigned)v) << 16); }
__device__ __forceinline__ bf16 f2bf(float f) { return (bf16)(cvt_pk_bf16(f, 0.f) & 0xffffu); }
__device__ __forceinline__ float sigmoidf_(float x) { return __builtin_amdgcn_rcpf(1.0f + __builtin_amdgcn_exp2f(-1.4426950408889634f * x)); }
__device__ __forceinline__ float siluf_(float x) { return x * __builtin_amdgcn_rcpf(1.0f + __builtin_amdgcn_exp2f(-1.4426950408889634f * x)); }
__device__ __forceinline__ float gelu_tanh(float x) { const float u = -2.302208198f * (x + 0.044715f * x * x * x); return x * __builtin_amdgcn_rcpf(1.0f + __builtin_amdgcn_exp2f(u)); }
__device__ __forceinline__ float logsigmoidf_(float x) { return fminf(x, 0.f) - log1pf(__expf(-fabsf(x))); }

namespace pg8 {
typedef unsigned short bf16_t;
constexpr int BM = 256, BK = 64, HALF = 128, HTB = HALF * BK * 2, STAGE_BYTES = 8 * HTB, NXCD = 8, WGM = 8;
__host__ __device__ __forceinline__ int lds_byte(int r, int c) { const int st = (r >> 4) * 2 + (c >> 5), rr = r & 15, cc = c & 31, ob = rr * 64 + cc * 2; return st * 1024 + (ob ^ (((ob >> 9) & 1) << 5)); }
__host__ __device__ __forceinline__ void stage_rc(int b, int& R, int& C) { const int st = b / 1024, sb = b % 1024, swz = sb ^ (((sb >> 9) & 1) << 5); R = (st >> 1) * 16 + swz / 64; C = (st & 1) * 32 + (swz % 64) / 2; }
__host__ __device__ __forceinline__ int perm32(int rho) { const int n = rho >> 4, i = rho & 15; return 8 * (i >> 2) + 4 * n + (i & 3); }

struct Unit { int pm, pn, z; };
struct Gemm { const bf16_t* A; const bf16_t* Bt; int lda, ldb, K; size_t zA, zB; };

struct StaticOrder {
    int nM, nN, nZ, nwg, G, c;
    __host__ __device__ void init(int nM_, int nN_, int nZ_, int G_, int c_) { nM = nM_; nN = nN_; nZ = nZ_; nwg = nM * nN; G = G_; c = c_; }
    __host__ __device__ bool next(int i, Unit& u) const {
        const long L = (long)i * G + c; if (L >= (long)nwg * nZ) return false;
        u.z = (int)(L / nwg);
        int wgid = (int)(L % nwg); { const int q = nwg / NXCD, r = nwg % NXCD, xcd = wgid % NXCD, off = wgid / NXCD; wgid = (xcd < r ? xcd * (q + 1) : r * (q + 1) + (xcd - r) * q) + off; }
        const int nig = WGM * nN, gid = wgid / nig, fm = gid * WGM, gsz = (nM - fm) < WGM ? (nM - fm) : WGM;
        u.pm = fm + ((wgid % nig) % gsz); u.pn = (wgid % nig) / gsz; return true;
    }
    __device__ __forceinline__ void a_ready(const Unit&) const {}
    __device__ __forceinline__ void done(const Unit&) const {}
};

struct EpiF32 {
    static constexpr bool PERM = false;
    float* C; int ldc;
    __device__ __forceinline__ void operator()(const f32x4 (&acc)[2][2][4][2], const Unit& u, int wr, int wc, int fr, int fq) const {
        const int row0 = u.pm * BM + wr * 64 + fr, col0 = u.pn * BM + wc * 32 + 4 * fq;
#pragma unroll
        for (int ai = 0; ai < 2; ++ai)
#pragma unroll
            for (int m = 0; m < 4; ++m) { float* rowp = C + (size_t)(row0 + ai * HALF + m * 16) * ldc + col0;
#pragma unroll
                for (int bj = 0; bj < 2; ++bj)
#pragma unroll
                    for (int n = 0; n < 2; ++n) *(f32x4*)(rowp + bj * HALF + n * 16) = acc[ai][bj][m][n]; }
    }
};
struct EpiBf16 {
    static constexpr bool PERM = true;
    bf16_t* O; int ldc;
    __device__ __forceinline__ void operator()(const f32x4 (&acc)[2][2][4][2], const Unit& u, int wr, int wc, int fr, int fq) const {
        const int row0 = u.pm * BM + wr * 64 + fr, col0 = u.pn * BM + wc * 32 + 8 * fq;
#pragma unroll
        for (int ai = 0; ai < 2; ++ai)
#pragma unroll
            for (int m = 0; m < 4; ++m) { bf16_t* rowp = O + (size_t)(row0 + ai * HALF + m * 16) * ldc + col0;
#pragma unroll
                for (int bj = 0; bj < 2; ++bj) { const f32x4 v0 = acc[ai][bj][m][0], v1 = acc[ai][bj][m][1];
                    u32x4 w; w.x = cvt_pk_bf16(v0[0], v0[1]); w.y = cvt_pk_bf16(v0[2], v0[3]); w.z = cvt_pk_bf16(v1[0], v1[1]); w.w = cvt_pk_bf16(v1[2], v1[3]);
                    *(u32x4*)(rowp + bj * HALF) = w; } }
    }
};
struct EpiBf16S {
    static constexpr bool PERM = true;
    bf16_t* O; int ldc; const float* sa; float sw;
    __device__ __forceinline__ void operator()(const i32x4 (&acc)[2][2][4][2], const Unit& u, int wr, int wc, int fr, int fq) const {
        const int row0 = u.pm * BM + wr * 64 + fr, col0 = u.pn * BM + wc * 32 + 8 * fq;
        float s8[2][4];
#pragma unroll
        for (int ai = 0; ai < 2; ++ai)
#pragma unroll
            for (int m = 0; m < 4; ++m) s8[ai][m] = sa[(size_t)(row0 + ai * HALF + m * 16) * 64] * sw;
#pragma unroll
        for (int ai = 0; ai < 2; ++ai)
#pragma unroll
            for (int m = 0; m < 4; ++m) { bf16_t* rowp = O + (size_t)(row0 + ai * HALF + m * 16) * ldc + col0; const float s = s8[ai][m];
#pragma unroll
                for (int bj = 0; bj < 2; ++bj) { const i32x4 v0 = acc[ai][bj][m][0], v1 = acc[ai][bj][m][1];
                    u32x4 w; w.x = cvt_pk_bf16((float)v0[0] * s, (float)v0[1] * s); w.y = cvt_pk_bf16((float)v0[2] * s, (float)v0[3] * s); w.z = cvt_pk_bf16((float)v1[0] * s, (float)v1[1] * s); w.w = cvt_pk_bf16((float)v1[2] * s, (float)v1[3] * s);
                    *(u32x4*)(rowp + bj * HALF) = w; } }
    }
};
struct EpiF32S {
    static constexpr bool PERM = false;
    float* C; int ldc; const float* sa; float sw;
    __device__ __forceinline__ void operator()(const i32x4 (&acc)[2][2][4][2], const Unit& u, int wr, int wc, int fr, int fq) const {
        const int row0 = u.pm * BM + wr * 64 + fr, col0 = u.pn * BM + wc * 32 + 4 * fq;
        float s8[2][4];
#pragma unroll
        for (int ai = 0; ai < 2; ++ai)
#pragma unroll
            for (int m = 0; m < 4; ++m) s8[ai][m] = sa[(size_t)(row0 + ai * HALF + m * 16) * 64] * sw;
#pragma unroll
        for (int ai = 0; ai < 2; ++ai)
#pragma unroll
            for (int m = 0; m < 4; ++m) { float* rowp = C + (size_t)(row0 + ai * HALF + m * 16) * ldc + col0; const float s = s8[ai][m];
#pragma unroll
                for (int bj = 0; bj < 2; ++bj)
#pragma unroll
                    for (int n = 0; n < 2; ++n) { const i32x4 v = acc[ai][bj][m][n]; *(f32x4*)(rowp + bj * HALF + n * 16) = (f32x4){(float)v[0] * s, (float)v[1] * s, (float)v[2] * s, (float)v[3] * s}; } }
    }
};
struct OneUnit {
    int pn;
    __device__ __forceinline__ bool next(int i, Unit& u) const { if (i) return false; u.pm = 0; u.pn = pn; u.z = 0; return true; }
    __device__ __forceinline__ void a_ready(const Unit&) const {}
    __device__ __forceinline__ void done(const Unit&) const {}
};
struct EpiF32Atomic {
    static constexpr bool PERM = false;
    float* C; int ldc;
    __device__ __forceinline__ void operator()(const f32x4 (&acc)[2][2][4][2], const Unit& u, int wr, int wc, int fr, int fq) const {
        const int row0 = u.pm * BM + wr * 64 + fr, col0 = u.pn * BM + wc * 32 + 4 * fq;
#pragma unroll
        for (int ai = 0; ai < 2; ++ai)
#pragma unroll
            for (int m = 0; m < 4; ++m) { float* rowp = C + (size_t)(row0 + ai * HALF + m * 16) * ldc + col0;
#pragma unroll
                for (int bj = 0; bj < 2; ++bj)
#pragma unroll
                    for (int n = 0; n < 2; ++n) { float* p = rowp + bj * HALF + n * 16; const f32x4 v = acc[ai][bj][m][n];
                        unsafeAtomicAdd(p, v[0]); unsafeAtomicAdd(p + 1, v[1]); unsafeAtomicAdd(p + 2, v[2]); unsafeAtomicAdd(p + 3, v[3]); } }
    }
};
struct EpiSwiGLU {
    static constexpr bool PERM = true;
    bf16_t* O; int ldc;
    __device__ __forceinline__ void operator()(const f32x4 (&acc)[2][2][4][2], const Unit& u, int wr, int wc, int fr, int fq) const {
        const int row0 = u.pm * BM + wr * 64 + fr, col0 = u.pn * HALF + wc * 32 + 8 * fq;
#pragma unroll
        for (int ai = 0; ai < 2; ++ai)
#pragma unroll
            for (int m = 0; m < 4; ++m) { bf16_t* rowp = O + (size_t)(row0 + ai * HALF + m * 16) * ldc + col0;
                const f32x4 g0 = acc[ai][0][m][0], g1 = acc[ai][0][m][1], u0 = acc[ai][1][m][0], u1 = acc[ai][1][m][1];
                float h[8];
#pragma unroll
                for (int j = 0; j < 4; ++j) { h[j] = siluf_(g0[j]) * u0[j]; h[4 + j] = siluf_(g1[j]) * u1[j]; }
                u32x4 w; w.x = cvt_pk_bf16(h[0], h[1]); w.y = cvt_pk_bf16(h[2], h[3]); w.z = cvt_pk_bf16(h[4], h[5]); w.w = cvt_pk_bf16(h[6], h[7]);
                *(u32x4*)rowp = w; }
    }
};
struct EpiSwiGLU8 {
    static constexpr bool PERM = true;
    bf16_t* O; int ldc; const float* sa; float swg, swu;
    __device__ __forceinline__ void operator()(const i32x4 (&acc)[2][2][4][2], const Unit& u, int wr, int wc, int fr, int fq) const {
        const int row0 = u.pm * BM + wr * 64 + fr, col0 = u.pn * HALF + wc * 32 + 8 * fq;
        float s8[2][4];
#pragma unroll
        for (int ai = 0; ai < 2; ++ai)
#pragma unroll
            for (int m = 0; m < 4; ++m) s8[ai][m] = sa[(size_t)(row0 + ai * HALF + m * 16) * 64];
#pragma unroll
        for (int ai = 0; ai < 2; ++ai)
#pragma unroll
            for (int m = 0; m < 4; ++m) { const int row = row0 + ai * HALF + m * 16; bf16_t* rowp = O + (size_t)row * ldc + col0;
                const float s = s8[ai][m], sg = s * swg, su = s * swu;
                const i32x4 g0 = acc[ai][0][m][0], g1 = acc[ai][0][m][1], u0 = acc[ai][1][m][0], u1 = acc[ai][1][m][1];
                float h[8];
#pragma unroll
                for (int j = 0; j < 4; ++j) { h[j] = siluf_((float)g0[j] * sg) * ((float)u0[j] * su); h[4 + j] = siluf_((float)g1[j] * sg) * ((float)u1[j] * su); }
                u32x4 w; w.x = cvt_pk_bf16(h[0], h[1]); w.y = cvt_pk_bf16(h[2], h[3]); w.z = cvt_pk_bf16(h[4], h[5]); w.w = cvt_pk_bf16(h[6], h[7]);
                *(u32x4*)rowp = w; }
    }
};
struct EpiWin {
    static constexpr bool PERM = true;
    bf16_t* PB; float* GATES;
    __device__ __forceinline__ void operator()(const f32x4 (&acc)[2][2][4][2], const Unit& u, int wr, int wc, int fr, int fq) const {
        const int row0 = u.pm * BM + wr * 64 + fr;
        if (u.pn < 32) {
            const int col0 = u.pn * BM + wc * 32 + 8 * fq;
#pragma unroll
            for (int ai = 0; ai < 2; ++ai)
#pragma unroll
                for (int m = 0; m < 4; ++m) { bf16_t* rowp = PB + (size_t)(row0 + ai * HALF + m * 16) * 8192 + col0;
#pragma unroll
                    for (int bj = 0; bj < 2; ++bj) { const f32x4 v0 = acc[ai][bj][m][0], v1 = acc[ai][bj][m][1];
                        u32x4 w; w.x = cvt_pk_bf16(v0[0], v0[1]); w.y = cvt_pk_bf16(v0[2], v0[3]); w.z = cvt_pk_bf16(v1[0], v1[1]); w.w = cvt_pk_bf16(v1[2], v1[3]);
                        *(u32x4*)(rowp + bj * HALF) = w; } }
        } else if (wc == 0 && fq == 0) {
#pragma unroll
            for (int ai = 0; ai < 2; ++ai)
#pragma unroll
                for (int m = 0; m < 4; ++m) { float* gp = GATES + (size_t)(row0 + ai * HALF + m * 16) * 8;
                    *(f32x4*)gp = acc[ai][0][m][0]; *(f32x4*)(gp + 4) = acc[ai][0][m][1]; }
        }
    }
};
struct EpiQK {
    static constexpr bool PERM = true;
    bf16_t* Q; bf16_t* Kd;
    __device__ __forceinline__ void operator()(const f32x4 (&acc)[2][2][4][2], const Unit& u, int wr, int wc, int fr, int fq) const {
        const int row0 = u.pm * BM + wr * 64 + fr, col0 = u.z * 256 + wc * 32 + 8 * fq; bf16_t* base = u.pn ? Kd : Q;
#pragma unroll
        for (int ai = 0; ai < 2; ++ai)
#pragma unroll
            for (int m = 0; m < 4; ++m) { bf16_t* rowp = base + (size_t)(row0 + ai * HALF + m * 16) * 1024 + col0;
#pragma unroll
                for (int bj = 0; bj < 2; ++bj) { const f32x4 v0 = acc[ai][bj][m][0], v1 = acc[ai][bj][m][1];
                    u32x4 w; w.x = cvt_pk_bf16(v0[0], v0[1]); w.y = cvt_pk_bf16(v0[2], v0[3]); w.z = cvt_pk_bf16(v1[0], v1[1]); w.w = cvt_pk_bf16(v1[2], v1[3]);
                    *(u32x4*)(rowp + bj * HALF) = w; } }
    }
};
struct EpiGLU {
    static constexpr bool PERM = true;
    const bf16_t* Gb; const float* bias; bf16_t* MIX;
    __device__ __forceinline__ void operator()(const f32x4 (&acc)[2][2][4][2], const Unit& u, int wr, int wc, int fr, int fq) const {
        const int row0 = u.pm * BM + wr * 64 + fr, col0 = u.pn * BM + wc * 32 + 8 * fq;
        f32x4 bv[2][2];
#pragma unroll
        for (int bj = 0; bj < 2; ++bj)
#pragma unroll
            for (int n = 0; n < 2; ++n) bv[bj][n] = *(const f32x4*)(bias + col0 + bj * HALF + 4 * n);
#pragma unroll
        for (int ai = 0; ai < 2; ++ai) {
            u32x4 gws[4][2];
#pragma unroll
            for (int m = 0; m < 4; ++m)
#pragma unroll
                for (int bj = 0; bj < 2; ++bj) gws[m][bj] = *(const u32x4*)(Gb + (size_t)(row0 + ai * HALF + m * 16) * 2048 + col0 + bj * HALF);
#pragma unroll
            for (int m = 0; m < 4; ++m) { const size_t row = (size_t)(row0 + ai * HALF + m * 16);
#pragma unroll
                for (int bj = 0; bj < 2; ++bj) { const f32x4 v0 = acc[ai][bj][m][0] + bv[bj][0], v1 = acc[ai][bj][m][1] + bv[bj][1];
                    const u32x4 gw = gws[m][bj];
                    float o[8];
                    o[0] = bflo(gw.x) * sigmoidf_(v0[0]); o[1] = bfhi(gw.x) * sigmoidf_(v0[1]); o[2] = bflo(gw.y) * sigmoidf_(v0[2]); o[3] = bfhi(gw.y) * sigmoidf_(v0[3]);
                    o[4] = bflo(gw.z) * sigmoidf_(v1[0]); o[5] = bfhi(gw.z) * sigmoidf_(v1[1]); o[6] = bflo(gw.w) * sigmoidf_(v1[2]); o[7] = bfhi(gw.w) * sigmoidf_(v1[3]);
                    u32x4 w; w.x = cvt_pk_bf16(o[0], o[1]); w.y = cvt_pk_bf16(o[2], o[3]); w.z = cvt_pk_bf16(o[4], o[5]); w.w = cvt_pk_bf16(o[6], o[7]);
                    *(u32x4*)(MIX + row * 4096 + 2048 + col0 + bj * HALF) = w; } } }
    }
};

template <class Epi, class Sched, bool ALIGN_EPI = false, bool SP2 = false, bool PFB = false, bool I8 = false>
__device__ __forceinline__ void gemm_phase(LAS unsigned char* lds, const Gemm g, const Sched& S, const Epi& E) {
    int tid = threadIdx.x; asm volatile("" : "+v"(tid));
    const int wid = __builtin_amdgcn_readfirstlane(tid >> 6), lane = tid & 63, wr = wid >> 2, wc = wid & 3, fr = lane & 15, fq = lane >> 4;
    const int K = g.K, nt = K / BK;
    unsigned voffA[2], voffB[2];
#pragma unroll
    for (int i = 0; i < 2; ++i) { int R, C; stage_rc(tid * 16 + i * 8192, R, C); const int Rb = Epi::PERM ? ((R & ~31) + perm32(R & 31)) : R;
        voffA[i] = (unsigned)(R * g.lda + C) * 2u; voffB[i] = (unsigned)(Rb * g.ldb + C) * 2u; }
    const size_t kstep = (size_t)(BK * 2);
    const size_t hstepA = (size_t)HALF * g.lda * 2, hstepB = (size_t)HALF * g.ldb * 2;
    const unsigned ldsw = (unsigned)wid * 1024u;
    const int aoff = lds_byte(wr * 64 + fr, fq * 8), boff = lds_byte(wc * 32 + fr, fq * 8);
#define PG8_SA(b, h) (((b) * 2 + (h)) * HTB)
#define PG8_SB(b, h) ((4 + (b) * 2 + (h)) * HTB)
#define PG8_STAGE(bufoff, gbase, voff) do { _Pragma("unroll") for (int _i = 0; _i < 2; ++_i) \
        __builtin_amdgcn_global_load_lds((const unsigned*)((const char*)(gbase) + (voff)[_i]), (LAS unsigned*)(lds + (bufoff) + ldsw + _i * 8192), 16, 0, 0); } while (0)
#define PG8_LDA(dst, b, h) do { _Pragma("unroll") for (int m = 0; m < 4; ++m) _Pragma("unroll") for (int k = 0; k < 2; ++k) dst[m][k] = *(const LAS bf16x8*)(lds + PG8_SA(b, h) + aoff + m * 2048 + k * 1024); } while (0)
#define PG8_LDB(dst, b, h) do { _Pragma("unroll") for (int n = 0; n < 2; ++n) _Pragma("unroll") for (int k = 0; k < 2; ++k) dst[n][k] = *(const LAS bf16x8*)(lds + PG8_SB(b, h) + boff + n * 2048 + k * 1024); } while (0)
#define PG8_MMA(ai, bj, At, Bt) do { __builtin_amdgcn_s_setprio(1); _Pragma("unroll") for (int m = 0; m < 4; ++m) _Pragma("unroll") for (int n = 0; n < 2; ++n) _Pragma("unroll") for (int k = 0; k < 2; ++k) { \
        if constexpr (I8) acc[ai][bj][m][n] = __builtin_bit_cast(AccT, __builtin_amdgcn_mfma_i32_16x16x64_i8(__builtin_bit_cast(i32x4, Bt[n][k]), __builtin_bit_cast(i32x4, At[m][k]), __builtin_bit_cast(i32x4, acc[ai][bj][m][n]), 0, 0, 0)); \
        else acc[ai][bj][m][n] = __builtin_bit_cast(AccT, __builtin_amdgcn_mfma_f32_16x16x32_bf16(Bt[n][k], At[m][k], __builtin_bit_cast(f32x4, acc[ai][bj][m][n]), 0, 0, 0)); } __builtin_amdgcn_s_setprio(0); } while (0)
#define PG8_WAIT_V(n) asm volatile("s_waitcnt vmcnt(" #n ")" ::: "memory")
#define PG8_WAIT_L(n) asm volatile("s_waitcnt lgkmcnt(" #n ")" ::: "memory")
#define PG8_BAR __builtin_amdgcn_s_barrier()
#define PG8_SCHED __builtin_amdgcn_sched_barrier(0)
    Unit cur, nxt; int ui = 0;
    if (!S.next(0, cur)) return;
    typedef typename std::conditional<I8, i32x4, f32x4>::type AccT;
    AccT acc[2][2][4][2];
#pragma unroll
    for (int a = 0; a < 2; ++a)
#pragma unroll
        for (int b = 0; b < 2; ++b)
#pragma unroll
            for (int m = 0; m < 4; ++m)
#pragma unroll
                for (int n = 0; n < 2; ++n) acc[a][b][m][n] = AccT{};
    bf16x8 At[4][2], B0[2][2], B1[2][2];
    const char* cA = (const char*)(g.A + (size_t)cur.pm * BM * g.lda + (size_t)cur.z * g.zA);
    const char* cB = (const char*)(g.Bt + (size_t)cur.pn * BM * g.ldb + (size_t)cur.z * g.zB);
    S.a_ready(cur);
    if constexpr (SP2) {
        PG8_STAGE(PG8_SB(0, 0), cB, voffB); PG8_STAGE(PG8_SB(0, 1), cB + hstepB, voffB); PG8_STAGE(PG8_SA(0, 0), cA, voffA); PG8_STAGE(PG8_SA(0, 1), cA + hstepA, voffA);
        if (wr == 1) PG8_BAR;
        PG8_WAIT_V(2); PG8_BAR;
        PG8_STAGE(PG8_SB(1, 0), cB + kstep, voffB); PG8_STAGE(PG8_SA(1, 0), cA + kstep, voffA); PG8_STAGE(PG8_SB(1, 1), cB + hstepB + kstep, voffB);
        PG8_WAIT_V(6); PG8_BAR;
    } else {
        PG8_STAGE(PG8_SB(0, 0), cB, voffB); PG8_STAGE(PG8_SA(0, 0), cA, voffA); PG8_STAGE(PG8_SB(0, 1), cB + hstepB, voffB); PG8_STAGE(PG8_SA(0, 1), cA + hstepA, voffA);
        if (wr == 1) PG8_BAR;
        PG8_WAIT_V(4); PG8_BAR;
        PG8_STAGE(PG8_SB(1, 0), cB + kstep, voffB); PG8_STAGE(PG8_SA(1, 0), cA + kstep, voffA); PG8_STAGE(PG8_SB(1, 1), cB + hstepB + kstep, voffB);
        PG8_WAIT_V(6); PG8_BAR;
    }
    for (;;) {
        const bool has_next = S.next(ui + 1, nxt);
        const char* nA = has_next ? (const char*)(g.A + (size_t)nxt.pm * BM * g.lda + (size_t)nxt.z * g.zA) : cA;
        const char* nB = has_next ? (const char*)(g.Bt + (size_t)nxt.pn * BM * g.ldb + (size_t)nxt.z * g.zB) : cB;
        for (int t = 0; t < nt; t += 2) {
            const bool last = (t == nt - 2);
            const char* a1 = cA + (size_t)(t + 1) * kstep;
            const char* a2 = last ? nA : cA + (size_t)(t + 2) * kstep; const char* b2 = last ? nB : cB + (size_t)(t + 2) * kstep;
            const char* a3 = a2 + kstep; const char* b3 = b2 + kstep;
            if (last && has_next) S.a_ready(nxt);
            if constexpr (SP2) {
            PG8_LDB(B0, 0, 0); PG8_LDB(B1, 0, 1); PG8_SCHED; PG8_LDA(At, 0, 0); PG8_STAGE(PG8_SA(1, 1), a1 + hstepA, voffA);
            PG8_WAIT_V(8); PG8_WAIT_L(0); PG8_BAR; PG8_MMA(0, 0, At, B0); PG8_MMA(0, 1, At, B1); PG8_BAR; PG8_SCHED;
            PG8_LDA(At, 0, 1); PG8_STAGE(PG8_SB(0, 0), b2, voffB); PG8_STAGE(PG8_SB(0, 1), b2 + hstepB, voffB); PG8_STAGE(PG8_SA(0, 0), a2, voffA);
            PG8_WAIT_V(8); PG8_WAIT_L(0); PG8_BAR; PG8_MMA(1, 0, At, B0); PG8_MMA(1, 1, At, B1); PG8_BAR; PG8_SCHED;
            PG8_LDB(B0, 1, 0); PG8_LDB(B1, 1, 1); PG8_SCHED; PG8_LDA(At, 1, 0); PG8_STAGE(PG8_SA(0, 1), a2 + hstepA, voffA);
            PG8_WAIT_V(8); PG8_WAIT_L(0); PG8_BAR; PG8_MMA(0, 0, At, B0); PG8_MMA(0, 1, At, B1); PG8_BAR; PG8_SCHED;
            PG8_LDA(At, 1, 1); PG8_STAGE(PG8_SB(1, 0), b3, voffB); PG8_STAGE(PG8_SB(1, 1), b3 + hstepB, voffB); PG8_STAGE(PG8_SA(1, 0), a3, voffA);
            PG8_WAIT_V(8); PG8_WAIT_L(0); PG8_BAR; PG8_MMA(1, 0, At, B0); PG8_MMA(1, 1, At, B1); PG8_BAR; PG8_SCHED;
            } else {
            PG8_LDB(B0, 0, 0); PG8_SCHED; PG8_LDA(At, 0, 0); PG8_STAGE(PG8_SA(1, 1), a1 + hstepA, voffA);
            PG8_WAIT_L(8); PG8_BAR; PG8_WAIT_L(0); PG8_MMA(0, 0, At, B0); PG8_BAR; PG8_SCHED;
            PG8_LDB(B1, 0, 1); PG8_STAGE(PG8_SB(0, 0), b2, voffB);
            PG8_BAR; PG8_WAIT_L(0); PG8_MMA(0, 1, At, B1); PG8_BAR;
            PG8_LDA(At, 0, 1); PG8_STAGE(PG8_SA(0, 0), a2, voffA);
            PG8_BAR; PG8_WAIT_L(0); PG8_MMA(1, 0, At, B0); PG8_BAR; PG8_SCHED;
            PG8_STAGE(PG8_SB(0, 1), b2 + hstepB, voffB);
            PG8_WAIT_V(6); PG8_BAR; PG8_MMA(1, 1, At, B1); PG8_BAR;
            PG8_LDB(B0, 1, 0); PG8_SCHED; PG8_LDA(At, 1, 0); PG8_STAGE(PG8_SA(0, 1), a2 + hstepA, voffA);
            PG8_WAIT_L(8); PG8_BAR; PG8_WAIT_L(0); PG8_MMA(0, 0, At, B0); PG8_BAR; PG8_SCHED;
            PG8_LDB(B1, 1, 1); PG8_STAGE(PG8_SB(1, 0), b3, voffB);
            PG8_BAR; PG8_WAIT_L(0); PG8_MMA(0, 1, At, B1); PG8_BAR;
            PG8_LDA(At, 1, 1); PG8_STAGE(PG8_SA(1, 0), a3, voffA);
            PG8_BAR; PG8_WAIT_L(0); PG8_MMA(1, 0, At, B0); PG8_BAR; PG8_SCHED;
            PG8_STAGE(PG8_SB(1, 1), b3 + hstepB, voffB);
            PG8_WAIT_V(6); PG8_BAR; PG8_MMA(1, 1, At, B1); PG8_BAR;
            }
        }
        if constexpr (ALIGN_EPI) { if (wr == 0) PG8_BAR; }
        E(acc, cur, wr, wc, fr, fq); S.done(cur);
        if (!has_next) break;
        if constexpr (PFB) {
            const char* pb = nB + (size_t)((nxt.pm & 7) * 32 + wid * 4) * g.ldb * 2 + lane * 128;
#pragma unroll
            for (int r = 0; r < 4; ++r) __builtin_amdgcn_global_load_lds((const unsigned*)(pb + (size_t)r * g.ldb * 2), (LAS unsigned*)(lds + STAGE_BYTES + wid * 256), 4, 0, 0);
        }
#pragma unroll
        for (int a = 0; a < 2; ++a)
#pragma unroll
            for (int b = 0; b < 2; ++b)
#pragma unroll
                for (int m = 0; m < 4; ++m)
#pragma unroll
                    for (int n = 0; n < 2; ++n) acc[a][b][m][n] = AccT{};
        cur = nxt; cA = nA; cB = nB; ++ui;
        if constexpr (ALIGN_EPI) { if (wr == 1) PG8_BAR; }
    }
    PG8_WAIT_V(0);
    if constexpr (!ALIGN_EPI) { if (wr == 0) PG8_BAR; }
    PG8_BAR;
#undef PG8_SA
#undef PG8_SB
#undef PG8_STAGE
#undef PG8_LDA
#undef PG8_LDB
#undef PG8_MMA
#undef PG8_WAIT_V
#undef PG8_WAIT_L
#undef PG8_BAR
#undef PG8_SCHED
}
}

#define XB_TMO      128
#define XB_XCNT(j)  (256  + 64 * (j))
#define XB_XSUB(j)  (1280 + 64 * (j))
#define XB_XGEN(j)  (2304 + 64 * (j))
#define XB_TOP      3328
#define XB_TOPGEN   3392
#define XCD_BAR_WORDS 3456
#define XB_SPIN_CAP (1u << 18)
__device__ __forceinline__ unsigned xb_ld(unsigned* p)              { return __hip_atomic_load(p, __ATOMIC_RELAXED, __HIP_MEMORY_SCOPE_AGENT); }
__device__ __forceinline__ unsigned xb_add(unsigned* p, unsigned v) { return __hip_atomic_fetch_add(p, v, __ATOMIC_RELAXED, __HIP_MEMORY_SCOPE_AGENT); }
__device__ __forceinline__ unsigned xb_xcc_id() { return (unsigned)__builtin_amdgcn_s_getreg((3 << 11) | 20) & 0xFu; }
#define XB_SPIN(cond, bar) do { unsigned _sp = 0; while (cond) { __builtin_amdgcn_s_sleep(1); \
    if ((++_sp & 255u) == 0u) { if (xb_ld(&(bar)[XB_TMO])) break; if (_sp > XB_SPIN_CAP) { atomicAdd(&(bar)[XB_TMO], 1u); break; } } } } while (0)
struct XcdBarrier { unsigned* bar; unsigned x; volatile LAS unsigned* st; };
__device__ __forceinline__ XcdBarrier xcd_barrier_post(unsigned* bar, volatile LAS unsigned* st) {
    XcdBarrier b; b.bar = bar; b.x = xb_xcc_id(); b.st = st;
    if (threadIdx.x == 0) (void)xb_add(&bar[XB_XCNT(b.x)], 1u);
    return b;
}
__device__ __forceinline__ void xcd_barrier_complete(unsigned* bar, unsigned x, unsigned& nloc, unsigned& nx) {
    const unsigned G = gridDim.x * gridDim.y * gridDim.z;
    unsigned sum, cnt, mine, sp = 0u;
    for (;;) {
        sum = 0u; cnt = 0u; mine = 0u;
#pragma unroll
        for (unsigned j = 0; j < 16; ++j) { const unsigned c = xb_ld(&bar[XB_XCNT(j)]); sum += c; cnt += (c > 0u) ? 1u : 0u; mine = (j == x) ? c : mine; }
        if (sum == G) break;
        __builtin_amdgcn_s_sleep(1);
        if ((++sp & 255u) == 0u) { if (xb_ld(&bar[XB_TMO])) break; if (sp > XB_SPIN_CAP) { atomicAdd(&bar[XB_TMO], 1u); break; } }
    }
    nloc = mine > 0u ? mine : 1u; nx = cnt > 0u ? cnt : 1u;
}
__device__ __forceinline__ void xcd_barrier(const XcdBarrier& b) {
    asm volatile("s_waitcnt vmcnt(0)" ::: "memory");
    __syncthreads();
    if (threadIdx.x == 0) {
        unsigned* bar = b.bar;
        __builtin_amdgcn_s_waitcnt(0);
        unsigned nloc = b.st[0], nx = b.st[1];
        if (nloc == 0u) { xcd_barrier_complete(bar, b.x, nloc, nx); b.st[0] = nloc; b.st[1] = nx; }
        const unsigned old = xb_add(&bar[XB_XSUB(b.x)], 1u);
        const unsigned gen = old / nloc;
        if (old + 1u == (gen + 1u) * nloc) {
            __builtin_amdgcn_fence(__ATOMIC_RELEASE, "agent");
            asm volatile("s_waitcnt vmcnt(0)" ::: "memory");
            const unsigned og = xb_add(&bar[XB_TOP], 1u);
            const unsigned tg = og / nx;
            if (og + 1u == (tg + 1u) * nx) xb_add(&bar[XB_TOPGEN], 1u);
            else XB_SPIN(xb_ld(&bar[XB_TOPGEN]) == tg, bar);
            __builtin_amdgcn_fence(__ATOMIC_ACQUIRE, "agent");
            xb_add(&bar[XB_XGEN(b.x)], 1u);
            asm volatile("s_waitcnt vmcnt(0)" ::: "memory");
        } else {
            XB_SPIN(xb_ld(&bar[XB_XGEN(b.x)]) == gen, bar);
            __builtin_amdgcn_fence(__ATOMIC_ACQUIRE, "agent");
            asm volatile("s_waitcnt vmcnt(0)" ::: "memory");
        }
    }
    __syncthreads();
}

struct Args { const float* in[N_IN]; float* out; unsigned char* ws; int ph_lo, ph_hi; };
static_assert(sizeof(Args) == (N_IN + 2) * 8 + 8, "Args has no padding holes");

struct Frame {
    LAS unsigned char* lds;
    int tid, lane, wave, G, vcu, pp;
    const float* const* in; float* out; unsigned char* ws;
};
#define WSP(type, off) ((type*)(F.ws + (off)))

constexpr int SCR_STRIDE = 16896;
struct CvtItem { const float* W; void* WT; int ldw, k0, n0, ldk, drow0, q8; float scale; };
__device__ __forceinline__ void cvt_load(const CvtItem& c, int lane, f32x4 (&v)[16]) {
    const int rr = c.q8 ? lane >> 3 : lane >> 4, cc = c.q8 ? lane & 7 : lane & 15;
    const float* src = c.W + (size_t)(c.k0 + rr) * c.ldw + c.n0 + 4 * cc; const size_t step = (size_t)(c.q8 ? 8 : 4) * c.ldw;
#pragma unroll
    for (int i = 0; i < 16; ++i) v[i] = __builtin_nontemporal_load((const f32x4*)(src + i * step));
}
__device__ __forceinline__ void cvt_finish(const CvtItem& c, int lane, const f32x4 (&v)[16], LAS float* scr) {
    const float scale = c.scale; const int cl = lane & 7;
    if (!c.q8) {
        { const int r4 = lane >> 4, c16 = lane & 15;
#pragma unroll
          for (int i = 0; i < 16; ++i) { LAS float* d = scr + (4 * i + r4) * 65 + 4 * c16; d[0] = v[i].x; d[1] = v[i].y; d[2] = v[i].z; d[3] = v[i].w; } }
        asm volatile("s_waitcnt lgkmcnt(0)" ::: "memory");
        bf16* WT = (bf16*)c.WT;
#pragma unroll
        for (int j = 0; j < 8; ++j) { const int n = (lane >> 3) + 8 * j; const LAS float* s = scr + (8 * cl) * 65 + n;
            u32x4 o; o.x = cvt_pk_bf16(s[0 * 65] * scale, s[1 * 65] * scale); o.y = cvt_pk_bf16(s[2 * 65] * scale, s[3 * 65] * scale);
            o.z = cvt_pk_bf16(s[4 * 65] * scale, s[5 * 65] * scale); o.w = cvt_pk_bf16(s[6 * 65] * scale, s[7 * 65] * scale);
            *(u32x4*)(WT + (size_t)(c.drow0 + n) * c.ldk + c.k0 + 8 * cl) = o; }
    } else {
        { const int r8 = lane >> 3, c8 = lane & 7;
#pragma unroll
          for (int i = 0; i < 16; ++i) { LAS float* d = scr + (8 * i + r8) * 33 + 4 * c8; d[0] = v[i].x; d[1] = v[i].y; d[2] = v[i].z; d[3] = v[i].w; } }
        asm volatile("s_waitcnt lgkmcnt(0)" ::: "memory");
        signed char* WT8 = (signed char*)c.WT;
#pragma unroll
        for (int j = 0; j < 4; ++j) { const int n = (lane >> 3) + 8 * j; const LAS float* s = scr + (16 * cl) * 33 + n;
            u32x4 o; o.x = q8x4(s[0 * 33] * scale, s[1 * 33] * scale, s[2 * 33] * scale, s[3 * 33] * scale); o.y = q8x4(s[4 * 33] * scale, s[5 * 33] * scale, s[6 * 33] * scale, s[7 * 33] * scale);
            o.z = q8x4(s[8 * 33] * scale, s[9 * 33] * scale, s[10 * 33] * scale, s[11 * 33] * scale); o.w = q8x4(s[12 * 33] * scale, s[13 * 33] * scale, s[14 * 33] * scale, s[15 * 33] * scale);
            *(u32x4*)(WT8 + (size_t)(c.drow0 + n) * c.ldk + c.k0 + 16 * cl) = o; }
    }
    asm volatile("s_waitcnt lgkmcnt(0)" ::: "memory");
}
__device__ __forceinline__ float wscale(Frame& F, int t) { return ((volatile LAS float*)(F.lds + LDS_MISC))[64 + t]; }
__device__ __forceinline__ void p0_stats(Frame& F) {
    LAS float* red = (LAS float*)F.lds;
    float s[3] = {0.f, 0.f, 0.f};
    for (int i = F.tid; i < DFF / 4; i += NTHREADS) {
        const f32x4 v0 = *(const f32x4*)(F.in[I_F2G] + (size_t)2048 * DFF + 4 * i), v1 = *(const f32x4*)(F.in[I_F2U] + (size_t)2048 * DFF + 4 * i), v2 = *(const f32x4*)(F.in[I_F2D] + (size_t)(4000 + 1000 * (i / 1024)) * D + 4 * (i % 1024));
        s[0] += (v0.x * v0.x + v0.y * v0.y) + (v0.z * v0.z + v0.w * v0.w); s[1] += (v1.x * v1.x + v1.y * v1.y) + (v1.z * v1.z + v1.w * v1.w); s[2] += (v2.x * v2.x + v2.y * v2.y) + (v2.z * v2.z + v2.w * v2.w); }
#pragma unroll
    for (int t = 0; t < 3; ++t) s[t] = wave_sum(s[t]);
    __syncthreads();
    if (F.lane == 0) { red[F.wave] = s[0]; red[8 + F.wave] = s[1]; red[16 + F.wave] = s[2]; }
    __syncthreads();
    if (F.tid < 3) { const LAS float* r = red + 8 * F.tid; const float tot = ((r[0] + r[1]) + (r[2] + r[3])) + ((r[4] + r[5]) + (r[6] + r[7]));
        ((volatile LAS float*)(F.lds + LDS_MISC))[66 + F.tid] = 6.0f * sqrtf(tot * (1.0f / DFF)) * (1.0f / 127.0f); }
    __syncthreads();
}
__device__ __forceinline__ void rms_row_to_i8(const float* xrow, const float* gain, signed char* qrow, float* sa, int lane) {
    const f32x4* xr = (const f32x4*)xrow + lane; const f32x4* gr = (const f32x4*)gain + lane;
    f32x4 v[16]; float s = 0.f;
#pragma unroll
    for (int j = 0; j < 16; ++j) { v[j] = xr[64 * j]; s += (v[j].x * v[j].x + v[j].y * v[j].y) + (v[j].z * v[j].z + v[j].w * v[j].w); }
    const float r = rsqrtf(wave_sum(s) * (1.f / D) + EPS); float am = 0.f;
#pragma unroll
    for (int j = 0; j < 16; ++j) { const f32x4 gg = gr[64 * j]; v[j] = v[j] * r * gg; am = fmaxf(fmaxf(am, fmaxf(fabsf(v[j].x), fabsf(v[j].y))), fmaxf(fabsf(v[j].z), fabsf(v[j].w))); }
    am = fmaxf(wave_max(am), 1e-20f); const float inv = 127.0f / am;
    unsigned* o4 = (unsigned*)qrow + lane;
#pragma unroll
    for (int j = 0; j < 16; ++j) o4[64 * j] = q8x4(v[j].x * inv, v[j].y * inv, v[j].z * inv, v[j].w * inv);
    if (lane == 0) *sa = am * (1.0f / 127.0f);
}
__device__ __forceinline__ void rms_row_to_bf16(const float* xrow, const float* gain, bf16* orow, int lane) {
    const f32x4* xr = (const f32x4*)xrow + lane; const f32x4* gr = (const f32x4*)gain + lane;
    f32x4 v[16]; float s = 0.f;
#pragma unroll
    for (int j = 0; j < 16; ++j) { v[j] = xr[64 * j]; s += (v[j].x * v[j].x + v[j].y * v[j].y) + (v[j].z * v[j].z + v[j].w * v[j].w); }
    const float r = rsqrtf(wave_sum(s) * (1.f / D) + EPS);
    u32x2* o8 = (u32x2*)orow + lane;
#pragma unroll
    for (int j = 0; j < 16; ++j) { const f32x4 gg = gr[64 * j]; u32x2 w; w.x = cvt_pk_bf16(v[j].x * r * gg.x, v[j].y * r * gg.y); w.y = cvt_pk_bf16(v[j].z * r * gg.z, v[j].w * r * gg.w); o8[64 * j] = w; }
}
__device__ __forceinline__ void sincos_d(double x, double& s, double& c) {
    const double n = rint(x * 0.63661977236758134308);
    const double r = (x - n * 1.5707963267948966192) - n * 6.123233995736766036e-17;
    const double r2 = r * r;
    const double sn = r * (1.0 + r2 * (-1.0 / 6 + r2 * (1.0 / 120 + r2 * (-1.0 / 5040 + r2 * (1.0 / 362880 + r2 * (-1.0 / 39916800 + r2 * (1.0 / 6227020800.0)))))));
    const double cs = 1.0 + r2 * (-0.5 + r2 * (1.0 / 24 + r2 * (-1.0 / 720 + r2 * (1.0 / 40320 + r2 * (-1.0 / 3628800 + r2 * (1.0 / 479001600.0 + r2 * (-1.0 / 87178291200.0)))))));
    const int q = ((int)n) & 3;
    s = (q == 0) ? sn : (q == 1) ? cs : (q == 2) ? -sn : -cs;
    c = (q == 0) ? cs : (q == 1) ? -sn : (q == 2) ? -cs : sn;
}
constexpr int I_GU = 64 * 172, I_DN = 172 * 64, I_WIN_ = 64 * 128, I_WOUT_ = 64 * 64, I_GLU_ = 32 * 32, I_QK_ = 32;
constexpr int IT_GU1 = 0, IT_GU2 = 2 * I_GU, IT_DN1 = 4 * I_GU, IT_DN2 = IT_DN1 + I_DN, IT_WIN = IT_DN2 + I_DN, IT_WOUT = IT_WIN + I_WIN_, IT_END = IT_WOUT + I_WOUT_ + I_GLU_ + 8 * I_QK_;
__device__ __forceinline__ void decode_item(Frame& F, int it, const float (&winv)[5], CvtItem& c) {
    int r = it; c.q8 = 0; c.scale = 1.f;
    if (r < 4 * I_GU) {
        const int which = r / I_GU; r -= which * I_GU;
        c.W = F.in[which == 0 ? I_F1G : which == 1 ? I_F1U : which == 2 ? I_F2G : I_F2U]; c.ldw = DFF; c.ldk = D;
        if (which < 2) { const int kb = r / 172, nb = r % 172, n0 = 64 * nb;
            c.k0 = 64 * kb; c.n0 = n0; c.WT = WSP(bf16, WS_W1GU); c.drow0 = (n0 >> 7) * 256 + (which & 1) * 128 + (n0 & 127); return; }
        const int kb = r / 344, nb = r % 344, n0 = 32 * nb;
        c.k0 = 128 * kb; c.n0 = n0; c.WT = WSP(signed char, WS_W2GU); c.drow0 = (n0 >> 7) * 256 + (which & 1) * 128 + (n0 & 127); c.q8 = 1; c.scale = winv[which]; return; }
    r -= 4 * I_GU;
    if (r < 2 * I_DN) { const int which = r / I_DN; r -= which * I_DN;
        if (which) { const int kb = r / 128, nb = r % 128;
            c.W = F.in[I_F2D]; c.ldw = D; c.k0 = 128 * kb; c.n0 = 32 * nb; c.WT = WSP(signed char, WS_W2D); c.ldk = DFF; c.drow0 = 32 * nb; c.q8 = 1; c.scale = winv[4]; return; }
        const int kb = r / 64, nb = r % 64;
        c.W = F.in[I_F1D]; c.ldw = D; c.k0 = 64 * kb; c.n0 = 64 * nb; c.WT = WSP(bf16, WS_W1D); c.ldk = DFF; c.drow0 = 64 * nb; return; }
    r -= 2 * I_DN;
    if (r < I_WIN_) { const int kb = r / 128, nb = r % 128; c.W = F.in[I_WIN]; c.ldw = 8200; c.k0 = 64 * kb; c.n0 = 64 * nb; c.WT = WSP(bf16, WS_WIN); c.ldk = D; c.drow0 = 64 * nb; return; }
    r -= I_WIN_;
    if (r < I_WOUT_) { const int kb = r / 64, nb = r % 64; c.W = F.in[I_WOUT]; c.ldw = D; c.k0 = 64 * kb; c.n0 = 64 * nb; c.WT = WSP(bf16, WS_WOUT); c.ldk = D; c.drow0 = 64 * nb; return; }
    r -= I_WOUT_;
    if (r < I_GLU_) { const int kb = r / 32, nb = r % 32; c.W = F.in[I_WGLU]; c.ldw = 2048; c.k0 = 64 * kb; c.n0 = 64 * nb; c.WT = WSP(bf16, WS_WGLU); c.ldk = 2048; c.drow0 = 64 * nb; return; }
    r -= I_GLU_;
    { const int hk = r / I_QK_; r -= hk * I_QK_; const int h = hk >> 1, isk = hk & 1, kb = r / 4, nb = r % 4;
      c.W = F.in[isk ? I_WK : I_WQ] + (size_t)h * 512 * 256; c.ldw = 256; c.k0 = 64 * kb; c.n0 = 64 * nb; c.WT = WSP(bf16, WS_WQK) + (size_t)h * 512 * 512; c.ldk = 512; c.drow0 = isk * 256 + 64 * nb; c.scale = isk ? 0.0625f : 1.f; }
}
__device__ __forceinline__ void convert_item(Frame& F, int it, LAS float* scr, const float (&winv)[5]) { CvtItem c; decode_item(F, it, winv, c); f32x4 v[16]; cvt_load(c, F.lane, v); cvt_finish(c, F.lane, v, scr); }
template <int SET> __device__ __forceinline__ int cvt_set_size() { return SET == 0 ? 2 * I_GU : SET == 1 ? I_DN + (IT_END - IT_WIN) : SET == 2 ? 2 * I_GU : I_DN; }
template <int SET> __device__ __forceinline__ int cvt_set_item(int q) {
    if (SET == 0) return q;
    if (SET == 1) return q < I_DN ? IT_DN1 + q : IT_WIN + (q - I_DN);
    if (SET == 2) return IT_GU2 + q;
    return IT_DN2 + q;
}
template <int SET>
__device__ __forceinline__ void convert_stream(Frame& F, int w, int nw) {
    LAS float* scr = (LAS float*)(F.lds + F.wave * SCR_STRIDE);
    const float winv[5] = {1.f, 1.f, 1.0f / wscale(F, 2), 1.0f / wscale(F, 3), 1.0f / wscale(F, 4)};
    const int n = cvt_set_size<SET>();
    CvtItem c0, c1; f32x4 v0[16], v1[16]; int q = w;
    if (q < n) { decode_item(F, cvt_set_item<SET>(q), winv, c0); cvt_load(c0, F.lane, v0); }
    while (q < n) {
        const int qn = q + nw;
        if (qn < n) { decode_item(F, cvt_set_item<SET>(qn), winv, c1); cvt_load(c1, F.lane, v1); }
        cvt_finish(c0, F.lane, v0, scr);
        c0 = c1;
#pragma unroll
        for (int i = 0; i < 16; ++i) v0[i] = v1[i];
        q = qn;
    }
}
template <int SET>
__device__ __forceinline__ void convert_static(Frame& F, int first) { convert_stream<SET>(F, ((int)blockIdx.x - first) * NWAVES + F.wave, ((int)gridDim.x - first) * NWAVES); }
__device__ __forceinline__ void p0_prologue(Frame& F) {
    const int gw = F.vcu * NWAVES + F.wave, NGW = F.G * NWAVES;
    convert_stream<0>(F, gw, NGW);
    {
        const f32x4* gr = (const f32x4*)F.in[I_F1PRE] + F.lane; f32x4 gq[16];
#pragma unroll
        for (int j = 0; j < 16; ++j) gq[j] = gr[64 * j];
        for (int m = gw; m < TP; m += NGW) {
            const f32x4* xr = (const f32x4*)(F.in[I_XP] + (size_t)m * D) + F.lane; f32x4 v[16]; float s = 0.f;
#pragma unroll
            for (int j = 0; j < 16; ++j) { v[j] = __builtin_nontemporal_load(xr + 64 * j); s += (v[j].x * v[j].x + v[j].y * v[j].y) + (v[j].z * v[j].z + v[j].w * v[j].w); }
            const float r = rsqrtf(wave_sum(s) * (1.f / D) + EPS);
            u32x2* o8 = (u32x2*)(WSP(bf16, WS_HA) + (size_t)m * D) + F.lane;
#pragma unroll
            for (int j = 0; j < 16; ++j) { const f32x4 gg = gq[j]; u32x2 w; w.x = cvt_pk_bf16(v[j].x * r * gg.x, v[j].y * r * gg.y); w.y = cvt_pk_bf16(v[j].z * r * gg.z, v[j].w * r * gg.w); o8[64 * j] = w; }
        }
        LAS float* red = (LAS float*)F.lds;
        for (int ms = TP + F.vcu; ms < T; ms += F.G) {
            const f32x4* xr = (const f32x4*)(F.in[I_XS] + (size_t)(ms - TP) * D) + F.tid; const f32x4* g2 = (const f32x4*)F.in[I_F1PRE] + F.tid;
            const f32x4 a = xr[0], b = xr[512], ga = g2[0], gb = g2[512];
            float s = wave_sum((a.x * a.x + a.y * a.y) + (a.z * a.z + a.w * a.w) + (b.x * b.x + b.y * b.y) + (b.z * b.z + b.w * b.w));
            __syncthreads();
            if (F.lane == 0) red[F.wave] = s;
            __syncthreads();
            const float r = rsqrtf((((red[0] + red[1]) + (red[2] + red[3])) + ((red[4] + red[5]) + (red[6] + red[7]))) * (1.f / D) + EPS);
            u32x2* o8 = (u32x2*)(WSP(bf16, WS_HA) + (size_t)ms * D) + F.tid; u32x2 w;
            w.x = cvt_pk_bf16(a.x * r * ga.x, a.y * r * ga.y); w.y = cvt_pk_bf16(a.z * r * ga.z, a.w * r * ga.w); o8[0] = w;
            w.x = cvt_pk_bf16(b.x * r * gb.x, b.y * r * gb.y); w.y = cvt_pk_bf16(b.z * r * gb.z, b.w * r * gb.w); o8[512] = w;
        }
    }
    const int gt = F.vcu * NTHREADS + F.tid, NT = F.G * NTHREADS;
    { bf16* WIN = WSP(bf16, WS_WIN); const float* W = F.in[I_WIN];
      for (int i = gt; i < 8 * D / 2; i += NT) { const int j = i >> 11, k = (i & 2047) * 2; *(unsigned*)(WIN + (size_t)(8192 + j) * D + k) = cvt_pk_bf16(W[(size_t)k * 8200 + 8192 + j], W[(size_t)(k + 1) * 8200 + 8192 + j]); }
      u32x4* z = (u32x4*)(WIN + (size_t)8200 * D); for (int i = gt; i < 248 * D / 8; i += NT) z[i] = (u32x4){0u, 0u, 0u, 0u}; }
    for (int i = gt; i < NG * NP; i += NT) {
        const int g = i >> 6;
        const double are = F.in[I_ARE][i], aim = F.in[I_AIM][i], dt = exp((double)F.in[I_LOGDT][g]);
        const double mag = exp(are * dt); double sn, cs; sincos_d(aim * dt, sn, cs);
        const double abre = mag * cs, abim = mag * sn, den = are * are + aim * aim, ire = are / den, iim = -aim / den, fre = abre - 1.0, fim = abim;
        const double qre = fre * ire - fim * iim, qim = fre * iim + fim * ire;
        WSP(float, WS_S5AB)[i] = (float)abre; WSP(float, WS_S5AB)[8192 + i] = (float)abim;
        const CAS float* bre = (const CAS float*)F.in[I_BRE] + (size_t)i * 16; const CAS float* bim = (const CAS float*)F.in[I_BIM] + (size_t)i * 16;
        float* obre = WSP(float, WS_S5BB) + (size_t)i * 16; float* obim = obre + 131072;
#pragma unroll
        for (int j = 0; j < 16; ++j) { const double br = bre[j], bi = bim[j]; obre[j] = (float)(qre * br - qim * bi); obim[j] = (float)(qre * bi + qim * br); }
    }
}

template <int MODE, bool SAMPLE>
__device__ __forceinline__ void row_one(Frame& F, int m, const float* dbuf, const float* gpost, float scale, const float* gnext, bf16* hout) {
    {
        int ln = F.lane; asm volatile("" : "+v"(ln));
        const f32x4* gp = (const f32x4*)gpost + ln;
        u32x2* xb = (u32x2*)(WSP(bf16, WS_XR) + (size_t)m * D) + F.lane;
        const f32x4* xr = (const f32x4*)((m < TP) ? F.in[I_XP] + (size_t)m * D : F.in[I_XS] + (size_t)(m - TP) * D) + F.lane;
        f32x4 xf[MODE == 0 ? 16 : 1]; u32x2 xw[MODE == 0 ? 1 : 16];
#define ROWPASS_LOAD_X() do { if (MODE == 0) { _Pragma("unroll") for (int j = 0; j < 16; ++j) xf[j] = __builtin_nontemporal_load(xr + 64 * j); } \
                              else { _Pragma("unroll") for (int j = 0; j < 16; ++j) xw[j] = __builtin_nontemporal_load(xb + 64 * j); } } while (0)
        f32x4 v[16]; float s = 0.f;
        if (!SAMPLE) {
            ROWPASS_LOAD_X();
            const u32x2* db = (const u32x2*)((const bf16*)dbuf + (size_t)m * D) + F.lane;
#pragma unroll
            for (int j = 0; j < 16; ++j) { const u32x2 w = __builtin_nontemporal_load(db + 64 * j); v[j] = (f32x4){bflo(w.x), bfhi(w.x), bflo(w.y), bfhi(w.y)}; }
        } else {
#pragma unroll
            for (int j = 0; j < 16; ++j) v[j] = ((const LAS f32x4*)F.lds)[64 * j + F.lane];
            ROWPASS_LOAD_X();
        }
#undef ROWPASS_LOAD_X
        f32x4 gq[8];
#pragma unroll
        for (int j = 0; j < 8; ++j) gq[j] = gp[64 * j];
#pragma unroll
        for (int j = 0; j < 16; ++j) s += (v[j].x * v[j].x + v[j].y * v[j].y) + (v[j].z * v[j].z + v[j].w * v[j].w);
        const float r = rsqrtf(wave_sum(s) * (1.f / D) + EPS) * scale; float s2 = 0.f;
        f32x4* yo = (f32x4*)(F.out + O_Y + (size_t)m * D) + F.lane;
#pragma unroll
        for (int j = 0; j < 16; ++j) { f32x4 x;
            if (j == 8) {
#pragma unroll
                for (int jj = 0; jj < 8; ++jj) gq[jj] = gp[64 * (8 + jj)]; }
            if (MODE == 0) x = xf[j]; else { const u32x2 w = xw[j]; x = (f32x4){bflo(w.x), bfhi(w.x), bflo(w.y), bfhi(w.y)}; }
            const f32x4 gg = gq[j & 7]; v[j] = x + v[j] * r * gg;
            if (MODE == 2) __builtin_nontemporal_store(v[j], yo + 64 * j); else { u32x2 w; w.x = cvt_pk_bf16(v[j].x, v[j].y); w.y = cvt_pk_bf16(v[j].z, v[j].w); xb[64 * j] = w; }
            s2 += (v[j].x * v[j].x + v[j].y * v[j].y) + (v[j].z * v[j].z + v[j].w * v[j].w); }
        if (MODE == 0) {
            const f32x4* gn = (const f32x4*)gnext + ln; u32x2* o8 = (u32x2*)(hout + (size_t)m * D) + F.lane;
#pragma unroll
            for (int j = 0; j < 8; ++j) gq[j] = gn[64 * j];
            const float r2 = rsqrtf(wave_sum(s2) * (1.f / D) + EPS);
#pragma unroll
            for (int j = 0; j < 16; ++j) {
                if (j == 8) {
#pragma unroll
                    for (int jj = 0; jj < 8; ++jj) gq[jj] = gn[64 * (8 + jj)]; }
                const f32x4 gg = gq[j & 7]; u32x2 w; w.x = cvt_pk_bf16(v[j].x * r2 * gg.x, v[j].y * r2 * gg.y); w.y = cvt_pk_bf16(v[j].z * r2 * gg.z, v[j].w * r2 * gg.w); o8[64 * j] = w; }
        }
        if (MODE == 1) {
            const f32x4* gn = (const f32x4*)gnext + ln; float am = 0.f;
            const float r2 = rsqrtf(wave_sum(s2) * (1.f / D) + EPS);
#pragma unroll
            for (int j = 0; j < 16; ++j) { const f32x4 gg = gn[64 * j]; v[j] = v[j] * r2 * gg; am = fmaxf(fmaxf(am, fmaxf(fabsf(v[j].x), fabsf(v[j].y))), fmaxf(fabsf(v[j].z), fabsf(v[j].w))); }
            am = fmaxf(wave_max(am), 1e-20f); const float inv = 127.0f / am;
            unsigned* o4 = (unsigned*)((signed char*)hout + (size_t)m * D) + F.lane;
#pragma unroll
            for (int j = 0; j < 16; ++j) o4[64 * j] = q8x4(v[j].x * inv, v[j].y * inv, v[j].z * inv, v[j].w * inv);
            WSP(float, WS_SA)[(size_t)m * 64 + F.lane] = am * (1.0f / 127.0f);
        }
    }
}
template <int MODE>
__device__ __forceinline__ void row_pass(Frame& F, const float* dbuf, const float* gpost, float scale, const float* gnext, bf16* hout) {
    const int gw = F.vcu * NWAVES + F.wave, NGW = F.G * NWAVES;
    LAS f32x4* rowb = (LAS f32x4*)F.lds;
    LAS f32x4* part = rowb + 1024;
    for (int ms = TP + F.vcu; ms < T; ms += F.G) {
        __syncthreads();
        { const u32x2* s0 = (const u32x2*)(WSP(bf16, WS_SLAB) + ((size_t)(2 * F.wave) * 256 + (ms - TP)) * D) + F.lane; const u32x2* s1 = s0 + (size_t)256 * D / 4;
#pragma unroll
          for (int jh = 0; jh < 2; ++jh) { u32x2 a[8], b[8];
#pragma unroll
              for (int j = 0; j < 8; ++j) { a[j] = s0[64 * (8 * jh + j)]; b[j] = s1[64 * (8 * jh + j)]; }
#pragma unroll
              for (int j = 0; j < 8; ++j) part[F.wave * 1024 + 64 * (8 * jh + j) + F.lane] = (f32x4){bflo(a[j].x) + bflo(b[j].x), bfhi(a[j].x) + bfhi(b[j].x), bflo(a[j].y) + bflo(b[j].y), bfhi(a[j].y) + bfhi(b[j].y)}; } }
        __syncthreads();
#pragma unroll
        for (int q = 0; q < 2; ++q) { const int c = F.wave * 128 + q * 64 + F.lane; f32x4 t = part[c];
#pragma unroll
            for (int w = 1; w < 8; ++w) t += part[w * 1024 + c];
            rowb[c] = t; }
        __syncthreads();
        if (F.wave == 0) row_one<MODE, true>(F, ms, dbuf, gpost, scale, gnext, hout);
    }
    __syncthreads();
    for (int m = gw; m < TP; m += NGW) row_one<MODE, false>(F, m, dbuf, gpost, scale, gnext, hout);
}
__device__ __forceinline__ void p13_quant(Frame& F) {
    const int gw = F.vcu * NWAVES + F.wave, NGW = F.G * NWAVES;
    {
        LAS float* red = (LAS float*)F.lds;
        for (int ms = TP + F.vcu; ms < T; ms += F.G) {
            const u32x4* src = (const u32x4*)(WSP(bf16, WS_HID) + (size_t)ms * DFF); u32x4 v[3]; float am = 0.f;
#pragma unroll
            for (int i = 0; i < 3; ++i) { const int c = F.tid + 512 * i; v[i] = (u32x4){0u, 0u, 0u, 0u}; if (c < 1376) v[i] = src[c]; }
#pragma unroll
            for (int i = 0; i < 3; ++i) { const u32x4 w = v[i];
                am = fmaxf(fmaxf(fmaxf(am, fmaxf(fabsf(bflo(w.x)), fabsf(bfhi(w.x)))), fmaxf(fabsf(bflo(w.y)), fabsf(bfhi(w.y)))), fmaxf(fmaxf(fabsf(bflo(w.z)), fabsf(bfhi(w.z))), fmaxf(fabsf(bflo(w.w)), fabsf(bfhi(w.w))))); }
            am = wave_max(am);
            __syncthreads();
            if (F.lane == 0) red[F.wave] = am;
            __syncthreads();
            am = fmaxf(fmaxf(fmaxf(red[0], red[1]), fmaxf(red[2], red[3])), fmaxf(fmaxf(red[4], red[5]), fmaxf(red[6], red[7]))); am = fmaxf(am, 1e-20f);
            const float inv = 127.0f / am; u32x2* dst = (u32x2*)(WSP(signed char, WS_HID8) + (size_t)ms * DFF);
#pragma unroll
            for (int i = 0; i < 3; ++i) { const int c = F.tid + 512 * i; const u32x4 w = v[i]; u32x2 o; o.x = q8x4(bflo(w.x) * inv, bfhi(w.x) * inv, bflo(w.y) * inv, bfhi(w.y) * inv); o.y = q8x4(bflo(w.z) * inv, bfhi(w.z) * inv, bflo(w.w) * inv, bfhi(w.w) * inv);
                if (c < 1376) dst[c] = o; }
            if (F.wave == 0) WSP(float, WS_SA2)[(size_t)ms * 64 + F.lane] = am * (1.0f / 127.0f);
        }
    }
    for (int m = gw; m < TP; m += NGW) {
        const u32x4* src = (const u32x4*)(WSP(bf16, WS_HID) + (size_t)m * DFF) + F.lane;
        u32x4 v[22]; float am = 0.f;
#pragma unroll
        for (int i = 0; i < 22; ++i) { v[i] = (u32x4){0u, 0u, 0u, 0u}; if (i < 21 || F.lane < 32) v[i] = __builtin_nontemporal_load(src + 64 * i); }
#pragma unroll
        for (int i = 0; i < 22; ++i) { const u32x4 w = v[i];
            am = fmaxf(fmaxf(fmaxf(am, fmaxf(fabsf(bflo(w.x)), fabsf(bfhi(w.x)))), fmaxf(fabsf(bflo(w.y)), fabsf(bfhi(w.y)))), fmaxf(fmaxf(fabsf(bflo(w.z)), fabsf(bfhi(w.z))), fmaxf(fabsf(bflo(w.w)), fabsf(bfhi(w.w))))); }
        am = fmaxf(wave_max(am), 1e-20f); const float inv = 127.0f / am;
        u32x2* dst = (u32x2*)(WSP(signed char, WS_HID8) + (size_t)m * DFF) + F.lane;
#pragma unroll
        for (int i = 0; i < 22; ++i) { const u32x4 w = v[i]; u32x2 o; o.x = q8x4(bflo(w.x) * inv, bfhi(w.x) * inv, bflo(w.y) * inv, bfhi(w.y) * inv); o.y = q8x4(bflo(w.z) * inv, bfhi(w.z) * inv, bflo(w.w) * inv, bfhi(w.w) * inv);
            if (i < 21 || F.lane < 32) dst[64 * i] = o; }
        WSP(float, WS_SA2)[(size_t)m * 64 + F.lane] = am * (1.0f / 127.0f);
    }
}
__device__ __forceinline__ void zero_dbuf_tail(Frame& F) {
    const int gt = F.vcu * NTHREADS + F.tid, NT = F.G * NTHREADS;
    u32x4* z = (u32x4*)(WSP(float, WS_DBUF) + (size_t)TP * D);
    for (int i = gt; i < 256 * D / 4; i += NT) z[i] = (u32x4){0u, 0u, 0u, 0u};
}
template <int NT_TOTAL, bool I8 = false>
__device__ __forceinline__ void gemm_tail_splitk(Frame& F, const bf16* A, int lda, const bf16* Bt, int ldb, const float* sa = nullptr, float sw = 0.f) {
    const int c = F.vcu; if (c >= 256) return;
    const int pn = c & 15, ch = c >> 4;
    constexpr int SMALL = (NT_TOTAL / 16) & ~1, R = (NT_TOTAL - 16 * SMALL) / 2, BIG = SMALL + 2;
    static_assert(R >= 0 && R <= 16 && R * BIG + (16 - R) * SMALL == NT_TOTAL && SMALL >= 4, "split");
    const int k0 = (ch < R) ? ch * BIG : R * BIG + (ch - R) * SMALL, len = (ch < R) ? BIG : SMALL;
    pg8::Gemm g{A + (size_t)TP * lda + (size_t)k0 * 64, Bt + (size_t)k0 * 64, lda, ldb, len * 64, 0, 0};
    pg8::OneUnit S{pn};
    if constexpr (I8) { pg8::EpiBf16S E{WSP(bf16, WS_SLAB) + (size_t)ch * 256 * D, D, sa + (size_t)TP * 64, sw}; pg8::gemm_phase<pg8::EpiBf16S, pg8::OneUnit, true, true, false, true>(F.lds, g, S, E); }
    else { pg8::EpiBf16 E{WSP(bf16, WS_SLAB) + (size_t)ch * 256 * D, D}; pg8::gemm_phase<pg8::EpiBf16, pg8::OneUnit, true, true>(F.lds, g, S, E); }
}

__device__ __forceinline__ void p7_sample_qk(Frame& F) {
    for (int unit = F.vcu; unit < 64; unit += F.G) {
    const int h = unit >> 4, isk = (unit >> 3) & 1, cs = unit & 7;
    int lane_l = F.lane; asm volatile("" : "+v"(lane_l));
    const int fr = lane_l & 15, fq = lane_l >> 4;
    const bf16* A = WSP(bf16, WS_CV) + (size_t)(TP + 32 * F.wave + fr) * 2048 + h * 512 + 8 * fq;
    const bf16* B = WSP(bf16, WS_WQK) + (size_t)h * 512 * 512 + (size_t)(isk * 256 + cs * 32 + fr) * 512 + 8 * fq;
    f32x4 acc[2][2];
#pragma unroll
    for (int i = 0; i < 2; ++i)
#pragma unroll
        for (int j = 0; j < 2; ++j) acc[i][j] = (f32x4){0.f, 0.f, 0.f, 0.f};
#pragma unroll 4
    for (int ks = 0; ks < 16; ++ks) {
        bf16x8 a[2], b[2];
#pragma unroll
        for (int i = 0; i < 2; ++i) a[i] = *(const bf16x8*)(A + (size_t)(16 * i) * 2048 + 32 * ks);
#pragma unroll
        for (int j = 0; j < 2; ++j) b[j] = *(const bf16x8*)(B + (size_t)(16 * j) * 512 + 32 * ks);
#pragma unroll
        for (int i = 0; i < 2; ++i)
#pragma unroll
            for (int j = 0; j < 2; ++j) acc[i][j] = __builtin_amdgcn_mfma_f32_16x16x32_bf16(a[i], b[j], acc[i][j], 0, 0, 0);
    }
    bf16* O = (isk ? WSP(bf16, WS_K) : WSP(bf16, WS_Q)) + (size_t)(TP + 32 * F.wave) * 1024 + h * 256 + cs * 32;
#pragma unroll
    for (int i = 0; i < 2; ++i)
#pragma unroll
        for (int j = 0; j < 2; ++j)
#pragma unroll
            for (int r = 0; r < 4; ++r) { const float own = acc[i][j][r], oth = __shfl_xor(own, 1);
                if (!(fr & 1)) *(unsigned*)(O + (size_t)(16 * i + 4 * fq + r) * 1024 + 16 * j + fr) = cvt_pk_bf16(own, oth); }
    }
}
__device__ __forceinline__ void p5_conv(Frame& F) {
    if (F.wave < 4) return;
    const int gt = F.vcu * 256 + (F.tid - 256), NT = F.G * 256;
    const bf16* PB = WSP(bf16, WS_PB);
    {
        const int c8 = (gt & 255) * 8; bf16* CV = WSP(bf16, WS_CV);
        const float* cw = F.in[I_CONVW]; const float* cb = F.in[I_CONVB]; const float* cache = F.in[I_CONV];
        float w[4][8], bb[8];
#pragma unroll
        for (int j = 0; j < 4; ++j) { const f32x4 w0 = *(const f32x4*)(cw + j * 2048 + c8), w1 = *(const f32x4*)(cw + j * 2048 + c8 + 4);
            w[j][0] = w0.x; w[j][1] = w0.y; w[j][2] = w0.z; w[j][3] = w0.w; w[j][4] = w1.x; w[j][5] = w1.y; w[j][6] = w1.z; w[j][7] = w1.w; }
        { const f32x4 b0 = *(const f32x4*)(cb + c8), b1 = *(const f32x4*)(cb + c8 + 4); bb[0] = b0.x; bb[1] = b0.y; bb[2] = b0.z; bb[3] = b0.w; bb[4] = b1.x; bb[5] = b1.y; bb[6] = b1.z; bb[7] = b1.w; }
        for (int rb = gt >> 8; rb < T / 4; rb += NT >> 8) {
            const int row = 4 * rb; int pos, sb; if (row < TP) { pos = row; sb = -1; } else { pos = (row - TP) & 15; sb = (row - TP) >> 4; }
            u32x4 raw[7];
#pragma unroll
            for (int i = 0; i < 7; ++i) { const int rr = (pos - 3 + i >= 0) ? row - 3 + i : row; raw[i] = *(const u32x4*)(PB + (size_t)rr * 8192 + c8); }
            float u[7][8];
#pragma unroll
            for (int i = 0; i < 7; ++i) { const u32x4 q = raw[i]; u[i][0] = bflo(q.x); u[i][1] = bfhi(q.x); u[i][2] = bflo(q.y); u[i][3] = bfhi(q.y); u[i][4] = bflo(q.z); u[i][5] = bfhi(q.z); u[i][6] = bflo(q.w); u[i][7] = bfhi(q.w); }
            if (pos == 0) {
#pragma unroll
                for (int i = 0; i < 3; ++i) {
                    if (sb >= 0) { const float* cp = cache + ((size_t)sb * 3 + i) * 2048 + c8; const f32x4 a = *(const f32x4*)cp, b = *(const f32x4*)(cp + 4);
                        u[i][0] = a.x; u[i][1] = a.y; u[i][2] = a.z; u[i][3] = a.w; u[i][4] = b.x; u[i][5] = b.y; u[i][6] = b.z; u[i][7] = b.w; }
                    else {
#pragma unroll
                        for (int e = 0; e < 8; ++e) u[i][e] = 0.f; } } }
#pragma unroll
            for (int r = 0; r < 4; ++r) { float acc[8];
#pragma unroll
                for (int e = 0; e < 8; ++e) { float a = bb[e];
#pragma unroll
                    for (int j = 0; j < 4; ++j) a += u[r + j][e] * w[j][e];
                    acc[e] = siluf_(a); }
                u32x4 o; o.x = cvt_pk_bf16(acc[0], acc[1]); o.y = cvt_pk_bf16(acc[2], acc[3]); o.z = cvt_pk_bf16(acc[4], acc[5]); o.w = cvt_pk_bf16(acc[6], acc[7]);
                *(u32x4*)(CV + (size_t)(row + r) * 2048 + c8) = o; }
        }
    }
    for (int idx = gt; idx < 17 * 3 * 2048; idx += NT) {
        const int c = idx & 2047, r = (idx >> 11) % 3, sq = idx / (3 * 2048);
        const int row = (sq == 0) ? (TP - 3 + r) : (TP + (sq - 1) * 16 + 13 + r);
        const float v = bf2f(PB[(size_t)row * 8192 + c]);
        if (sq == 0) F.out[O_CONVP + (size_t)r * 2048 + c] = v; else F.out[O_CONVS + ((size_t)(sq - 1) * 3 + r) * 2048 + c] = v;
    }
}
__device__ __forceinline__ void p5_gates(Frame& F) {
    if (F.wave < 4) return;
    const int gw = F.vcu * 4 + (F.wave - 4), NGW = F.G * 4;
    const float* GATES = WSP(float, WS_GATES);
    for (int task = gw; task < NSU * NH; task += NGW) {
        const int su = task >> 2, h = task & 3, row0 = su_row0(su), len = su_len(su);
        const float bi = F.in[I_BI][h], bfv = F.in[I_BF][h];
        float lf[4], ig[4];
#pragma unroll
        for (int i = 0; i < 4; ++i) { const int tl = 4 * F.lane + i;
            if (tl < len) { const float* gp = GATES + (size_t)(row0 + tl) * 8; ig[i] = gp[h] + bi; lf[i] = logsigmoidf_(gp[4 + h] + bfv); } else { ig[i] = -INFINITY; lf[i] = 0.f; } }
        float c[4]; c[0] = lf[0]; c[1] = c[0] + lf[1]; c[2] = c[1] + lf[2]; c[3] = c[2] + lf[3];
        float incl = c[3];
#pragma unroll
        for (int o = 1; o < 64; o <<= 1) { const float t = __shfl_up(incl, o); if (F.lane >= o) incl += t; }
        const float excl = incl - c[3];
        float b[4], a[4], mr[4];
#pragma unroll
        for (int i = 0; i < 4; ++i) { b[i] = excl + c[i]; a[i] = ig[i] - b[i]; }
        mr[0] = a[0]; mr[1] = fmaxf(mr[0], a[1]); mr[2] = fmaxf(mr[1], a[2]); mr[3] = fmaxf(mr[2], a[3]);
        float mincl = mr[3];
#pragma unroll
        for (int o = 1; o < 64; o <<= 1) { const float t = __shfl_up(mincl, o); if (F.lane >= o) mincl = fmaxf(mincl, t); }
        float mexcl = __shfl_up(mincl, 1); if (F.lane == 0) mexcl = -INFINITY;
#pragma unroll
        for (int i = 0; i < 4; ++i) { const int tl = 4 * F.lane + i;
            if (tl < len) { const size_t o = (size_t)h * T + row0 + tl; WSP(float, WS_BARR)[o] = b[i]; WSP(float, WS_AARR)[o] = a[i]; WSP(float, WS_MRUN)[o] = fmaxf(mexcl, mr[i]); } }
        const float tot = __shfl(incl, 63), mx = __shfl(mincl, 63);
        if (F.lane == 0) { WSP(float, WS_SUA)[su * 4 + h] = mx; WSP(float, WS_SUB)[su * 4 + h] = tot; }
    }
}
struct S5C {
    float a1r[4], a1i[4], a2r[4], a2i[4], a3r[4], a3i[4], a4r[4], a4i[4], afr[4], afi[4], a8r[4], a8i[4], a16r[4], a16i[4];
    bf16x8 bfr[8];
};
#define CMULADD(orr, oi, ar_, ai_, xr_, xi_, br_, bi_) do { float _r = __builtin_fmaf((ar_), (xr_), __builtin_fmaf(-(ai_), (xi_), (br_))); asm volatile("" : "+v"(_r)); const float _i = __builtin_fmaf((ar_), (xi_), __builtin_fmaf((ai_), (xr_), (bi_))); orr = _r; oi = _i; } while (0)
__device__ __forceinline__ void s5_setup(Frame& F, int g, int fr, int fq, S5C& c) {
#pragma unroll
    for (int nb = 0; nb < 4; ++nb) {
        const int p = 16 * nb + fr; const float ar = WSP(float, WS_S5AB)[g * 64 + p], ai = WSP(float, WS_S5AB)[8192 + g * 64 + p];
        c.a1r[nb] = ar; c.a1i[nb] = ai;
        float a2r, a2i; CMULADD(a2r, a2i, ar, ai, ar, ai, 0.f, 0.f);
        c.a2r[nb] = a2r; c.a2i[nb] = a2i; CMULADD(c.a3r[nb], c.a3i[nb], a2r, a2i, ar, ai, 0.f, 0.f);
        CMULADD(c.a4r[nb], c.a4i[nb], a2r, a2i, a2r, a2i, 0.f, 0.f);
        CMULADD(c.a8r[nb], c.a8i[nb], c.a4r[nb], c.a4i[nb], c.a4r[nb], c.a4i[nb], 0.f, 0.f);
        float a12r, a12i; CMULADD(a12r, a12i, c.a8r[nb], c.a8i[nb], c.a4r[nb], c.a4i[nb], 0.f, 0.f);
        CMULADD(c.a16r[nb], c.a16i[nb], c.a8r[nb], c.a8i[nb], c.a8r[nb], c.a8i[nb], 0.f, 0.f);
        c.afr[nb] = fq == 0 ? 1.f : fq == 1 ? c.a4r[nb] : fq == 2 ? c.a8r[nb] : a12r;
        c.afi[nb] = fq == 0 ? 0.f : fq == 1 ? c.a4i[nb] : fq == 2 ? c.a8i[nb] : a12i;
    }
    f32x4 bq[8][2];
#pragma unroll
    for (int nbt = 0; nbt < 8; ++nbt) {
        const float* q = WSP(float, WS_S5BB) + (nbt >= 4 ? 131072 : 0) + ((size_t)g * 64 + 16 * (nbt & 3) + fr) * 16 + 8 * (fq & 1); bq[nbt][0] = *(const f32x4*)q; bq[nbt][1] = *(const f32x4*)(q + 4); }
#pragma unroll
    for (int nbt = 0; nbt < 8; ++nbt) { const f32x4 a = bq[nbt][0], b = bq[nbt][1];
        u32x4 w; w.x = cvt_pk_bf16(a.x, a.y); w.y = cvt_pk_bf16(a.z, a.w); w.z = cvt_pk_bf16(b.x, b.y); w.w = cvt_pk_bf16(b.z, b.w);
        if (fq >= 2) w = (u32x4){0u, 0u, 0u, 0u};
        c.bfr[nbt] = __builtin_bit_cast(bf16x8, w); }
}
template <bool FINAL>
__device__ __forceinline__ void s5_block(const S5C& c, const bf16x8 uf, int fr, int fq, float (&hr)[4], float (&hi)[4], LAS unsigned char* hs) {
    const bool odd = (fq & 1) != 0, up = (fq & 2) != 0;
#pragma unroll
    for (int nb = 0; nb < 4; ++nb) {
        const f32x4 dre = __builtin_amdgcn_mfma_f32_16x16x32_bf16(uf, c.bfr[nb], (f32x4){0.f, 0.f, 0.f, 0.f}, 0, 0, 0);
        const f32x4 dim = __builtin_amdgcn_mfma_f32_16x16x32_bf16(uf, c.bfr[nb + 4], (f32x4){0.f, 0.f, 0.f, 0.f}, 0, 0, 0);
        float lr[4], li[4];
#pragma unroll
        for (int r = 0; r < 4; ++r) { lr[r] = dre[r]; li[r] = dim[r]; }
#pragma unroll
        for (int r = 1; r < 4; ++r) CMULADD(lr[r], li[r], c.a1r[nb], c.a1i[nb], lr[r - 1], li[r - 1], lr[r], li[r]);
        const float p1r = __shfl_xor(lr[3], 16), p1i = __shfl_xor(li[3], 16);
        const float lor = odd ? p1r : lr[3], loi = odd ? p1i : li[3], hir = odd ? lr[3] : p1r, hii = odd ? li[3] : p1i;
        float tpr, tpi; CMULADD(tpr, tpi, c.a4r[nb], c.a4i[nb], lor, loi, hir, hii);
        const float p2r = __shfl_xor(tpr, 32), p2i = __shfl_xor(tpi, 32);
        const float t01r = up ? p2r : tpr, t01i = up ? p2i : tpi, t23r = up ? tpr : p2r, t23i = up ? tpi : p2i;
        if (FINAL) {
            float xr, xi; CMULADD(xr, xi, c.a4r[nb], c.a4i[nb], t01r, t01i, lor, loi);
            const float prer = up ? (odd ? xr : t01r) : (odd ? lor : 0.f), prei = up ? (odd ? xi : t01i) : (odd ? loi : 0.f);
            float cr, ci; CMULADD(cr, ci, c.afr[nb], c.afi[nb], hr[nb], hi[nb], prer, prei);
            float h0r, h0i, h1r, h1i, h2r, h2i, h3r, h3i;
            CMULADD(h0r, h0i, c.a1r[nb], c.a1i[nb], cr, ci, lr[0], li[0]);
            CMULADD(h1r, h1i, c.a2r[nb], c.a2i[nb], cr, ci, lr[1], li[1]);
            CMULADD(h2r, h2i, c.a3r[nb], c.a3i[nb], cr, ci, lr[2], li[2]);
            CMULADD(h3r, h3i, c.a4r[nb], c.a4i[nb], cr, ci, lr[3], li[3]);
            LAS unsigned char* hp = hs + (4 * fq) * 272 + (16 * nb + fr) * 4;
            *(LAS unsigned*)(hp) = cvt_pk_bf16(h0r, h0i); *(LAS unsigned*)(hp + 272) = cvt_pk_bf16(h1r, h1i); *(LAS unsigned*)(hp + 544) = cvt_pk_bf16(h2r, h2i); *(LAS unsigned*)(hp + 816) = cvt_pk_bf16(h3r, h3i);
        }
        float nr, ni; CMULADD(nr, ni, c.a8r[nb], c.a8i[nb], t01r, t01i, t23r, t23i);
        CMULADD(hr[nb], hi[nb], c.a16r[nb], c.a16i[nb], hr[nb], hi[nb], nr, ni);
    }
}
__device__ __forceinline__ bf16x8 s5_ufrag(const bf16* PB, int row, int g, int fq) {
    u32x4 w = (u32x4){0u, 0u, 0u, 0u}; if (fq < 2) w = *(const u32x4*)(PB + (size_t)row * 8192 + 6144 + g * 16 + 8 * fq);
    return __builtin_bit_cast(bf16x8, w);
}
__device__ __forceinline__ void s5_stage_u(const bf16* PB, int row0, int len, int g, LAS unsigned char* ul, int lane) {
    u32x4 st[8];
#pragma unroll
    for (int i = 0; i < 8; ++i) { const int c = lane + 64 * i, row = c >> 1, half = c & 1; const int rc = row < len ? row : len - 1;
        st[i] = *(const u32x4*)(PB + (size_t)(row0 + rc) * 8192 + 6144 + g * 16 + 8 * half); }
#pragma unroll
    for (int i = 0; i < 8; ++i) { const int c = lane + 64 * i, row = c >> 1; if (row < len) *(LAS u32x4*)(ul + c * 16) = st[i]; }
    asm volatile("s_waitcnt vmcnt(0) lgkmcnt(0)" ::: "memory"); __builtin_amdgcn_wave_barrier();
}
__device__ __forceinline__ bf16x8 s5_ufrag_lds(const LAS unsigned char* ul, int blk, int fr, int fq) {
    u32x4 w = (u32x4){0u, 0u, 0u, 0u}; if (fq < 2) w = *(const LAS u32x4*)(ul + ((16 * blk + fr) * 2 + fq) * 16);
    return __builtin_bit_cast(bf16x8, w);
}
__device__ __forceinline__ void p5_s5_local(Frame& F) {
    const int gw = F.vcu * NWAVES + F.wave, NGW = F.G * NWAVES, fr = F.lane & 15, fq = F.lane >> 4;
    const bf16* PB = WSP(bf16, WS_PB);
    unsigned* ticket = (unsigned*)(F.ws + WS_CTL) + 16384 + 64 * (4 + 16 * F.pp);
    for (;;) {
        int task = 0; if (F.lane == 0) task = (int)__hip_atomic_fetch_add(ticket, 1u, __ATOMIC_RELAXED, __HIP_MEMORY_SCOPE_AGENT);
        task = __builtin_amdgcn_readfirstlane(task);
        if (task >= 31 * NG) break;
        const int su = task >> 7, g = task & 127, row0 = su * 256;
        S5C c; s5_setup(F, g, fr, fq, c);
        float hr[4] = {0.f, 0.f, 0.f, 0.f}, hi[4] = {0.f, 0.f, 0.f, 0.f};
        LAS unsigned char* ul = F.lds + F.wave * 16384;
        s5_stage_u(PB, row0, 256, g, ul, F.lane);
        for (int blk = 0; blk < 16; ++blk) s5_block<false>(c, s5_ufrag_lds(ul, blk, fr, fq), fr, fq, hr, hi, nullptr);
        asm volatile("s_waitcnt lgkmcnt(0)" ::: "memory"); __builtin_amdgcn_wave_barrier();
        if (fq == 0) {
#pragma unroll
            for (int nb = 0; nb < 4; ++nb) { const size_t o = (size_t)su * 8192 + g * 64 + 16 * nb + fr; WSP(float, WS_S5LOC)[o] = hr[nb]; WSP(float, WS_S5LOC)[(size_t)32 * 8192 + o] = hi[nb]; }
        }
    }
}
__device__ __forceinline__ void p7_s5_final(Frame& F) {
    const int gw = F.vcu * NWAVES + F.wave, NGW = F.G * NWAVES;
    LAS unsigned char* ul = F.lds + F.wave * 16384;
    LAS unsigned char* hs = ul + 8192;
    const bf16* PB = WSP(bf16, WS_PB); bf16* Gb = WSP(bf16, WS_G);
    const int fr = F.lane & 15, fq = F.lane >> 4;
    S5C c; bf16x8 cf[4], dmf;
    auto group_setup = [&](const int g) __attribute__((always_inline)) {
        s5_setup(F, g, fr, fq, c);
#pragma unroll
        for (int ks = 0; ks < 4; ++ks) {
            const size_t o = ((size_t)g * 16 + fr) * 64 + 16 * ks + 4 * fq; const f32x4 a = *(const f32x4*)(F.in[I_CRE] + o), b = *(const f32x4*)(F.in[I_CIM] + o);
            u32x4 w; w.x = cvt_pk_bf16(a.x, -b.x); w.y = cvt_pk_bf16(a.y, -b.y); w.z = cvt_pk_bf16(a.z, -b.z); w.w = cvt_pk_bf16(a.w, -b.w);
            cf[ks] = __builtin_bit_cast(bf16x8, w); }
        { const float dj = F.in[I_S5D][g * 16 + fr]; float e[8];
#pragma unroll
          for (int k = 0; k < 8; ++k) e[k] = (8 * fq + k == fr) ? dj : 0.f;
          u32x4 w; w.x = cvt_pk_bf16(e[0], e[1]); w.y = cvt_pk_bf16(e[2], e[3]); w.z = cvt_pk_bf16(e[4], e[5]); w.w = cvt_pk_bf16(e[6], e[7]); dmf = __builtin_bit_cast(bf16x8, w); }
    };
    const bool same_g = (NGW & (NG - 1)) == 0;
    if (same_g) group_setup(gw & (NG - 1));
    for (int task = gw; task < NSU * NG; task += NGW) {
        const int su = task >> 7, g = task & 127, row0 = su_row0(su), len = su_len(su);
        if (!same_g) group_setup(g);
        float hr[4], hi[4];
        if (su < 32) {
            float pr[4], pi[4];
#pragma unroll
            for (int nb = 0; nb < 4; ++nb) { pr[nb] = c.a16r[nb]; pi[nb] = c.a16i[nb];
#pragma unroll
                for (int s = 0; s < 4; ++s) CMULADD(pr[nb], pi[nb], pr[nb], pi[nb], pr[nb], pi[nb], 0.f, 0.f);
                hr[nb] = 0.f; hi[nb] = 0.f; }
            for (int s0 = 0; s0 < su; s0 += 8) {
                float lr[4][8], li[4][8];
#pragma unroll
                for (int nb = 0; nb < 4; ++nb)
#pragma unroll
                    for (int k = 0; k < 8; ++k) { const int s = (s0 + k < su) ? s0 + k : su - 1; const size_t o = (size_t)s * 8192 + g * 64 + 16 * nb + fr; lr[nb][k] = WSP(float, WS_S5LOC)[o]; li[nb][k] = WSP(float, WS_S5LOC)[(size_t)32 * 8192 + o]; }
#pragma unroll
                for (int k = 0; k < 8; ++k) if (s0 + k < su) {
#pragma unroll
                    for (int nb = 0; nb < 4; ++nb) CMULADD(hr[nb], hi[nb], pr[nb], pi[nb], hr[nb], hi[nb], lr[nb][k], li[nb][k]); }
            }
        } else {
#pragma unroll
            for (int nb = 0; nb < 4; ++nb) { const int p = 16 * nb + fr; hr[nb] = F.in[I_S5RE][(size_t)(su - 32) * 8192 + g * 64 + p]; hi[nb] = F.in[I_S5IM][(size_t)(su - 32) * 8192 + g * 64 + p]; }
        }
        const int nblk = len >> 4;
        s5_stage_u(PB, row0, len, g, ul, F.lane);
        for (int blk = 0; blk < nblk; ++blk) {
            const bf16x8 uf = s5_ufrag_lds(ul, blk, fr, fq);
            s5_block<true>(c, uf, fr, fq, hr, hi, hs);
            asm volatile("s_waitcnt lgkmcnt(0)" ::: "memory"); __builtin_amdgcn_wave_barrier();
            f32x4 acc = __builtin_amdgcn_mfma_f32_16x16x32_bf16(uf, dmf, (f32x4){0.f, 0.f, 0.f, 0.f}, 0, 0, 0);
#pragma unroll
            for (int ks = 0; ks < 4; ++ks) { const bf16x8 af = *(const LAS bf16x8*)(hs + fr * 272 + (32 * ks + 8 * fq) * 2); acc = __builtin_amdgcn_mfma_f32_16x16x32_bf16(af, cf[ks], acc, 0, 0, 0); }
#pragma unroll
            for (int r = 0; r < 4; ++r) {
                const float own = gelu_tanh(acc[r]), oth = __shfl_xor(own, 1);
                if (!(fr & 1)) *(unsigned*)(Gb + (size_t)(row0 + 16 * blk + 4 * fq + r) * 2048 + g * 16 + fr) = cvt_pk_bf16(own, oth); }
            asm volatile("s_waitcnt lgkmcnt(0)" ::: "memory"); __builtin_amdgcn_wave_barrier();
        }
        if (fq == 0) {
#pragma unroll
            for (int nb = 0; nb < 4; ++nb) { const int p = 16 * nb + fr;
                if (su == 31) { F.out[O_S5REP + g * 64 + p] = hr[nb]; F.out[O_S5IMP + g * 64 + p] = hi[nb]; }
                if (su >= 32) { F.out[O_S5RES + (size_t)(su - 32) * 8192 + g * 64 + p] = hr[nb]; F.out[O_S5IMS + (size_t)(su - 32) * 8192 + g * 64 + p] = hi[nb]; } }
        }
    }
}

__device__ __forceinline__ bf16x8 tr_frag(const LAS unsigned char* p0, const LAS unsigned char* p1) {
    const s16x4 a = __builtin_amdgcn_ds_read_tr16_b64_v4i16((LAS s16x4*)p0), b = __builtin_amdgcn_ds_read_tr16_b64_v4i16((LAS s16x4*)p1);
    bf16x8 f; f[0] = a[0]; f[1] = a[1]; f[2] = a[2]; f[3] = a[3]; f[4] = b[0]; f[5] = b[1]; f[6] = b[2]; f[7] = b[3]; return f;
}
__device__ __forceinline__ void p7_m1(Frame& F) {
    constexpr int KP = 528, VP1 = 272;
    LAS unsigned char* KT = F.lds; LAS unsigned char* VT = F.lds + 64 * KP;
    const bf16* Kg = WSP(bf16, WS_K); const bf16* PB = WSP(bf16, WS_PB); const float* AARR = WSP(float, WS_AARR);
    int lane_l = F.lane; asm volatile("" : "+v"(lane_l));
    const int w = F.wave, wd = w >> 1, we = w & 1, fr = lane_l & 15, fq = lane_l >> 4;
    for (int unit = F.vcu; unit < 512; unit += F.G) {
        const int su = unit >> 4, h = (unit >> 2) & 3, es = unit & 3, row0 = su * 256;
        if (F.tid == 0) {
            const unsigned* fl = (const unsigned*)(F.ws + WS_CTL) + 32768 + 64 * ((su * 4 + h) * 2 + 1);
            for (unsigned sp = 0; sp < (1u << 20); ++sp) { if (__hip_atomic_load(fl, __ATOMIC_RELAXED, __HIP_MEMORY_SCOPE_AGENT) != 0u) break; __builtin_amdgcn_s_sleep(2); }
            __builtin_amdgcn_fence(__ATOMIC_ACQUIRE, "agent");
            asm volatile("s_waitcnt vmcnt(0)" ::: "memory");
        }
        __syncthreads();
        const float Asu = WSP(float, WS_SUA)[su * 4 + h];
        f32x4 acc[4][4];
#pragma unroll
        for (int i = 0; i < 4; ++i)
#pragma unroll
            for (int j = 0; j < 4; ++j) acc[i][j] = (f32x4){0.f, 0.f, 0.f, 0.f};
        float nk = 0.f;
        u32x4 pk[4], pv[2]; float pa[4];
#define M1_PREFETCH(KT_) do { const int s0_ = row0 + 64 * (KT_); int tq_ = F.tid; asm volatile("" : "+v"(tq_)); \
            _Pragma("unroll") for (int i = 0; i < 4; ++i) { const int c = tq_ + 512 * i, row = c >> 5, cc = c & 31; pa[i] = AARR[(size_t)h * T + s0_ + row]; pk[i] = *(const u32x4*)(Kg + (size_t)(s0_ + row) * 1024 + h * 256 + cc * 8); } \
            _Pragma("unroll") for (int i = 0; i < 2; ++i) { const int c = tq_ + 512 * i, row = c >> 4, cc = c & 15; pv[i] = *(const u32x4*)(PB + (size_t)(s0_ + row) * 8192 + 2048 + h * 512 + es * 128 + cc * 8); } } while (0)
        M1_PREFETCH(0);
        for (int kt = 0; kt < 4; ++kt) {
            { int tq = F.tid; asm volatile("" : "+v"(tq));
#pragma unroll
              for (int i = 0; i < 4; ++i) { const int c = tq + 512 * i, row = c >> 5, cc = c & 31;
                const float wgt = __expf(pa[i] - Asu); const u32x4 kv = pk[i];
                u32x4 o; o.x = cvt_pk_bf16(bflo(kv.x) * wgt, bfhi(kv.x) * wgt); o.y = cvt_pk_bf16(bflo(kv.y) * wgt, bfhi(kv.y) * wgt); o.z = cvt_pk_bf16(bflo(kv.z) * wgt, bfhi(kv.z) * wgt); o.w = cvt_pk_bf16(bflo(kv.w) * wgt, bfhi(kv.w) * wgt);
                *(LAS u32x4*)(KT + row * KP + cc * 16) = o; }
#pragma unroll
              for (int i = 0; i < 2; ++i) { const int c = tq + 512 * i, row = c >> 4, cc = c & 15; *(LAS u32x4*)(VT + row * VP1 + cc * 16) = pv[i]; } }
            if (kt + 1 < 4) M1_PREFETCH(kt + 1);
            __syncthreads();
            if (es == 0 && F.tid < 256) { for (int r = 0; r < 64; ++r) nk += bf2f(*(const LAS bf16*)(KT + r * KP + F.tid * 2)); }
#pragma unroll
            for (int ks = 0; ks < 2; ++ks) {
                const int rbase = 32 * ks + 8 * fq + (fr >> 2);
                bf16x8 af[4];
#pragma unroll
                for (int dt = 0; dt < 4; ++dt) { const LAS unsigned char* p = KT + rbase * KP + (64 * wd + 16 * dt + 4 * (fr & 3)) * 2; af[dt] = tr_frag(p, p + 4 * KP); }
#pragma unroll
                for (int et = 0; et < 4; ++et) { const LAS unsigned char* p = VT + rbase * VP1 + (64 * we + 16 * et + 4 * (fr & 3)) * 2; const bf16x8 bfr = tr_frag(p, p + 4 * VP1);
#pragma unroll
                    for (int dt = 0; dt < 4; ++dt) acc[dt][et] = __builtin_amdgcn_mfma_f32_16x16x32_bf16(af[dt], bfr, acc[dt][et], 0, 0, 0); }
            }
            __syncthreads();
        }
        int kvo = (64 * wd + 4 * fq) * 512 + es * 128 + 64 * we + fr; asm volatile("" : "+v"(kvo));
        float* KV = WSP(float, WS_KV) + (size_t)(su * 4 + h) * 131072 + kvo;
#pragma unroll
        for (int dt = 0; dt < 4; ++dt)
#pragma unroll
            for (int et = 0; et < 4; ++et)
#pragma unroll
                for (int r = 0; r < 4; ++r) KV[(16 * dt + r) * 512 + 16 * et] = acc[dt][et][r];
        if (es == 0 && F.tid < 256) WSP(float, WS_NK)[(su * 4 + h) * 256 + F.tid] = nk;
    }
#undef M1_PREFETCH
    __syncthreads();
}
__device__ __forceinline__ void p8_m2(Frame& F) {
    const int gt = F.vcu * NTHREADS + F.tid, NT = F.G * NTHREADS;
    const float* SUA = WSP(float, WS_SUA); const float* SUB = WSP(float, WS_SUB); const float* KV = WSP(float, WS_KV); bf16* C0 = WSP(bf16, WS_C0);
    LAS float* s_ab = (LAS float*)F.lds;
    __syncthreads();
    if (F.tid < 128) { s_ab[F.tid] = SUA[F.tid]; s_ab[128 + F.tid] = SUB[F.tid]; }
    __syncthreads();
    for (int idx2 = gt; idx2 < NH * 131072 / 2; idx2 += NT) {
        const int idx = idx2 * 2, h = idx >> 17, de = idx & 131071; float st0 = 0.f, st1 = 0.f, m = 0.f;
        f32x2 kv[32];
#pragma unroll
        for (int su = 0; su < 32; ++su) kv[su] = __builtin_nontemporal_load((const f32x2*)(KV + (size_t)(su * 4 + h) * 131072 + de));
#pragma unroll
        for (int su = 0; su < 32; ++su) {
            *(unsigned*)(C0 + (size_t)(su * 4 + h) * 131072 + de) = cvt_pk_bf16(st0, st1);
            const float A = s_ab[su * 4 + h], B = s_ab[128 + su * 4 + h], Mx = fmaxf(m, A), al = __expf(m - Mx), be = __expf(A - Mx);
            st0 = al * st0 + be * kv[su].x; st1 = al * st1 + be * kv[su].y; m = B + Mx;
        }
        *(f32x2*)(F.out + O_CP + idx) = (f32x2){st0, st1};
    }
    for (int idx = gt; idx < NH * 256; idx += NT) {
        const int h = idx >> 8, d = idx & 255; float st = 0.f, m = 0.f;
        float nk[32], sa[32], sb[32];
#pragma unroll
        for (int su = 0; su < 32; ++su) { nk[su] = WSP(float, WS_NK)[(su * 4 + h) * 256 + d]; sa[su] = SUA[su * 4 + h]; sb[su] = SUB[su * 4 + h]; }
#pragma unroll
        for (int su = 0; su < 32; ++su) {
            WSP(float, WS_N0)[(su * 4 + h) * 256 + d] = st; if (d == 0) WSP(float, WS_M0)[su * 4 + h] = m;
            const float A = sa[su], B = sb[su], Mx = fmaxf(m, A);
            st = __expf(m - Mx) * st + __expf(A - Mx) * nk[su]; m = B + Mx;
        }
        F.out[O_NP + idx] = st; if (d == 0) F.out[O_MP + h] = m;
    }
    { const float* sc = F.in[I_SC]; bf16* dst = C0 + (size_t)128 * 131072;
      for (int idx = gt; idx < 64 * 131072 / 4; idx += NT) { const f32x4 v = *(const f32x4*)(sc + (size_t)idx * 4); u32x2 w; w.x = cvt_pk_bf16(v.x, v.y); w.y = cvt_pk_bf16(v.z, v.w); *(u32x2*)(dst + (size_t)idx * 4) = w; }
      for (int idx = gt; idx < 64 * 256; idx += NT) WSP(float, WS_N0)[128 * 256 + idx] = F.in[I_SN][idx];
      for (int idx = gt; idx < 64; idx += NT) WSP(float, WS_M0)[128 + idx] = F.in[I_SM][idx]; }
}
__device__ __forceinline__ void p8_m4(Frame& F) {
    LAS float* kw = (LAS float*)F.lds;
    LAS float* vv = (LAS float*)(F.lds + 16384);
    const bf16* Kg = WSP(bf16, WS_K); const bf16* PB = WSP(bf16, WS_PB);
    for (int unit4 = F.vcu; unit4 < 256; unit4 += F.G) {
        const int unit = unit4 >> 2, dq = unit4 & 3, b = unit >> 2, h = unit & 3, su = 32 + b, row0 = su_row0(su);
        const float A = WSP(float, WS_SUA)[su * 4 + h], B = WSP(float, WS_SUB)[su * 4 + h], m0 = F.in[I_SM][b * 4 + h], Mx = fmaxf(m0, A), alpha = __expf(m0 - Mx);
        __syncthreads();
        { const int s = F.tid >> 5, c8 = (F.tid & 31) * 8;
          const u32x4 kq = *(const u32x4*)(Kg + (size_t)(row0 + s) * 1024 + h * 256 + c8); const float wgt = __expf(WSP(float, WS_AARR)[(size_t)h * T + row0 + s] - Mx);
          u32x4 vq[2];
#pragma unroll
          for (int i = 0; i < 2; ++i) { const int c = F.tid + 512 * i, sv = c >> 6, cc = c & 63; vq[i] = *(const u32x4*)(PB + (size_t)(row0 + sv) * 8192 + 2048 + h * 512 + cc * 8); }
          LAS f32x4* kd = (LAS f32x4*)(kw + s * 256 + c8);
          kd[0] = (f32x4){bflo(kq.x) * wgt, bfhi(kq.x) * wgt, bflo(kq.y) * wgt, bfhi(kq.y) * wgt}; kd[1] = (f32x4){bflo(kq.z) * wgt, bfhi(kq.z) * wgt, bflo(kq.w) * wgt, bfhi(kq.w) * wgt};
#pragma unroll
          for (int i = 0; i < 2; ++i) { const int c = F.tid + 512 * i, sv = c >> 6, cc = c & 63; LAS f32x4* vd = (LAS f32x4*)(vv + sv * 512 + cc * 8);
              vd[0] = (f32x4){bflo(vq[i].x), bfhi(vq[i].x), bflo(vq[i].y), bfhi(vq[i].y)}; vd[1] = (f32x4){bflo(vq[i].z), bfhi(vq[i].z), bflo(vq[i].w), bfhi(vq[i].w)}; } }
        __syncthreads();
        const int e4 = F.tid & 127, dg = F.tid >> 7;
        f32x4 vr[16];
#pragma unroll
        for (int s = 0; s < 16; ++s) vr[s] = *(const LAS f32x4*)(vv + s * 512 + e4 * 4);
        const float* c0 = F.in[I_SC] + (size_t)(b * 4 + h) * 131072; float* co = F.out + O_CS + (size_t)(b * 4 + h) * 131072;
        for (int d0 = 64 * dq + dg; d0 < 64 * dq + 64; d0 += 32) {
            f32x4 a[8];
#pragma unroll
            for (int u = 0; u < 8; ++u) a[u] = *(const f32x4*)(c0 + (size_t)(d0 + 4 * u) * 512 + e4 * 4);
#pragma unroll
            for (int u = 0; u < 8; ++u) { a[u] = a[u] * alpha;
#pragma unroll
                for (int s = 0; s < 16; ++s) a[u] += vr[s] * kw[s * 256 + d0 + 4 * u];
                *(f32x4*)(co + (size_t)(d0 + 4 * u) * 512 + e4 * 4) = a[u]; }
        }
        if (dq == 0 && F.tid < 256) { float a = F.in[I_SN][(b * 4 + h) * 256 + F.tid] * alpha;
#pragma unroll
            for (int s = 0; s < 16; ++s) a += kw[s * 256 + F.tid];
            F.out[O_NS + (b * 4 + h) * 256 + F.tid] = a; }
        if (dq == 0 && F.tid == 0) F.out[O_MS + b * 4 + h] = B + Mx;
    }
    __syncthreads();
}
__device__ __forceinline__ void glu_tail_fixup(Frame& F) {
    const int gt = F.vcu * NTHREADS + F.tid, NT = F.G * NTHREADS;
    const float* SL = WSP(float, WS_SLAB); const bf16* Gb = WSP(bf16, WS_G); bf16* MIX = WSP(bf16, WS_HA);
    for (int i = gt; i < 256 * 2048 / 4; i += NT) {
        const int r = i >> 9, c4 = (i & 511) * 4;
        f32x4 z = *(const f32x4*)(F.in[I_BGLU] + c4);
#pragma unroll
        for (int ch = 0; ch < 8; ++ch) z += *(const f32x4*)(SL + ((size_t)ch * 256 + r) * 2048 + c4);
        const u32x2 gw = *(const u32x2*)(Gb + (size_t)(TP + r) * 2048 + c4);
        u32x2 o; o.x = cvt_pk_bf16(bflo(gw.x) * sigmoidf_(z.x), bfhi(gw.x) * sigmoidf_(z.y)); o.y = cvt_pk_bf16(bflo(gw.y) * sigmoidf_(z.z), bfhi(gw.y) * sigmoidf_(z.w));
        *(u32x2*)(MIX + (size_t)(TP + r) * 4096 + 2048 + c4) = o;
    }
}
__device__ __forceinline__ void p9_m3(Frame& F) {
    constexpr int QP = 528, VP = 1040, PP = 144;
    constexpr int OFF_Q = 0, OFF_K = 64 * QP, OFF_V = OFF_K + 64 * QP, OFF_P = OFF_V + 64 * VP, OFF_S = OFF_P + 64 * PP;
    static_assert(OFF_S + 8192 <= LDS_MISC, "M3 LDS");
    LAS unsigned char* QT = F.lds + OFF_Q; LAS unsigned char* KT = F.lds + OFF_K; LAS unsigned char* VT = F.lds + OFF_V; LAS unsigned char* PT = F.lds + OFF_P;
    LAS float* s_a = (LAS float*)(F.lds + OFF_S);
    LAS float* s_M = s_a + 64;
    LAS float* s_w = s_M + 64;
    LAS float* s_em = s_w + 64;
    LAS float* s_den = s_em + 64;
    LAS float* s_n0 = s_den + 64;
    LAS float* s_dp = s_n0 + 256;
    LAS float* s_rs = s_dp + 256;
    volatile LAS int* s_unit = (volatile LAS int*)(s_rs + 256);
    const bf16* Qg = WSP(bf16, WS_Q); const bf16* Kg = WSP(bf16, WS_K); const bf16* PB = WSP(bf16, WS_PB); const bf16* C0 = WSP(bf16, WS_C0); bf16* MIX = WSP(bf16, WS_HA);
    unsigned* ticket = (unsigned*)(F.ws + WS_CTL) + 16384 + 64 * (3 + 16 * F.pp);
    int lane_l = F.lane, tid_l = F.tid; asm volatile("" : "+v"(lane_l), "+v"(tid_l));
    const int w = F.wave, fr = lane_l & 15, fq = lane_l >> 4, tid = tid_l, wt2 = w >> 2, we = w & 3;
    if (tid == 0) s_unit[0] = (int)__hip_atomic_fetch_add(ticket, 1u, __ATOMIC_RELAXED, __HIP_MEMORY_SCOPE_AGENT);
    for (;;) {
        __syncthreads();
        const int unit = s_unit[0];
        if (unit >= 576) break;
        int nextu = 0; if (tid == 0) nextu = (int)__hip_atomic_fetch_add(ticket, 1u, __ATOMIC_RELAXED, __HIP_MEMORY_SCOPE_AGENT);
        int su, h, lt;
        if (unit < 512) { lt = 3 - (unit >> 7); su = (unit & 127) >> 2; h = unit & 3; } else { lt = 0; su = 32 + ((unit - 512) >> 2); h = unit & 3; }
        const int row0 = su_row0(su), len = su_len(su), t0 = row0 + 64 * lt, nvt = (len - 64 * lt) < 64 ? (len - 64 * lt) : 64;
        const float m0 = WSP(float, WS_M0)[su * 4 + h];
        const bf16* C0u = C0 + (size_t)(su * 4 + h) * 131072;
        const int nit = lt + 5;
        u32x4 pk[4], pv[8]; float pa = 0.f;
#define M3_PREFETCH(IT) do { const int it_ = (IT); int tq_ = tid; asm volatile("" : "+v"(tq_)); \
        if (it_ <= lt) { const int s0_ = row0 + 64 * it_, nvs_ = (len - 64 * it_) < 64 ? (len - 64 * it_) : 64; \
            _Pragma("unroll") for (int i = 0; i < 4; ++i) { const int c = tq_ + 512 * i, row = c >> 5, cc = c & 31; \
                pk[i] = (u32x4){0u, 0u, 0u, 0u}; if (row < nvs_) pk[i] = *(const u32x4*)(Kg + (size_t)(s0_ + row) * 1024 + h * 256 + cc * 8); } \
            _Pragma("unroll") for (int i = 0; i < 8; ++i) { const int c = tq_ + 512 * i, row = c >> 6, cc = c & 63; \
                pv[i] = (u32x4){0u, 0u, 0u, 0u}; if (row < nvs_) pv[i] = *(const u32x4*)(PB + (size_t)(s0_ + row) * 8192 + 2048 + h * 512 + cc * 8); } \
            if (tq_ < 64) pa = (tq_ < nvs_) ? WSP(float, WS_AARR)[(size_t)h * T + s0_ + tq_] : -INFINITY; } \
        else { const int ds_ = it_ - lt - 1; \
            _Pragma("unroll") for (int i = 0; i < 8; ++i) { const int c = tq_ + 512 * i, row = c >> 6, cc = c & 63; pv[i] = *(const u32x4*)(C0u + (size_t)(64 * ds_ + row) * 512 + cc * 8); } } } while (0)
        M3_PREFETCH(0);
        { u32x4 qv[4];
#pragma unroll
          for (int i = 0; i < 4; ++i) { const int c = tid + 512 * i, row = c >> 5, cc = c & 31; const int rc = row < nvt ? row : nvt - 1;
              qv[i] = *(const u32x4*)(Qg + (size_t)(t0 + rc) * 1024 + h * 256 + cc * 8); if (row >= nvt) qv[i] = (u32x4){0u, 0u, 0u, 0u}; }
#pragma unroll
          for (int i = 0; i < 4; ++i) { const int c = tid + 512 * i, row = c >> 5, cc = c & 31; *(LAS u32x4*)(QT + row * QP + cc * 16) = qv[i]; } }
        if (tid < 256) s_n0[tid] = WSP(float, WS_N0)[(su * 4 + h) * 256 + tid];
        if (tid < 64) { float Mt = m0, wt = 1.f, em = 1.f;
            if (tid < nvt) { const size_t o = (size_t)h * T + t0 + tid; const float mr = WSP(float, WS_MRUN)[o], b = WSP(float, WS_BARR)[o]; Mt = fmaxf(m0, mr); wt = __expf(m0 - Mt); em = __expf(-(b + Mt)); }
            s_M[tid] = Mt; s_w[tid] = wt; s_em[tid] = em; }
        f32x4 acc[2][8];
#pragma unroll
        for (int i = 0; i < 2; ++i)
#pragma unroll
            for (int j = 0; j < 8; ++j) acc[i][j] = (f32x4){0.f, 0.f, 0.f, 0.f};
        for (int it = 0; it < nit; ++it) {
            const bool key = it <= lt;
            if (it > 0) __syncthreads();
            if (key) { int tq = tid; asm volatile("" : "+v"(tq));
#pragma unroll
                for (int i = 0; i < 4; ++i) { const int c = tq + 512 * i, row = c >> 5, cc = c & 31; *(LAS u32x4*)(KT + row * QP + cc * 16) = pk[i]; }
                if (tid < 64) s_a[tid] = pa;
            }
            { int tq = tid; asm volatile("" : "+v"(tq));
#pragma unroll
              for (int i = 0; i < 8; ++i) { const int c = tq + 512 * i, row = c >> 6, cc = c & 63; *(LAS u32x4*)(VT + row * VP + cc * 16) = pv[i]; } }
            if (it + 1 < nit) M3_PREFETCH(it + 1);
            if (!key) {
                const int ds = it - lt - 1, t = tid >> 3, part = tid & 7; const float wt = s_w[t]; const u32x4 qv = *(const LAS u32x4*)(QT + t * QP + (64 * ds + 8 * part) * 2);
                u32x4 o; o.x = cvt_pk_bf16(bflo(qv.x) * wt, bfhi(qv.x) * wt); o.y = cvt_pk_bf16(bflo(qv.y) * wt, bfhi(qv.y) * wt); o.z = cvt_pk_bf16(bflo(qv.z) * wt, bfhi(qv.z) * wt); o.w = cvt_pk_bf16(bflo(qv.w) * wt, bfhi(qv.w) * wt);
                *(LAS u32x4*)(PT + t * PP + part * 16) = o; }
            __syncthreads();
            if (key) {
                const int kt = it;
                if (kt == 0) {
                    const int t = tid >> 3, part = tid & 7; float s = 0.f;
#pragma unroll
                    for (int c4 = 0; c4 < 4; ++c4) { const u32x4 qv = *(const LAS u32x4*)(QT + t * QP + (32 * part + 8 * c4) * 2); const LAS float* nn = s_n0 + 32 * part + 8 * c4;
                        s += bflo(qv.x) * nn[0] + bfhi(qv.x) * nn[1] + bflo(qv.y) * nn[2] + bfhi(qv.y) * nn[3] + bflo(qv.z) * nn[4] + bfhi(qv.z) * nn[5] + bflo(qv.w) * nn[6] + bfhi(qv.w) * nn[7]; }
                    s += __shfl_xor(s, 1); s += __shfl_xor(s, 2); s += __shfl_xor(s, 4);
                    if (part == 0) s_den[t] = s_w[t] * s;
                }
                { const int st = w & 3, tp = w >> 2;
                  f32x4 sacc[2] = {(f32x4){0.f, 0.f, 0.f, 0.f}, (f32x4){0.f, 0.f, 0.f, 0.f}};
#pragma unroll
                  for (int kk = 0; kk < 8; ++kk) { const bf16x8 af = *(const LAS bf16x8*)(KT + (16 * st + fr) * QP + (32 * kk + 8 * fq) * 2);
#pragma unroll
                      for (int j = 0; j < 2; ++j) { const bf16x8 bq = *(const LAS bf16x8*)(QT + (16 * (2 * tp + j) + fr) * QP + (32 * kk + 8 * fq) * 2); sacc[j] = __builtin_amdgcn_mfma_f32_16x16x32_bf16(af, bq, sacc[j], 0, 0, 0); } }
#pragma unroll
                  for (int j = 0; j < 2; ++j) { const int tl = 16 * (2 * tp + j) + fr; const float Mt = s_M[tl]; float pvv[4], ps = 0.f;
#pragma unroll
                      for (int r = 0; r < 4; ++r) { const int sl = 16 * st + 4 * fq + r; const bool ok = (64 * kt + sl) <= (64 * lt + tl);
                          const float e = ok ? __expf(s_a[sl] - Mt) : 0.f; pvv[r] = ok ? sacc[j][r] * e : 0.f; ps += pvv[r]; }
                      ps += __shfl_xor(ps, 16); ps += __shfl_xor(ps, 32);
                      if (fq == 0) s_dp[tl * 4 + st] = ps;
                      u32x2 pw; pw.x = cvt_pk_bf16(pvv[0], pvv[1]); pw.y = cvt_pk_bf16(pvv[2], pvv[3]);
                      *(LAS u32x2*)(PT + tl * PP + (16 * st + 4 * fq) * 2) = pw; } }
                __syncthreads();
                if (tid < 64) s_den[tid] += (s_dp[tid * 4] + s_dp[tid * 4 + 1]) + (s_dp[tid * 4 + 2] + s_dp[tid * 4 + 3]);
            }
#pragma unroll
            for (int ks = 0; ks < 2; ++ks) {
                bf16x8 pf[2];
#pragma unroll
                for (int j = 0; j < 2; ++j) pf[j] = *(const LAS bf16x8*)(PT + (16 * (2 * wt2 + j) + fr) * PP + (32 * ks + 8 * fq) * 2);
#pragma unroll
                for (int et = 0; et < 8; ++et) { const LAS unsigned char* p = VT + (32 * ks + 8 * fq + (fr >> 2)) * VP + (128 * we + 16 * et + 4 * (fr & 3)) * 2; const bf16x8 vf = tr_frag(p, p + 4 * VP);
#pragma unroll
                    for (int j = 0; j < 2; ++j) acc[j][et] = __builtin_amdgcn_mfma_f32_16x16x32_bf16(pf[j], vf, acc[j][et], 0, 0, 0); }
            }
        }
#undef M3_PREFETCH
#pragma unroll
        for (int j = 0; j < 2; ++j)
#pragma unroll
            for (int r = 0; r < 4; ++r) { const int tl = 16 * (2 * wt2 + j) + 4 * fq + r; const float inv = 1.0f / fmaxf(fabsf(s_den[tl]), s_em[tl]); float ss = 0.f;
#pragma unroll
                for (int et = 0; et < 8; ++et) { const float hv = acc[j][et][r] * inv; acc[j][et][r] = hv; ss += hv * hv; }
                ss += __shfl_xor(ss, 1); ss += __shfl_xor(ss, 2); ss += __shfl_xor(ss, 4); ss += __shfl_xor(ss, 8);
                if (fr == 0) s_rs[tl * 4 + we] = ss; }
        __syncthreads();
        const CAS float* hn = (const CAS float*)F.in[I_HN] + h * 512 + 128 * we + fr;
        float hnv[8];
#pragma unroll
        for (int et = 0; et < 8; ++et) hnv[et] = hn[16 * et];
#pragma unroll
        for (int j = 0; j < 2; ++j) {
            bf16 ogr[4][8];
#pragma unroll
            for (int r = 0; r < 4; ++r) { const int tl = 16 * (2 * wt2 + j) + 4 * fq + r; const size_t row = (size_t)(t0 + (tl < nvt ? tl : nvt - 1));
#pragma unroll
                for (int et = 0; et < 8; ++et) ogr[r][et] = PB[row * 8192 + 4096 + h * 512 + 128 * we + 16 * et + fr]; }
#pragma unroll
            for (int r = 0; r < 4; ++r) { const int tl = 16 * (2 * wt2 + j) + 4 * fq + r;
                const float rn = rsqrtf(((s_rs[tl * 4] + s_rs[tl * 4 + 1]) + (s_rs[tl * 4 + 2] + s_rs[tl * 4 + 3])) * (1.f / 512.f) + EPS); const size_t row = (size_t)(t0 + tl);
#pragma unroll
                for (int et = 0; et < 8; ++et) { const int e = 128 * we + 16 * et + fr;
                    const float own = acc[j][et][r] * rn * hnv[et] * sigmoidf_(bf2f(ogr[r][et])), oth = __shfl_xor(own, 1);
                    if (tl < nvt && !(fr & 1)) *(unsigned*)(MIX + row * 4096 + h * 512 + e) = cvt_pk_bf16(own, oth); } } }
        if (tid == 0) s_unit[0] = nextu;
    }
}

constexpr int N_PHASES = 16;
__global__ void __launch_bounds__(NTHREADS, 2) fwd_kernel(Args args) {
    extern __shared__ __attribute__((aligned(16))) unsigned char lds_raw[];
    Frame F;
    F.lds = (LAS unsigned char*)lds_raw;
    F.tid = threadIdx.x; F.lane = F.tid & 63; F.wave = __builtin_amdgcn_readfirstlane(F.tid >> 6);
    F.G = gridDim.x; { const int bx = blockIdx.x; F.vcu = (F.G % 8 == 0) ? (bx % 8) * (F.G / 8) + bx / 8 : bx; }
    F.in = args.in; F.out = args.out; F.ws = args.ws; F.pp = 0;
    volatile LAS unsigned* MISC = (volatile LAS unsigned*)(F.lds + LDS_MISC);
    if (F.tid < 32) MISC[F.tid] = 0u;
    __syncthreads();
    const int lo = args.ph_lo, hi = args.ph_hi;
    const bool multi = (hi - lo) > 1;
    XcdBarrier bar; bar.bar = (unsigned*)(F.ws + WS_CTL) + 4096; bar.x = 0; bar.st = MISC + 8;
    if (multi) bar = xcd_barrier_post((unsigned*)(F.ws + WS_CTL) + 4096, MISC + 8);
#define IN(k) (lo <= (k) && (k) < hi)
#define SEAM(k) do { if (IN(k) && IN((k) + 1)) xcd_barrier(bar); } while (0)
    const int bx = blockIdx.x;

#define PHASE(k, ...) if (IN(k)) { __VA_ARGS__ } SEAM(k); if constexpr (((PROBE_MASK) >> (k)) & 1) { F.pp = 1; if (IN(k)) { __VA_ARGS__ } SEAM(k); F.pp = 0; }
    PHASE(0, p0_stats(F); p0_prologue(F);)
    PHASE(1,
        if (F.G == 256 && bx >= 240) convert_static<1>(F, 240);
        else { const int GG = (F.G == 256) ? 240 : F.G;
        pg8::Gemm g{WSP(bf16, WS_HA), WSP(bf16, WS_W1GU), D, D, D, 0, 0}; pg8::StaticOrder S; S.init(T / 256, 2 * DFF / 256, 1, GG, bx);
        pg8::EpiSwiGLU E{WSP(bf16, WS_HID), DFF};
        pg8::gemm_phase<pg8::EpiSwiGLU, pg8::StaticOrder, true, true>(F.lds, g, S, E);
        if (F.G != 256) convert_static<1>(F, 0); })
    PHASE(2,
        pg8::Gemm g{WSP(bf16, WS_HID), WSP(bf16, WS_W1D), DFF, DFF, DFF, 0, 0}; pg8::StaticOrder S; S.init(32, D / 256, 1, F.G, bx);
        pg8::EpiBf16 E{WSP(bf16, WS_DBUF), D};
        pg8::gemm_phase<pg8::EpiBf16, pg8::StaticOrder, true, true>(F.lds, g, S, E);
        gemm_tail_splitk<172>(F, WSP(bf16, WS_HID), DFF, WSP(bf16, WS_W1D), DFF);)
    PHASE(3, row_pass<0>(F, WSP(float, WS_DBUF), F.in[I_F1POST], 0.5f, F.in[I_MIXPRE], WSP(bf16, WS_HA));)
    PHASE(4,
        if (F.G == 256 && bx >= 224) convert_static<2>(F, 224);
        else { const int GG = (F.G == 256) ? 224 : F.G;
        pg8::Gemm g{WSP(bf16, WS_HA), WSP(bf16, WS_WIN), D, D, D, 0, 0}; pg8::StaticOrder S; S.init(T / 256, 33, 1, GG, bx);
        pg8::EpiWin E{WSP(bf16, WS_PB), WSP(float, WS_GATES)};
        pg8::gemm_phase<pg8::EpiWin, pg8::StaticOrder, true, true>(F.lds, g, S, E);
        if (F.G != 256) convert_static<2>(F, 0); })
    PHASE(5, p5_conv(F); p5_gates(F); p5_s5_local(F);)
    if (IN(6)) {
        pg8::Gemm g{WSP(bf16, WS_CV), WSP(bf16, WS_WQK), 2048, 512, 512, 512, (size_t)512 * 512}; pg8::StaticOrder S; S.init(32, 2, 4, F.G, bx);
        pg8::EpiQK E{WSP(bf16, WS_Q), WSP(bf16, WS_K)};
        pg8::gemm_phase<pg8::EpiQK, pg8::StaticOrder, true, true>(F.lds, g, S, E);
        __syncthreads();
        if (F.tid == 0) {
            __builtin_amdgcn_fence(__ATOMIC_RELEASE, "agent");
            asm volatile("s_waitcnt vmcnt(0)" ::: "memory");
            unsigned* fl = (unsigned*)(F.ws + WS_CTL) + 32768;
            for (int i = 0; i < 2; ++i) {
                const long L = (long)i * F.G + bx; if (L >= 256) break;
                const int z = (int)(L / 64); int wgid = (int)(L % 64); { const int q = 8, xcd = wgid % 8, off = wgid / 8; wgid = xcd * q + off; }
                const int nig = 16, gid = wgid / nig, fm = gid * 8, pm = fm + (wgid % nig) % 8, pn = (wgid % nig) / 8;
                __hip_atomic_store(fl + 64 * ((pm * 4 + z) * 2 + pn), 1u, __ATOMIC_RELAXED, __HIP_MEMORY_SCOPE_AGENT); }
        }
    }
    if (!(IN(6) && IN(7))) {   }
    PHASE(7, p7_s5_final(F); p7_sample_qk(F); p7_m1(F);)
    PHASE(8,
        unsigned* hand = (unsigned*)(F.ws + WS_CTL) + 49152;
        p8_m2(F);
        asm volatile("s_waitcnt vmcnt(0)" ::: "memory"); __syncthreads();
        if (F.tid == 0) { __builtin_amdgcn_fence(__ATOMIC_RELEASE, "agent"); asm volatile("s_waitcnt vmcnt(0)" ::: "memory"); (void)__hip_atomic_fetch_add(hand, 1u, __ATOMIC_RELAXED, __HIP_MEMORY_SCOPE_AGENT); }
        p8_m4(F);
        pg8::Gemm g{WSP(bf16, WS_G), WSP(bf16, WS_WGLU), 2048, 2048, 2048, 0, 0}; pg8::StaticOrder S; S.init(32, 8, 1, F.G, bx);
        pg8::EpiGLU E{WSP(bf16, WS_G), F.in[I_BGLU], WSP(bf16, WS_HA)};
        pg8::gemm_phase<pg8::EpiGLU, pg8::StaticOrder, true, true>(F.lds, g, S, E);
        if (F.vcu >= 64 && F.vcu < 128) {
            const int c = F.vcu - 64, pn = c & 7, ch = c >> 3;
            pg8::Gemm gt{WSP(bf16, WS_G) + (size_t)TP * 2048 + (size_t)ch * 256, WSP(bf16, WS_WGLU) + (size_t)ch * 256, 2048, 2048, 256, 0, 0};
            pg8::OneUnit S1{pn}; pg8::EpiF32 E1{WSP(float, WS_SLAB) + (size_t)ch * 256 * 2048, 2048};
            pg8::gemm_phase<pg8::EpiF32, pg8::OneUnit, true, true>(F.lds, gt, S1, E1);
            __syncthreads();
            if (F.tid == 0) { __builtin_amdgcn_fence(__ATOMIC_RELEASE, "agent"); asm volatile("s_waitcnt vmcnt(0)" ::: "memory"); (void)__hip_atomic_fetch_add(hand + 64, 1u, __ATOMIC_RELAXED, __HIP_MEMORY_SCOPE_AGENT); } }
        if (F.tid == 0) { for (unsigned sp = 0; sp < (1u << 20); ++sp) { if (__hip_atomic_load(hand, __ATOMIC_RELAXED, __HIP_MEMORY_SCOPE_AGENT) >= (unsigned)F.G) break; __builtin_amdgcn_s_sleep(2); }
            __builtin_amdgcn_fence(__ATOMIC_ACQUIRE, "agent"); asm volatile("s_waitcnt vmcnt(0)" ::: "memory"); }
        __syncthreads();
        p9_m3(F);
        if (F.tid == 0) { const unsigned want = F.G >= 128 ? 64u : (F.G > 64 ? (unsigned)(F.G - 64) : 0u);
            for (unsigned sp = 0; sp < (1u << 20); ++sp) { if (__hip_atomic_load(hand + 64, __ATOMIC_RELAXED, __HIP_MEMORY_SCOPE_AGENT) >= want) break; __builtin_amdgcn_s_sleep(2); }
            __builtin_amdgcn_fence(__ATOMIC_ACQUIRE, "agent"); asm volatile("s_waitcnt vmcnt(0)" ::: "memory"); }
        __syncthreads();
        glu_tail_fixup(F);)
    PHASE(10,
        pg8::Gemm g{WSP(bf16, WS_HA), WSP(bf16, WS_WOUT), D, D, D, 0, 0}; pg8::StaticOrder S; S.init(32, D / 256, 1, F.G, bx);
        pg8::EpiBf16 E{WSP(bf16, WS_DBUF), D};
        pg8::gemm_phase<pg8::EpiBf16, pg8::StaticOrder, true, true>(F.lds, g, S, E);
        gemm_tail_splitk<64>(F, WSP(bf16, WS_HA), D, WSP(bf16, WS_WOUT), D);)
    if (IN(11)) { row_pass<1>(F, WSP(float, WS_DBUF), F.in[I_MIXPOST], 1.0f, F.in[I_F2PRE], WSP(bf16, WS_HQ)); } SEAM(11);
    PHASE(12,
        if (F.G == 256 && bx >= 240) convert_static<3>(F, 240);
        else { const int GG = (F.G == 256) ? 240 : F.G;
        pg8::Gemm g{WSP(bf16, WS_HQ), WSP(bf16, WS_W2GU), D / 2, D / 2, D / 2, 0, 0}; pg8::StaticOrder S; S.init(T / 256, 2 * DFF / 256, 1, GG, bx);
        pg8::EpiSwiGLU8 E{WSP(bf16, WS_HID), DFF, WSP(float, WS_SA), wscale(F, 2), wscale(F, 3)};
        pg8::gemm_phase<pg8::EpiSwiGLU8, pg8::StaticOrder, true, true, false, true>(F.lds, g, S, E);
        if (F.G != 256) convert_static<3>(F, 0); })
    PHASE(13, p13_quant(F);)
    PHASE(14,
        pg8::Gemm g{WSP(bf16, WS_HID8), WSP(bf16, WS_W2D), DFF / 2, DFF / 2, DFF / 2, 0, 0}; pg8::StaticOrder S; S.init(32, D / 256, 1, F.G, bx);
        pg8::EpiBf16S E{WSP(bf16, WS_DBUF), D, WSP(float, WS_SA2), wscale(F, 4)};
        pg8::gemm_phase<pg8::EpiBf16S, pg8::StaticOrder, true, true, false, true>(F.lds, g, S, E);
        gemm_tail_splitk<86, true>(F, WSP(bf16, WS_HID8), DFF / 2, WSP(bf16, WS_W2D), DFF / 2, WSP(float, WS_SA2), wscale(F, 4));)
    if (IN(15)) { row_pass<2>(F, WSP(float, WS_DBUF), F.in[I_F2POST], 0.5f, nullptr, nullptr); }
#undef PHASE
#undef IN
#undef SEAM
}

extern "C" void kernel_launch(void* const* d_in, const int* in_sizes, int n_in, void* d_out, int out_size, void* d_ws, size_t ws_size, hipStream_t stream) {
    static int grid = 0;
    if (grid == 0) {
        if (n_in != N_IN || out_size != (int)O_END || ws_size < WS_END) { fprintf(stderr, "kernel_launch: unexpected shapes (n_in %d, out %d, ws %zu, need %zu)\n", n_in, out_size, ws_size, (size_t)WS_END); grid = -1; return; }
        int dev = 0, cus = 0;
        if (hipGetDevice(&dev) != hipSuccess || hipDeviceGetAttribute(&cus, hipDeviceAttributeMultiprocessorCount, dev) != hipSuccess) { grid = -1; return; }
        if (hipFuncSetAttribute((const void*)fwd_kernel, hipFuncAttributeMaxDynamicSharedMemorySize, LDS_BYTES) != hipSuccess) { fprintf(stderr, "kernel_launch: hipFuncSetAttribute failed\n"); grid = -1; return; }
        int per_cu = 0; (void)hipOccupancyMaxActiveBlocksPerMultiprocessor(&per_cu, (const void*)fwd_kernel, NTHREADS, LDS_BYTES); (void)hipGetLastError();
        grid = cus;
    }
    if (grid < 0) return;
    (void)hipMemsetAsync((char*)d_ws + WS_CTL, 0, 200 * 1024, stream);
    Args a{};
    for (int i = 0; i < N_IN; ++i) a.in[i] = (const float*)d_in[i];
    a.out = (float*)d_out; a.ws = (unsigned char*)d_ws;
#if MK_ONE_LAUNCH
    a.ph_lo = 0; a.ph_hi = N_PHASES;
    hipLaunchKernelGGL(fwd_kernel, dim3(grid), dim3(NTHREADS), LDS_BYTES, stream, a);
#else
    for (int p = 0; p < N_PHASES; ++p) { a.ph_lo = p; a.ph_hi = p + 1; hipLaunchKernelGGL(fwd_kernel, dim3(grid), dim3(NTHREADS), LDS_BYTES, stream, a); }
#endif
}
```
